# Optimizing an MI355X kernel written in HIP

```python
import jax
import jax.numpy as jnp
from jax import lax
import numpy as np

D_MODEL = 2048
BATCH = 4
SEQ = 2048
DEPTH = 2

GRID_W = 64
CTX_LEN = 256
NORM_EPS = 1e-6
NEG_INF = -1e30

POOL_GROUPS = 4
POOL_WINDOWS = (2, 4, 8, 16)
POOL_GROUP_DIM = D_MODEL // 16
POOL_WIDTH = POOL_GROUPS * POOL_GROUP_DIM

RWKV_HEAD = 64
RWKV_HEADS = D_MODEL // 256
RWKV_WIDTH = RWKV_HEADS * RWKV_HEAD
DECAY_LORA = D_MODEL // 32
ICL_LORA = D_MODEL // 32
GATE_LORA = D_MODEL // 16
RWKV_GN_EPS = 64e-5
RWKV_SPLIT_SIZES = (RWKV_WIDTH, RWKV_WIDTH, RWKV_WIDTH, DECAY_LORA, ICL_LORA, GATE_LORA)
RWKV_COLS = 3 * RWKV_WIDTH + DECAY_LORA + ICL_LORA + GATE_LORA

ATT_HEAD = 128
ATT_Q_HEADS = D_MODEL // 256
ATT_KV_HEADS = ATT_Q_HEADS // 4
ATT_GROUP = ATT_Q_HEADS // ATT_KV_HEADS
ATT_WIDTH = ATT_Q_HEADS * ATT_HEAD
ATT_KV_WIDTH = ATT_KV_HEADS * ATT_HEAD
WINDOW = 128
BLOCK = 128
ROPE_AXIS_DIM = ATT_HEAD // 2
ROPE_THETA = 10000.0

IN_SPLIT_SIZES = (POOL_WIDTH, RWKV_COLS, ATT_WIDTH, ATT_KV_WIDTH, ATT_KV_WIDTH, D_MODEL, D_MODEL, D_MODEL)
IN_DIM = POOL_WIDTH + RWKV_COLS + ATT_WIDTH + 2 * ATT_KV_WIDTH + 3 * D_MODEL

N_GROUPS = 4
EXPERTS_PER_GROUP = 8
N_EXPERTS = N_GROUPS * EXPERTS_PER_GROUP
D_EXPERT = D_MODEL // 4
TOP_K = 2

kernel_name = 'hybrid_pool_rwkv7_swa_hmoe_dit'


def rms_norm(x, g):
    xf = x.astype(jnp.float32)
    y = xf * lax.rsqrt(jnp.mean(xf * xf, axis=-1, keepdims=True) + NORM_EPS)
    return (y * g.astype(jnp.float32)).astype(x.dtype)


def modulate(h, shift, scale):
    return h * (1 + scale) + shift


def split_cols(u, sizes):
    out, start = [], 0
    for s in sizes:
        out.append(u[..., start:start + s])
        start += s
    return out


def to_heads(t, n):
    return t.reshape(*t.shape[:-1], t.shape[-1] // n, n)


def axial_rope_tables(n_tokens):
    rows = n_tokens // GRID_W
    row = jnp.broadcast_to(jnp.arange(rows)[:, None], (rows, GRID_W)).reshape(-1).astype(jnp.float32)
    col = jnp.broadcast_to(jnp.arange(GRID_W)[None, :], (rows, GRID_W)).reshape(-1).astype(jnp.float32)
    inv_freq = ROPE_THETA ** (-jnp.arange(0, ROPE_AXIS_DIM, 2, dtype=jnp.float32) / ROPE_AXIS_DIM)
    ang = jnp.concatenate([row[:, None] * inv_freq, col[:, None] * inv_freq], axis=-1)
    return jnp.cos(ang), jnp.sin(ang)


def apply_axial_rope(x, cos, sin):
    B, T, H, Dh = x.shape
    half = ROPE_AXIS_DIM // 2
    xr = x.reshape(B, T, H, 2, 2, half)
    x1, x2 = xr[..., 0, :], xr[..., 1, :]
    c = cos.reshape(1, T, 1, 2, half).astype(x.dtype)
    s = sin.reshape(1, T, 1, 2, half).astype(x.dtype)
    out = jnp.stack([x1 * c - x2 * s, x1 * s + x2 * c], axis=-2)
    return out.reshape(B, T, H, Dh)


def centred_mean_minus_self(x, window):
    T = x.shape[1]
    cs = jnp.cumsum(x.astype(jnp.float32), axis=1)
    cs = jnp.concatenate([jnp.zeros_like(cs[:, :1]), cs], axis=1)
    t = jnp.arange(T)
    lo = jnp.clip(t - window // 2, 0, T)
    hi = jnp.clip(t + window - window // 2, 0, T)
    cnt = (hi - lo).astype(jnp.float32)[None, :, None]
    return ((cs[:, hi] - cs[:, lo]) / cnt).astype(x.dtype) - x


def pool_mixer(xa, pool_w, pool_scale):
    B, T, _ = xa.shape
    xg = xa.reshape(B, T, POOL_GROUPS, POOL_GROUP_DIM)
    pooled = jnp.stack([centred_mean_minus_self(xg[:, :, i], w) for i, w in enumerate(POOL_WINDOWS)], axis=2)
    y = jnp.einsum('btgc,gcd->btgd', pooled, pool_w)
    return y.reshape(B, T, POOL_WIDTH) * pool_scale


def centred_shift(u):
    pad = jnp.pad(u, ((0, 0), (1, 1), (0, 0)))
    return 0.5 * (pad[:, :-2] + pad[:, 2:])


def rwkv_streams(u, rwkv_mu, decay_w0, decay_up, icl_a0, icl_up, gate_up, k_k, k_a):
    u = u + rwkv_mu * (centred_shift(u) - u)
    r, k, v, wd, ad, gd = split_cols(u, RWKV_SPLIT_SIZES)
    g = jax.nn.sigmoid(gd) @ gate_up
    kk = to_heads(k * k_k, RWKV_HEAD).astype(jnp.float32)
    kk = kk / jnp.maximum(jnp.sqrt(jnp.sum(kk * kk, axis=-1, keepdims=True)), 1e-12)
    wd_t = jnp.tanh(wd)
    decays, keys, icls = [], [], []
    for d in range(2):
        w_log = -jax.nn.softplus(-(decay_w0[d] + wd_t @ decay_up[d]).astype(jnp.float32)) - 0.5
        decays.append(to_heads(jnp.exp(-jnp.exp(w_log)), RWKV_HEAD))
        a = jax.nn.sigmoid(icl_a0[d] + ad @ icl_up[d])
        keys.append(to_heads(k * (1 + (a - 1) * k_a), RWKV_HEAD))
        icls.append(to_heads(a, RWKV_HEAD))
    return to_heads(r, RWKV_HEAD), to_heads(v, RWKV_HEAD), kk, g, decays, keys, icls


def wkv_scan(state0, r, decay, k, v, kk, a, reverse):
    xs = tuple(jnp.moveaxis(t.astype(jnp.float32), 1, 0) for t in (r, decay, k, v, kk, a))

    def step(S, inp):
        r_t, w_t, k_t, v_t, kk_t, a_t = inp
        sa = jnp.einsum('bhvk,bhk->bhv', S, -kk_t)
        S = S * w_t[:, :, None, :] + sa[..., None] * (kk_t * a_t)[:, :, None, :] + v_t[..., None] * k_t[:, :, None, :]
        return S, jnp.einsum('bhvk,bhk->bhv', S, r_t)

    S, ys = lax.scan(step, state0, xs, reverse=reverse)
    return S, jnp.moveaxis(ys, 0, 1)


def rwkv_readout(y, r, v, keys, g, r_k, lnx_g, lnx_b):
    B, T, H, N = y.shape
    mean = jnp.mean(y, axis=-1, keepdims=True)
    var = jnp.mean(jnp.square(y - mean), axis=-1, keepdims=True)
    yn = ((y - mean) * lax.rsqrt(var + RWKV_GN_EPS)).reshape(B, T, H * N).astype(r.dtype) * lnx_g + lnx_b
    bonus = 0.5 * (jnp.sum(r * keys[0] * r_k, axis=-1, keepdims=True)
                   + jnp.sum(r * keys[1] * r_k, axis=-1, keepdims=True)) * v
    return (yn + bonus.reshape(B, T, H * N)) * g


def rwkv_mixer(u_lat, u_ctx, need_ctx, rwkv_mu, decay_w0, decay_up, icl_a0, icl_up, gate_up,
               k_k, k_a, r_k, lnx_g, lnx_b):
    r_l, v_l, kk_l, g_l, w_l, k_l, a_l = rwkv_streams(u_lat, rwkv_mu, decay_w0, decay_up, icl_a0, icl_up, gate_up, k_k, k_a)
    r_c, v_c, kk_c, g_c, w_c, k_c, a_c = rwkv_streams(u_ctx, rwkv_mu, decay_w0, decay_up, icl_a0, icl_up, gate_up, k_k, k_a)
    B = u_lat.shape[0]
    s0 = jnp.zeros((B, RWKV_HEADS, RWKV_HEAD, RWKV_HEAD), jnp.float32)
    y_lat, y_ctx = [], []
    for d, rev in ((0, False), (1, True)):
        s_ctx, yc = wkv_scan(s0, r_c, w_c[d], k_c[d], v_c, kk_c, a_c[d], rev)
        _, yl = wkv_scan(s_ctx, r_l, w_l[d], k_l[d], v_l, kk_l, a_l[d], rev)
        y_lat.append(yl)
        y_ctx.append(yc)
    out_lat = rwkv_readout(y_lat[0] + y_lat[1], r_l, v_l, k_l, g_l, r_k, lnx_g, lnx_b)
    out_ctx = rwkv_readout(y_ctx[0] + y_ctx[1], r_c, v_c, k_c, g_c, r_k, lnx_g, lnx_b) if need_ctx else None
    return out_lat, out_ctx


def latent_window_attention(q, q_nr, k, v, k_ctx, v_ctx, sink):
    B, L, KV, G, Dh = q.shape
    C = k_ctx.shape[1]
    nb = L // BLOCK
    scale = Dh ** -0.5

    def band(t):
        tp = jnp.pad(t, ((0, 0), (BLOCK, BLOCK), (0, 0), (0, 0))).reshape(B, nb + 2, BLOCK, KV, Dh)
        return jnp.concatenate([tp[:, :-2], tp[:, 1:-1], tp[:, 2:]], axis=2)

    kw, vw = band(k), band(v)
    qb = q.reshape(B, nb, BLOCK, KV, G, Dh)
    s_win = jnp.einsum('bnqhgd,bnkhd->bhgnqk', qb, kw).astype(jnp.float32) * scale
    qpos = jnp.arange(nb)[:, None] * BLOCK + jnp.arange(BLOCK)[None, :]
    kpos = jnp.arange(nb)[:, None] * BLOCK - BLOCK + jnp.arange(3 * BLOCK)[None, :]
    valid = ((kpos[:, None, :] >= 0) & (kpos[:, None, :] < L)
             & (jnp.abs(qpos[:, :, None] - kpos[:, None, :]) <= WINDOW))
    s_win = jnp.where(valid, s_win, NEG_INF)
    s_ctx = jnp.einsum('bnqhgd,bchd->bhgnqc', q_nr.reshape(B, nb, BLOCK, KV, G, Dh), k_ctx).astype(jnp.float32) * scale
    s_sink = jnp.broadcast_to(sink.reshape(1, KV, G, 1, 1, 1).astype(jnp.float32), s_ctx.shape[:-1] + (1,))
    p = jax.nn.softmax(jnp.concatenate([s_sink, s_ctx, s_win], axis=-1), axis=-1)
    p_ctx = p[..., 1:1 + C].astype(v.dtype)
    p_win = p[..., 1 + C:].astype(v.dtype)
    o = (jnp.einsum('bhgnqc,bchd->bnqhgd', p_ctx, v_ctx)
         + jnp.einsum('bhgnqk,bnkhd->bnqhgd', p_win, vw))
    return o.reshape(B, L, KV * G * Dh)


def context_attention(q, k, v, sink):
    B, C, KV, G, Dh = q.shape
    s = jnp.einsum('bchgd,bkhd->bhgck', q, k).astype(jnp.float32) * Dh ** -0.5
    s_sink = jnp.broadcast_to(sink.reshape(1, KV, G, 1, 1).astype(jnp.float32), (B, KV, G, C, 1))
    p = jax.nn.softmax(jnp.concatenate([s_sink, s], axis=-1), axis=-1)[..., 1:].astype(v.dtype)
    return jnp.einsum('bhgck,bkhd->bchgd', p, v).reshape(B, C, KV * G * Dh)


def attention_mixer(q_lat, k_lat, v_lat, q_ctx, k_ctx, v_ctx, sink, cos, sin, need_ctx):
    B, L, _ = q_lat.shape
    C = q_ctx.shape[1]
    ql = q_lat.reshape(B, L, ATT_Q_HEADS, ATT_HEAD)
    ql_rot = apply_axial_rope(ql, cos, sin).reshape(B, L, ATT_KV_HEADS, ATT_GROUP, ATT_HEAD)
    ql = ql.reshape(B, L, ATT_KV_HEADS, ATT_GROUP, ATT_HEAD)
    kl = apply_axial_rope(k_lat.reshape(B, L, ATT_KV_HEADS, ATT_HEAD), cos, sin)
    vl = v_lat.reshape(B, L, ATT_KV_HEADS, ATT_HEAD)
    kc = k_ctx.reshape(B, C, ATT_KV_HEADS, ATT_HEAD)
    vc = v_ctx.reshape(B, C, ATT_KV_HEADS, ATT_HEAD)
    sink = sink.reshape(ATT_KV_HEADS, ATT_GROUP)
    out_lat = latent_window_attention(ql_rot, ql, kl, vl, kc, vc, sink)
    out_ctx = None
    if need_ctx:
        out_ctx = context_attention(q_ctx.reshape(B, C, ATT_KV_HEADS, ATT_GROUP, ATT_HEAD), kc, vc, sink)
    return out_lat, out_ctx


def merge_branches(o_pool, o_rwkv, o_attn, g_pool, g_rwkv, g_attn, proj_pool, proj_rwkv, proj_attn, w_out):
    m = (jax.nn.sigmoid(g_pool) * (o_pool @ proj_pool)
         + jax.nn.sigmoid(g_rwkv) * (o_rwkv @ proj_rwkv)
         + jax.nn.sigmoid(g_attn) * (o_attn @ proj_attn))
    return m @ w_out


def token_mixer(h_lat, h_ctx, need_ctx, w_in, pool_w, pool_scale, rwkv_mu, decay_w0, decay_up, icl_a0, icl_up,
                gate_up, k_k, k_a, r_k, lnx_g, lnx_b, attn_sink, proj_pool, proj_rwkv, proj_attn, w_out, cos, sin):
    xa_l, rw_l, q_l, k_l, v_l, ga_l, gb_l, gc_l = split_cols(h_lat @ w_in, IN_SPLIT_SIZES)
    xa_c, rw_c, q_c, k_c, v_c, ga_c, gb_c, gc_c = split_cols(h_ctx @ w_in, IN_SPLIT_SIZES)
    rwkv_l, rwkv_c = rwkv_mixer(rw_l, rw_c, need_ctx, rwkv_mu, decay_w0, decay_up, icl_a0, icl_up, gate_up,
                                k_k, k_a, r_k, lnx_g, lnx_b)
    att_l, att_c = attention_mixer(q_l, k_l, v_l, q_c, k_c, v_c, attn_sink, cos, sin, need_ctx)
    out_l = merge_branches(pool_mixer(xa_l, pool_w, pool_scale), rwkv_l, att_l, ga_l, gb_l, gc_l,
                           proj_pool, proj_rwkv, proj_attn, w_out)
    out_c = None
    if need_ctx:
        out_c = merge_branches(pool_mixer(xa_c, pool_w, pool_scale), rwkv_c, att_c, ga_c, gb_c, gc_c,
                               proj_pool, proj_rwkv, proj_attn, w_out)
    return out_l, out_c


def hierarchical_moe(h, group_w, group_b, expert_rw, expert_rb, w_gate, w_up, w_down):
    B, T, _ = h.shape
    g_prob = jax.nn.softmax((h @ group_w).astype(jnp.float32) + group_b.astype(jnp.float32), axis=-1)
    g_top, g_idx = lax.top_k(g_prob, 1)
    e_logits = ((h @ expert_rw).astype(jnp.float32) + expert_rb.astype(jnp.float32)).reshape(B, T, N_GROUPS, EXPERTS_PER_GROUP)
    e_logits = jnp.take_along_axis(e_logits, g_idx[..., None], axis=2)[:, :, 0]
    e_top, e_idx = lax.top_k(jax.nn.softmax(e_logits, axis=-1), TOP_K)
    weights = g_top * e_top / jnp.sum(e_top, axis=-1, keepdims=True)
    ids = g_idx * EXPERTS_PER_GROUP + e_idx
    gate = jnp.sum(jax.nn.one_hot(ids, N_EXPERTS, dtype=jnp.float32) * weights[..., None], axis=2).astype(h.dtype)
    y = jnp.zeros_like(h)
    for e in range(N_EXPERTS):
        a = jax.nn.silu(h @ w_gate[e]) * (h @ w_up[e])
        y = y + (a * gate[..., e:e + 1]) @ w_down[e]
    return y


def setup_inputs(seed: int = 0) -> dict:
    key = jax.random.key(seed)
    k = jax.random.split(key, 35)
    D = D_MODEL
    f32 = jnp.float32

    def nrm(i, shape, scale):
        return jax.random.normal(k[i], shape, f32) * scale

    return {
        'x': nrm(0, (BATCH, SEQ, D), 1.0),
        'c': nrm(1, (BATCH, D), 1.0),
        'ctx': nrm(2, (BATCH, CTX_LEN, D), 1.0),
        'c_ctx': nrm(3, (D,), 1.0),
        'mod_w': nrm(4, (DEPTH, D, 6 * D), 0.5 * D ** -0.5),
        'mod_b': nrm(5, (DEPTH, 6 * D), 0.02),
        'norm1_g': 1.0 + nrm(6, (DEPTH, D), 0.05),
        'w_in': nrm(7, (DEPTH, D, IN_DIM), D ** -0.5),
        'pool_w': nrm(8, (DEPTH, POOL_GROUPS, POOL_GROUP_DIM, POOL_GROUP_DIM), POOL_GROUP_DIM ** -0.5),
        'pool_scale': 1.0 + nrm(9, (DEPTH, POOL_WIDTH), 0.1),
        'rwkv_mu': jax.random.uniform(k[10], (DEPTH, RWKV_COLS), f32, 0.0, 1.0),
        'decay_w0': jax.random.uniform(k[11], (DEPTH, 2, RWKV_WIDTH), f32, -5.0, -1.0),
        'decay_up': nrm(12, (DEPTH, 2, DECAY_LORA, RWKV_WIDTH), 0.1 * DECAY_LORA ** -0.5),
        'icl_a0': nrm(13, (DEPTH, 2, RWKV_WIDTH), 0.1),
        'icl_up': nrm(14, (DEPTH, 2, ICL_LORA, RWKV_WIDTH), 0.1 * ICL_LORA ** -0.5),
        'gate_up': nrm(15, (DEPTH, GATE_LORA, RWKV_WIDTH), GATE_LORA ** -0.5),
        'k_k': 0.85 + nrm(16, (DEPTH, RWKV_WIDTH), 0.05),
        'k_a': 1.0 + nrm(17, (DEPTH, RWKV_WIDTH), 0.05),
        'r_k': nrm(18, (DEPTH, RWKV_HEADS, RWKV_HEAD), 0.1),
        'lnx_g': 1.0 + nrm(19, (DEPTH, RWKV_WIDTH), 0.05),
        'lnx_b': nrm(20, (DEPTH, RWKV_WIDTH), 0.02),
        'attn_sink': nrm(21, (DEPTH, ATT_Q_HEADS), 0.5),
        'proj_pool': nrm(22, (DEPTH, POOL_WIDTH, D), POOL_WIDTH ** -0.5),
        'proj_rwkv': nrm(23, (DEPTH, RWKV_WIDTH, D), RWKV_WIDTH ** -0.5),
        'proj_attn': nrm(24, (DEPTH, ATT_WIDTH, D), ATT_WIDTH ** -0.5),
        'w_out': nrm(25, (DEPTH, D, D), D ** -0.5),
        'norm2_g': 1.0 + nrm(26, (DEPTH, D), 0.05),
        'router_group_w': nrm(27, (DEPTH, D, N_GROUPS), D ** -0.5),
        'router_group_b': nrm(28, (DEPTH, N_GROUPS), 0.01),
        'router_expert_w': nrm(29, (DEPTH, D, N_EXPERTS), D ** -0.5),
        'router_expert_b': nrm(30, (DEPTH, N_EXPERTS), 0.01),
        'expert_w_gate': nrm(31, (DEPTH, N_EXPERTS, D, D_EXPERT), D ** -0.5),
        'expert_w_up': nrm(32, (DEPTH, N_EXPERTS, D, D_EXPERT), D ** -0.5),
        'expert_w_down': nrm(33, (DEPTH, N_EXPERTS, D_EXPERT, D), D_EXPERT ** -0.5),
        'final_g': 1.0 + nrm(34, (D,), 0.05),
    }


def reference(x, c, ctx, c_ctx, mod_w, mod_b, norm1_g, w_in, pool_w, pool_scale, rwkv_mu, decay_w0, decay_up,
              icl_a0, icl_up, gate_up, k_k, k_a, r_k, lnx_g, lnx_b, attn_sink, proj_pool, proj_rwkv, proj_attn,
              w_out, norm2_g, router_group_w, router_group_b, router_expert_w, router_expert_b,
              expert_w_gate, expert_w_up, expert_w_down, final_g):
    n_ctx = ctx.shape[1]
    cos, sin = axial_rope_tables(x.shape[1])
    s_lat = jax.nn.silu(c)
    s_ctx = jax.nn.silu(c_ctx)[None]
    for l in range(DEPTH):
        last = l == DEPTH - 1
        m_lat = jnp.split((s_lat @ mod_w[l] + mod_b[l])[:, None, :], 6, axis=-1)
        m_ctx = jnp.split((s_ctx @ mod_w[l] + mod_b[l])[:, None, :], 6, axis=-1)
        h_lat = modulate(rms_norm(x, norm1_g[l]), m_lat[0], m_lat[1])
        h_ctx = modulate(rms_norm(ctx, norm1_g[l]), m_ctx[0], m_ctx[1])
        mix_lat, mix_ctx = token_mixer(h_lat, h_ctx, not last, w_in[l], pool_w[l], pool_scale[l], rwkv_mu[l],
                                       decay_w0[l], decay_up[l], icl_a0[l], icl_up[l], gate_up[l], k_k[l], k_a[l],
                                       r_k[l], lnx_g[l], lnx_b[l], attn_sink[l], proj_pool[l], proj_rwkv[l],
                                       proj_attn[l], w_out[l], cos, sin)
        x = x + m_lat[2] * mix_lat
        h2_lat = modulate(rms_norm(x, norm2_g[l]), m_lat[3], m_lat[4])
        if last:
            x = x + m_lat[5] * hierarchical_moe(h2_lat, router_group_w[l], router_group_b[l], router_expert_w[l],
                                                router_expert_b[l], expert_w_gate[l], expert_w_up[l], expert_w_down[l])
        else:
            ctx = ctx + m_ctx[2] * mix_ctx
            h2_ctx = modulate(rms_norm(ctx, norm2_g[l]), m_ctx[3], m_ctx[4])
            y = hierarchical_moe(jnp.concatenate([h2_ctx, h2_lat], axis=1), router_group_w[l], router_group_b[l],
                                 router_expert_w[l], router_expert_b[l], expert_w_gate[l], expert_w_up[l],
                                 expert_w_down[l])
            ctx = ctx + m_ctx[5] * y[:, :n_ctx]
            x = x + m_lat[5] * y[:, n_ctx:]
    return rms_norm(x, final_g)
```

```cpp
#ifndef EMU
#include <hip/hip_runtime.h>
#endif
#include <stdint.h>

#ifndef CFG_D
#define CFG_D 2048
#define CFG_B 4
#define CFG_L 2048
#define CFG_C 256
#endif
namespace {
constexpr int D = CFG_D, NB = CFG_B, L = CFG_L, C = CFG_C, DEPTH = 2;
constexpr int TC = NB * C, TL = NB * L, T = TC + TL;
constexpr int PGD = D / 16, PW = 4 * PGD;
constexpr int RH = D / 256, RW = RH * 64, DL = D / 32, IL = D / 32, GL = D / 16, RC = 3 * RW + DL + IL + GL;
constexpr int QH = D / 256, KVH = QH / 4, AW = QH * 128, KVW = KVH * 128;
constexpr int IN_DIM = PW + RC + AW + 2 * KVW + 3 * D;
constexpr int OFF_XA = 0, OFF_RW = PW, OFF_Q = PW + RC, OFF_K = OFF_Q + AW, OFF_V = OFF_K + KVW, OFF_GA = OFF_V + KVW, OFF_GB = OFF_GA + D, OFF_GC = OFF_GB + D;
constexpr int DE = D / 4, NE = 32;
constexpr float NORM_EPS = 1e-6f, GN_EPS = 64e-5f;
constexpr int NT = 256;

enum { IX = 0, IC, ICTX, ICCTX, IMODW, IMODB, INORM1, IWIN, IPOOLW, IPOOLS, IMU, IDW0, IDUP, IA0, IAUP, IGUP, IKK, IKA, IRK, ILNG, ILNB, ISINK, IPP, IPR, IPA, IWOUT, INORM2, IRGW, IRGB, IREW, IREB, IEWG, IEWU, IEWD, IFG, N_IN };

struct Params {
    const float* in[N_IN];
    float* out;
    float *X, *MOD, *H, *U, *POOLED, *OP, *QR, *KR, *OATT, *R_, *V_, *KK_, *G_, *W_, *K_, *B_, *BON, *Y, *ORW, *MB, *H2, *ACT, *YS, *EWT;
    int *EID, *ECNT, *ELIST;
};

__device__ __forceinline__ float sigmoidf_(float x) { return 1.0f / (1.0f + expf(-x)); }
__device__ __forceinline__ float siluf_(float x) { return x * sigmoidf_(x); }
__device__ __forceinline__ float softplusf_(float x) { return fmaxf(x, 0.0f) + log1pf(expf(-fabsf(x))); }

__device__ __forceinline__ void seq_info(int r, int& t, int& len, int& modrow) {
    if (r < TC) { t = r % C; len = C; modrow = NB; }
    else { const int q = r - TC; t = q % L; len = L; modrow = q / L; }
}

__device__ __forceinline__ float wave_sum(float v) {
#pragma unroll
    for (int m = 32; m >= 1; m >>= 1) v += __shfl_xor(v, m);
    return v;
}
__device__ __forceinline__ float wave_max(float v) {
#pragma unroll
    for (int m = 32; m >= 1; m >>= 1) v = fmaxf(v, __shfl_xor(v, m));
    return v;
}
__device__ __forceinline__ float block_sum(float v, float* red) {
    v = wave_sum(v);
    __syncthreads();
    if ((threadIdx.x & 63) == 0) red[threadIdx.x >> 6] = v;
    __syncthreads();
    return red[0] + red[1] + red[2] + red[3];
}

__device__ void ph_copy(const Params& p) {
    const int gt = blockIdx.x * NT + threadIdx.x, gs = gridDim.x * NT;
    for (long i = gt; i < (long)T * D; i += gs) p.X[i] = (i < (long)TC * D) ? p.in[ICTX][i] : p.in[IX][i - (long)TC * D];
    for (int i = gt; i < DEPTH * NE; i += gs) p.ECNT[i] = 0;
}
__device__ void ph_mod(const Params& p) {
    const int gt = blockIdx.x * NT + threadIdx.x, gs = gridDim.x * NT;
    for (int i = gt; i < DEPTH * 6 * D; i += gs) {
        const int l = i / (6 * D), n = i % (6 * D);
        float acc[NB + 1];
#pragma unroll
        for (int j = 0; j <= NB; ++j) acc[j] = 0.f;
        const float* w = p.in[IMODW] + (size_t)l * D * 6 * D + n;
        for (int k = 0; k < D; ++k) {
            const float wv = w[(size_t)k * 6 * D];
#pragma unroll
            for (int j = 0; j < NB; ++j) acc[j] += siluf_(p.in[IC][j * D + k]) * wv;
            acc[NB] += siluf_(p.in[ICCTX][k]) * wv;
        }
        const float bb = p.in[IMODB][l * 6 * D + n];
#pragma unroll
        for (int j = 0; j <= NB; ++j) p.MOD[((size_t)l * (NB + 1) + j) * 6 * D + n] = acc[j] + bb;
    }
}
__device__ void ph_norm1(const Params& p, int l, int mode) {
    __shared__ float red[4];
    const int r_begin = (mode == 2) ? TC : 0;
    for (int r = r_begin + blockIdx.x; r < T; r += gridDim.x) {
        int t, len, mr; seq_info(r, t, len, mr);
        float* xr = p.X + (size_t)r * D;
        const int lp = (mode == 2) ? DEPTH - 1 : l - 1;
        const bool comb = (lp >= 0) && (lp != DEPTH - 1 || r >= TC);
        float ss = 0.f;
        for (int i = threadIdx.x; i < D; i += NT) {
            float v = xr[i];
            if (comb) {
                const float g2 = p.MOD[((size_t)lp * (NB + 1) + mr) * 6 * D + 5 * D + i];
                v += g2 * (p.YS[(size_t)(2 * r) * D + i] + p.YS[(size_t)(2 * r + 1) * D + i]);
                xr[i] = v;
            }
            ss += v * v;
        }
        ss = block_sum(ss, red);
        const float rs = rsqrtf(ss / (float)D + NORM_EPS);
        if (mode == 2) {
            for (int i = threadIdx.x; i < D; i += NT) p.out[(size_t)(r - TC) * D + i] = xr[i] * rs * p.in[IFG][i];
        } else {
            const float* md = p.MOD + ((size_t)l * (NB + 1) + mr) * 6 * D;
            const float* g = p.in[INORM1] + l * D;
            for (int i = threadIdx.x; i < D; i += NT) p.H[(size_t)r * D + i] = (xr[i] * rs * g[i]) * (1.0f + md[D + i]) + md[i];
        }
    }
}

__device__ void gemm_tile(const float* A, int lda, const int* aidx, int ashift, int mvalid, int m0, const float* B, int ldb, int n0, int K, float (&acc)[4][4]) {
    __shared__ float As[16][68];
    __shared__ float Bs[16][68];
    const int tid = threadIdx.x, tx = tid & 15, ty = tid >> 4;
    const int ar = tid >> 2, ak = (tid & 3) * 4;
    const int bk = tid >> 4, bn = (tid & 15) * 4;
    const bool avalid = (m0 + ar) < mvalid;
    long arow = 0;
    if (avalid) arow = aidx ? (long)(aidx[m0 + ar] >> ashift) : (long)(m0 + ar);
    const float* ap = A + arow * lda + ak;
    const float* bp = B + (size_t)bk * ldb + n0 + bn;
    for (int k0 = 0; k0 < K; k0 += 16) {
        float a0 = 0.f, a1 = 0.f, a2 = 0.f, a3 = 0.f;
        if (avalid) { a0 = ap[k0]; a1 = ap[k0 + 1]; a2 = ap[k0 + 2]; a3 = ap[k0 + 3]; }
        const float* bq = bp + (size_t)k0 * ldb;
        const float b0 = bq[0], b1 = bq[1], b2 = bq[2], b3 = bq[3];
        __syncthreads();
        As[ak][ar] = a0; As[ak + 1][ar] = a1; As[ak + 2][ar] = a2; As[ak + 3][ar] = a3;
        Bs[bk][bn] = b0; Bs[bk][bn + 1] = b1; Bs[bk][bn + 2] = b2; Bs[bk][bn + 3] = b3;
        __syncthreads();
#pragma unroll
        for (int k = 0; k < 16; ++k) {
            float a[4], b[4];
#pragma unroll
            for (int i = 0; i < 4; ++i) { a[i] = As[k][4 * ty + i]; b[i] = Bs[k][4 * tx + i]; }
#pragma unroll
            for (int i = 0; i < 4; ++i)
#pragma unroll
                for (int j = 0; j < 4; ++j) acc[i][j] += a[i] * b[j];
        }
    }
}
#define ZERO_ACC(a) { _Pragma("unroll") for (int i_ = 0; i_ < 4; ++i_) _Pragma("unroll") for (int j_ = 0; j_ < 4; ++j_) a[i_][j_] = 0.f; }

__device__ void ph_win(const Params& p, int l) {
    const int tx = threadIdx.x & 15, ty = threadIdx.x >> 4;
    const int nM = T / 64, nN = IN_DIM / 64;
    for (int it = blockIdx.x; it < nM * nN; it += gridDim.x) {
        const int m0 = (it / nN) * 64, n0 = (it % nN) * 64;
        float acc[4][4]; ZERO_ACC(acc);
        gemm_tile(p.H, D, nullptr, 0, T, m0, p.in[IWIN] + (size_t)l * D * IN_DIM, IN_DIM, n0, D, acc);
#pragma unroll
        for (int i = 0; i < 4; ++i)
#pragma unroll
            for (int j = 0; j < 4; ++j) p.U[(size_t)(m0 + 4 * ty + i) * IN_DIM + n0 + 4 * tx + j] = acc[i][j];
    }
}

__device__ void ph_prep(const Params& p, int l) {
    __shared__ float us[RC];
    __shared__ float th[DL];
    __shared__ float sg[GL];
    __shared__ float kkr[RW];
    __shared__ float a_s[2][RW];
    __shared__ float bon[RW];
    __shared__ float hn[RH];
    const int tid = threadIdx.x;
    for (int r = blockIdx.x; r < T; r += gridDim.x) {
        int t, len, mr; seq_info(r, t, len, mr);
        const float* ur = p.U + (size_t)r * IN_DIM;
        for (int ch = tid; ch < PW; ch += NT) {
            const int gi = ch / PGD, w = 2 << gi;
            const int lo = max(t - w / 2, 0), hi = min(t + w / 2, len);
            float s = 0.f;
            for (int tt = lo; tt < hi; ++tt) s += p.U[(size_t)(r + tt - t) * IN_DIM + OFF_XA + ch];
            p.POOLED[(size_t)r * PW + ch] = s / (float)(hi - lo) - ur[OFF_XA + ch];
        }
        if (r >= TC) {
            const int rl = r - TC;
            const float prow = (float)(t / 64), pcol = (float)(t % 64);
            for (int i = tid; i < (QH + KVH) * 64; i += NT) {
                const int hh = i / 64, j = i % 64, ax = j / 32, f = j % 32;
                const float inv = powf(10000.0f, -(float)(2 * f) / 64.0f);
                const float ang = (ax == 0 ? prow : pcol) * inv;
                const float cs = cosf(ang), sn = sinf(ang);
                const float* src = (hh < QH) ? (ur + OFF_Q + hh * 128) : (ur + OFF_K + (hh - QH) * 128);
                float* dst = (hh < QH) ? (p.QR + (size_t)rl * AW + hh * 128) : (p.KR + (size_t)rl * KVW + (hh - QH) * 128);
                const float x1 = src[ax * 64 + f], x2 = src[ax * 64 + 32 + f];
                dst[ax * 64 + f] = x1 * cs - x2 * sn;
                dst[ax * 64 + 32 + f] = x1 * sn + x2 * cs;
            }
        }
        const float* mu = p.in[IMU] + l * RC;
        for (int ch = tid; ch < RC; ch += NT) {
            const float u0 = ur[OFF_RW + ch];
            const float up = (t > 0) ? p.U[(size_t)(r - 1) * IN_DIM + OFF_RW + ch] : 0.f;
            const float un = (t < len - 1) ? p.U[(size_t)(r + 1) * IN_DIM + OFF_RW + ch] : 0.f;
            us[ch] = u0 + mu[ch] * (0.5f * (up + un) - u0);
        }
        __syncthreads();
        for (int j = tid; j < DL; j += NT) th[j] = tanhf(us[3 * RW + j]);
        for (int j = tid; j < GL; j += NT) sg[j] = sigmoidf_(us[3 * RW + DL + IL + j]);
        __syncthreads();
        for (int ch = tid; ch < RW; ch += NT) {
            const float rr = us[ch], kk = us[RW + ch], vv = us[2 * RW + ch];
            float g = 0.f;
            const float* gu = p.in[IGUP] + (size_t)l * GL * RW + ch;
            for (int j = 0; j < GL; ++j) g += sg[j] * gu[(size_t)j * RW];
            float keysum = 0.f;
#pragma unroll
            for (int d = 0; d < 2; ++d) {
                float wl = p.in[IDW0][(l * 2 + d) * RW + ch];
                const float* du = p.in[IDUP] + ((size_t)(l * 2 + d) * DL) * RW + ch;
                for (int j = 0; j < DL; ++j) wl += th[j] * du[(size_t)j * RW];
                const float w_log = -softplusf_(-wl) - 0.5f;
                const float w = expf(-expf(w_log));
                float al = p.in[IA0][(l * 2 + d) * RW + ch];
                const float* au = p.in[IAUP] + ((size_t)(l * 2 + d) * IL) * RW + ch;
                for (int j = 0; j < IL; ++j) al += us[3 * RW + DL + j] * au[(size_t)j * RW];
                const float a = sigmoidf_(al);
                const float key = kk * (1.0f + (a - 1.0f) * p.in[IKA][l * RW + ch]);
                a_s[d][ch] = a;
                keysum += key;
                p.W_[((size_t)d * T + r) * RW + ch] = w;
                p.K_[((size_t)d * T + r) * RW + ch] = key;
            }
            kkr[ch] = kk * p.in[IKK][l * RW + ch];
            bon[ch] = rr * keysum * p.in[IRK][l * RW + ch];
            p.R_[(size_t)r * RW + ch] = rr;
            p.V_[(size_t)r * RW + ch] = vv;
            p.G_[(size_t)r * RW + ch] = g;
        }
        __syncthreads();
        if (tid < RH) {
            float s = 0.f, b = 0.f;
            for (int n = 0; n < 64; ++n) { const float v = kkr[tid * 64 + n]; s += v * v; b += bon[tid * 64 + n]; }
            hn[tid] = fmaxf(sqrtf(s), 1e-12f);
            p.BON[(size_t)r * RH + tid] = 0.5f * b;
        }
        __syncthreads();
        for (int ch = tid; ch < RW; ch += NT) {
            const float kn = kkr[ch] / hn[ch / 64];
            p.KK_[(size_t)r * RW + ch] = kn;
            p.B_[((size_t)0 * T + r) * RW + ch] = kn * a_s[0][ch];
            p.B_[((size_t)1 * T + r) * RW + ch] = kn * a_s[1][ch];
        }
        __syncthreads();
    }
}

__device__ void ph_scan(const Params& p, int l) {
    __shared__ float sv[4][5][64];
    const int wave = threadIdx.x >> 6, lane = threadIdx.x & 63;
    const int nchains = 2 * NB * RH;
    for (int c0 = blockIdx.x * 4; c0 < nchains; c0 += gridDim.x * 4) {
        const int chain = c0 + wave;
        const bool act = chain < nchains;
        const int d = act ? chain / (NB * RH) : 0, b = act ? (chain / RH) % NB : 0, h = act ? chain % RH : 0;
        float S[64];
#pragma unroll
        for (int k = 0; k < 64; ++k) S[k] = 0.f;
        for (int s = 0; s < C + L; ++s) {
            int row;
            if (s < C) row = b * C + (d == 0 ? s : C - 1 - s);
            else row = TC + b * L + (d == 0 ? (s - C) : (L - 1 - (s - C)));
            const size_t o = (size_t)row * RW + h * 64 + lane, od = ((size_t)d * T + row) * RW + h * 64 + lane;
            const float wv = p.W_[od], kv = p.K_[od], bv = p.B_[od], kkv = p.KK_[o], rv = p.R_[o], vv = p.V_[o];
            __syncthreads();
            sv[wave][0][lane] = wv; sv[wave][1][lane] = kv; sv[wave][2][lane] = bv; sv[wave][3][lane] = kkv; sv[wave][4][lane] = rv;
            __syncthreads();
            float sa = 0.f;
#pragma unroll
            for (int k = 0; k < 64; ++k) sa -= S[k] * sv[wave][3][k];
            float y = 0.f;
#pragma unroll
            for (int k = 0; k < 64; ++k) { S[k] = S[k] * sv[wave][0][k] + sa * sv[wave][2][k] + vv * sv[wave][1][k]; y += S[k] * sv[wave][4][k]; }
            if (act) p.Y[od] = y;
        }
    }
}

__device__ void ph_readout(const Params& p, int l) {
    for (int r = blockIdx.x; r < T; r += gridDim.x) {
        for (int ch = threadIdx.x; ch < RW; ch += NT) {
            const size_t o = (size_t)r * RW + ch;
            const float y = p.Y[o] + p.Y[(size_t)T * RW + o];
            const float mean = wave_sum(y) * (1.0f / 64.0f);
            const float dv = y - mean;
            const float var = wave_sum(dv * dv) * (1.0f / 64.0f);
            const float yn = dv * rsqrtf(var + GN_EPS) * p.in[ILNG][l * RW + ch] + p.in[ILNB][l * RW + ch];
            p.ORW[o] = (yn + p.BON[(size_t)r * RH + ch / 64] * p.V_[o]) * p.G_[o];
        }
    }
}

__device__ void ph_attn(const Params& p, int l, bool need_ctx) {
    constexpr int MAXK = C + 2 * 128 + 1;
    __shared__ float qs[4][2][128];
    __shared__ float sc[4][MAXK];
    const int wave = threadIdx.x >> 6, lane = threadIdx.x & 63;
    const int r_begin = need_ctx ? 0 : TC;
    const int nitems = (T - r_begin) * KVH;
    for (int it = blockIdx.x; it < nitems; it += gridDim.x) {
        const int r = r_begin + it / KVH, kvh = it % KVH;
        int t, len, mr; seq_info(r, t, len, mr);
        const int b = (r < TC) ? r / C : (r - TC) / L;
        const int hq = kvh * 4 + wave;
        const bool lat = r >= TC;
        __syncthreads();
        for (int i = lane; i < 128; i += 64) {
            qs[wave][0][i] = p.U[(size_t)r * IN_DIM + OFF_Q + hq * 128 + i];
            qs[wave][1][i] = lat ? p.QR[(size_t)(r - TC) * AW + hq * 128 + i] : 0.f;
        }
        __syncthreads();
        const int jlo = lat ? max(t - 128, 0) : 0, jhi = lat ? min(t + 128, L - 1) : -1;
        const int nwin = jhi - jlo + 1, nk = C + nwin;
        const float scale = 0.08838834764831845f;
        const float sink = p.in[ISINK][l * QH + hq];
        float mx = sink;
        for (int j = lane; j < nk; j += 64) {
            const float* kp; const float* qp;
            if (j < C) { kp = p.U + (size_t)(b * C + j) * IN_DIM + OFF_K + kvh * 128; qp = qs[wave][0]; }
            else { kp = p.KR + (size_t)(b * L + jlo + (j - C)) * KVW + kvh * 128; qp = qs[wave][1]; }
            float s = 0.f;
            for (int dd = 0; dd < 128; ++dd) s += qp[dd] * kp[dd];
            s *= scale;
            sc[wave][j] = s;
            mx = fmaxf(mx, s);
        }
        mx = wave_max(mx);
        float den = 0.f;
        for (int j = lane; j < nk; j += 64) { const float e = expf(sc[wave][j] - mx); sc[wave][j] = e; den += e; }
        den = wave_sum(den) + expf(sink - mx);
        __syncthreads();
        float o0 = 0.f, o1 = 0.f;
        for (int j = 0; j < nk; ++j) {
            const float* vp = (j < C) ? (p.U + (size_t)(b * C + j) * IN_DIM + OFF_V + kvh * 128) : (p.U + (size_t)(TC + b * L + jlo + (j - C)) * IN_DIM + OFF_V + kvh * 128);
            const float pj = sc[wave][j];
            o0 += pj * vp[lane]; o1 += pj * vp[lane + 64];
        }
        const float inv = 1.0f / den;
        p.OATT[(size_t)r * AW + hq * 128 + lane] = o0 * inv;
        p.OATT[(size_t)r * AW + hq * 128 + lane + 64] = o1 * inv;
    }
}

__device__ void ph_poolmm(const Params& p, int l) {
    const int tx = threadIdx.x & 15, ty = threadIdx.x >> 4;
    const int nM = T / 64, nN = PW / 64;
    for (int it = blockIdx.x; it < nM * nN; it += gridDim.x) {
        const int m0 = (it / nN) * 64, n0 = (it % nN) * 64, g = n0 / PGD;
        float acc[4][4]; ZERO_ACC(acc);
        gemm_tile(p.POOLED + g * PGD, PW, nullptr, 0, T, m0, p.in[IPOOLW] + ((size_t)l * 4 + g) * PGD * PGD, PGD, n0 - g * PGD, PGD, acc);
#pragma unroll
        for (int i = 0; i < 4; ++i)
#pragma unroll
            for (int j = 0; j < 4; ++j) { const int n = n0 + 4 * tx + j; p.OP[(size_t)(m0 + 4 * ty + i) * PW + n] = acc[i][j] * p.in[IPOOLS][l * PW + n]; }
    }
}

__device__ void ph_merge(const Params& p, int l, bool need_ctx) {
    const int tx = threadIdx.x & 15, ty = threadIdx.x >> 4;
    const int mt0 = need_ctx ? 0 : TC / 64;
    const int nM = T / 64 - mt0, nN = D / 64;
    for (int it = blockIdx.x; it < nM * nN; it += gridDim.x) {
        const int m0 = (mt0 + it / nN) * 64, n0 = (it % nN) * 64;
        float tot[4][4]; ZERO_ACC(tot);
#pragma unroll 1
        for (int br = 0; br < 3; ++br) {
            float acc[4][4]; ZERO_ACC(acc);
            if (br == 0) gemm_tile(p.OP, PW, nullptr, 0, T, m0, p.in[IPP] + (size_t)l * PW * D, D, n0, PW, acc);
            else if (br == 1) gemm_tile(p.ORW, RW, nullptr, 0, T, m0, p.in[IPR] + (size_t)l * RW * D, D, n0, RW, acc);
            else gemm_tile(p.OATT, AW, nullptr, 0, T, m0, p.in[IPA] + (size_t)l * AW * D, D, n0, AW, acc);
            const int goff = (br == 0) ? OFF_GA : (br == 1 ? OFF_GB : OFF_GC);
#pragma unroll
            for (int i = 0; i < 4; ++i)
#pragma unroll
                for (int j = 0; j < 4; ++j) tot[i][j] += sigmoidf_(p.U[(size_t)(m0 + 4 * ty + i) * IN_DIM + goff + n0 + 4 * tx + j]) * acc[i][j];
        }
#pragma unroll
        for (int i = 0; i < 4; ++i)
#pragma unroll
            for (int j = 0; j < 4; ++j) p.MB[(size_t)(m0 + 4 * ty + i) * D + n0 + 4 * tx + j] = tot[i][j];
    }
}

__device__ void ph_wout(const Params& p, int l, bool need_ctx) {
    const int tx = threadIdx.x & 15, ty = threadIdx.x >> 4;
    const int mt0 = need_ctx ? 0 : TC / 64;
    const int nM = T / 64 - mt0, nN = D / 64;
    for (int it = blockIdx.x; it < nM * nN; it += gridDim.x) {
        const int m0 = (mt0 + it / nN) * 64, n0 = (it % nN) * 64;
        float acc[4][4]; ZERO_ACC(acc);
        gemm_tile(p.MB, D, nullptr, 0, T, m0, p.in[IWOUT] + (size_t)l * D * D, D, n0, D, acc);
#pragma unroll
        for (int i = 0; i < 4; ++i) {
            const int r = m0 + 4 * ty + i; int t, len, mr; seq_info(r, t, len, mr);
#pragma unroll
            for (int j = 0; j < 4; ++j) { const int n = n0 + 4 * tx + j; p.X[(size_t)r * D + n] += p.MOD[((size_t)l * (NB + 1) + mr) * 6 * D + 2 * D + n] * acc[i][j]; }
        }
    }
}

__device__ void ph_norm2(const Params& p, int l, bool need_ctx) {
    __shared__ float red[4];
    __shared__ float hrow[D];
    __shared__ float lg[36];
    const int wave = threadIdx.x >> 6, lane = threadIdx.x & 63;
    const int r_begin = need_ctx ? 0 : TC;
    for (int r = r_begin + blockIdx.x; r < T; r += gridDim.x) {
        int t, len, mr; seq_info(r, t, len, mr);
        const float* xr = p.X + (size_t)r * D;
        float ss = 0.f;
        for (int i = threadIdx.x; i < D; i += NT) { const float v = xr[i]; ss += v * v; }
        ss = block_sum(ss, red);
        const float rs = rsqrtf(ss / (float)D + NORM_EPS);
        const float* md = p.MOD + ((size_t)l * (NB + 1) + mr) * 6 * D;
        const float* g = p.in[INORM2] + l * D;
        for (int i = threadIdx.x; i < D; i += NT) { const float h = (xr[i] * rs * g[i]) * (1.0f + md[4 * D + i]) + md[3 * D + i]; hrow[i] = h; p.H2[(size_t)r * D + i] = h; }
        __syncthreads();
        for (int q = wave; q < 36; q += 4) {
            float s = 0.f;
            if (q < 4) { const float* w = p.in[IRGW] + (size_t)l * D * 4 + q; for (int i = lane; i < D; i += 64) s += hrow[i] * w[(size_t)i * 4]; }
            else { const float* w = p.in[IREW] + (size_t)l * D * NE + (q - 4); for (int i = lane; i < D; i += 64) s += hrow[i] * w[(size_t)i * NE]; }
            s = wave_sum(s);
            if (lane == 0) lg[q] = s + (q < 4 ? p.in[IRGB][l * 4 + q] : p.in[IREB][l * NE + q - 4]);
        }
        __syncthreads();
        if (threadIdx.x == 0) {
            int gi = 0; float gm = lg[0];
            for (int q = 1; q < 4; ++q) if (lg[q] > gm) { gm = lg[q]; gi = q; }
            float gs = 0.f; for (int q = 0; q < 4; ++q) gs += expf(lg[q] - gm);
            const float g_top = 1.0f / gs;
            const float* el = lg + 4 + gi * 8;
            int e0 = 0; for (int q = 1; q < 8; ++q) if (el[q] > el[e0]) e0 = q;
            int e1 = (e0 == 0) ? 1 : 0; for (int q = 0; q < 8; ++q) if (q != e0 && el[q] > el[e1]) e1 = q;
            const float p1 = expf(el[e1] - el[e0]);
            const float w0 = g_top / (1.0f + p1), w1 = g_top * p1 / (1.0f + p1);
            const int id0 = gi * 8 + e0, id1 = gi * 8 + e1;
            p.EID[2 * r] = id0; p.EID[2 * r + 1] = id1; p.EWT[2 * r] = w0; p.EWT[2 * r + 1] = w1;
            const int p0 = atomicAdd(&p.ECNT[l * NE + id0], 1); p.ELIST[((size_t)l * NE + id0) * T + p0] = 2 * r;
            const int p1i = atomicAdd(&p.ECNT[l * NE + id1], 1); p.ELIST[((size_t)l * NE + id1) * T + p1i] = 2 * r + 1;
        }
        __syncthreads();
    }
}

__device__ __forceinline__ bool moe_item(const int* cnt, int it, int nN, int& e, int& mt, int& nt) {
    int base = 0;
    for (int q = 0; q < NE; ++q) { const int ntile = ((cnt[q] + 63) / 64) * nN; if (it < base + ntile) { e = q; mt = (it - base) / nN; nt = (it - base) % nN; return true; } base += ntile; }
    return false;
}
__device__ void ph_moe1(const Params& p, int l) {
    __shared__ int cnt[NE];
    const int tx = threadIdx.x & 15, ty = threadIdx.x >> 4;
    if (threadIdx.x < NE) cnt[threadIdx.x] = p.ECNT[l * NE + threadIdx.x];
    __syncthreads();
    const int nN = DE / 64;
    for (int it = blockIdx.x;; it += gridDim.x) {
        int e, mt, nt; if (!moe_item(cnt, it, nN, e, mt, nt)) break;
        const int* list = p.ELIST + ((size_t)l * NE + e) * T;
        const int m0 = mt * 64, n0 = nt * 64, mv = cnt[e];
        float ag[4][4], au[4][4]; ZERO_ACC(ag); ZERO_ACC(au);
        gemm_tile(p.H2, D, list, 1, mv, m0, p.in[IEWG] + ((size_t)l * NE + e) * D * DE, DE, n0, D, ag);
        gemm_tile(p.H2, D, list, 1, mv, m0, p.in[IEWU] + ((size_t)l * NE + e) * D * DE, DE, n0, D, au);
#pragma unroll
        for (int i = 0; i < 4; ++i) {
            const int m = m0 + 4 * ty + i; if (m >= mv) continue;
            const int slot = list[m]; const float wt = p.EWT[slot];
#pragma unroll
            for (int j = 0; j < 4; ++j) p.ACT[(size_t)slot * DE + n0 + 4 * tx + j] = siluf_(ag[i][j]) * au[i][j] * wt;
        }
    }
}
__device__ void ph_moe2(const Params& p, int l) {
    __shared__ int cnt[NE];
    const int tx = threadIdx.x & 15, ty = threadIdx.x >> 4;
    if (threadIdx.x < NE) cnt[threadIdx.x] = p.ECNT[l * NE + threadIdx.x];
    __syncthreads();
    const int nN = D / 64;
    for (int it = blockIdx.x;; it += gridDim.x) {
        int e, mt, nt; if (!moe_item(cnt, it, nN, e, mt, nt)) break;
        const int* list = p.ELIST + ((size_t)l * NE + e) * T;
        const int m0 = mt * 64, n0 = nt * 64, mv = cnt[e];
        float acc[4][4]; ZERO_ACC(acc);
        gemm_tile(p.ACT, DE, list, 0, mv, m0, p.in[IEWD] + ((size_t)l * NE + e) * DE * D, D, n0, DE, acc);
#pragma unroll
        for (int i = 0; i < 4; ++i) {
            const int m = m0 + 4 * ty + i; if (m >= mv) continue;
            const int slot = list[m];
#pragma unroll
            for (int j = 0; j < 4; ++j) p.YS[(size_t)slot * D + n0 + 4 * tx + j] = acc[i][j];
        }
    }
}

enum { PH_COPY = 0, PH_MOD, PH_NORM1, PH_WIN, PH_PREP, PH_SCAN, PH_ATTN, PH_POOLMM, PH_READOUT, PH_MERGE, PH_WOUT, PH_NORM2, PH_MOE1, PH_MOE2, PH_FINAL };
template <int PH> __global__ void __launch_bounds__(NT) k_phase(Params p, int l) {
    const bool need_ctx = (l != DEPTH - 1);
    if (PH == PH_COPY) ph_copy(p);
    if (PH == PH_MOD) ph_mod(p);
    if (PH == PH_NORM1) ph_norm1(p, l, 0);
    if (PH == PH_WIN) ph_win(p, l);
    if (PH == PH_PREP) ph_prep(p, l);
    if (PH == PH_SCAN) ph_scan(p, l);
    if (PH == PH_ATTN) ph_attn(p, l, need_ctx);
    if (PH == PH_POOLMM) ph_poolmm(p, l);
    if (PH == PH_READOUT) ph_readout(p, l);
    if (PH == PH_MERGE) ph_merge(p, l, need_ctx);
    if (PH == PH_WOUT) ph_wout(p, l, need_ctx);
    if (PH == PH_NORM2) ph_norm2(p, l, need_ctx);
    if (PH == PH_MOE1) ph_moe1(p, l);
    if (PH == PH_MOE2) ph_moe2(p, l);
    if (PH == PH_FINAL) ph_norm1(p, 0, 2);
}
}

#ifdef EMU
#define LAUNCH(PH, grid, l) emu::launch([=] { k_phase<PH>(p, l); }, dim3(grid), dim3(NT))
#else
#define LAUNCH(PH, grid, l) hipLaunchKernelGGL(k_phase<PH>, dim3(grid), dim3(NT), 0, stream, p, l)
#endif

extern "C" void kernel_launch(void* const* d_in, const int* in_sizes, int n_in, void* d_out, int out_size, void* d_ws, size_t ws_size, hipStream_t stream) {
    Params p{};
    for (int i = 0; i < N_IN; ++i) p.in[i] = (const float*)d_in[i];
    p.out = (float*)d_out;
    char* w = (char*)d_ws; size_t off = 0;
    auto alloc = [&](size_t bytes) { void* r = w + off; off += (bytes + 255) & ~(size_t)255; return r; };
    p.X = (float*)alloc((size_t)T * D * 4);
    p.MOD = (float*)alloc((size_t)DEPTH * (NB + 1) * 6 * D * 4);
    p.H = (float*)alloc((size_t)T * D * 4);
    p.U = (float*)alloc((size_t)T * IN_DIM * 4);
    p.POOLED = (float*)alloc((size_t)T * PW * 4);
    p.OP = (float*)alloc((size_t)T * PW * 4);
    p.QR = (float*)alloc((size_t)TL * AW * 4);
    p.KR = (float*)alloc((size_t)TL * KVW * 4);
    p.OATT = (float*)alloc((size_t)T * AW * 4);
    p.R_ = (float*)alloc((size_t)T * RW * 4);
    p.V_ = (float*)alloc((size_t)T * RW * 4);
    p.KK_ = (float*)alloc((size_t)T * RW * 4);
    p.G_ = (float*)alloc((size_t)T * RW * 4);
    p.W_ = (float*)alloc((size_t)2 * T * RW * 4);
    p.K_ = (float*)alloc((size_t)2 * T * RW * 4);
    p.B_ = (float*)alloc((size_t)2 * T * RW * 4);
    p.BON = (float*)alloc((size_t)T * RH * 4);
    p.Y = (float*)alloc((size_t)2 * T * RW * 4);
    p.ORW = (float*)alloc((size_t)T * RW * 4);
    p.MB = (float*)alloc((size_t)T * D * 4);
    p.H2 = (float*)alloc((size_t)T * D * 4);
    p.ACT = (float*)alloc((size_t)2 * T * DE * 4);
    p.YS = (float*)alloc((size_t)2 * T * D * 4);
    p.EWT = (float*)alloc((size_t)2 * T * 4);
    p.EID = (int*)alloc((size_t)2 * T * 4);
    p.ECNT = (int*)alloc((size_t)DEPTH * NE * 4);
    p.ELIST = (int*)alloc((size_t)DEPTH * NE * T * 4);
    const int G = 2048;
    LAUNCH(PH_COPY, G, 0);
    LAUNCH(PH_MOD, (DEPTH * 6 * D + NT - 1) / NT, 0);
    for (int l = 0; l < DEPTH; ++l) {
        LAUNCH(PH_NORM1, G, l);
        LAUNCH(PH_WIN, G * 2, l);
        LAUNCH(PH_PREP, G, l);
        LAUNCH(PH_SCAN, (2 * NB * RH + 3) / 4, l);
        LAUNCH(PH_ATTN, G * 4, l);
        LAUNCH(PH_POOLMM, G, l);
        LAUNCH(PH_READOUT, G, l);
        LAUNCH(PH_MERGE, G, l);
        LAUNCH(PH_WOUT, G, l);
        LAUNCH(PH_NORM2, G, l);
        LAUNCH(PH_MOE1, G, l);
        LAUNCH(PH_MOE2, G, l);
    }
    LAUNCH(PH_FINAL, G, 0);
}
```

```cpp
#ifndef EMU
#include <hip/hip_runtime.h>
#endif
#include <stdint.h>
#include <stddef.h>

#ifndef CFG_D
#define CFG_D 2048
#define CFG_B 4
#define CFG_L 2048
#define CFG_C 256
#endif
#ifndef PROBE_MASK
#define PROBE_MASK 0
#endif
#ifdef EMU
#define LAS
#else
#define LAS __attribute__((address_space(3)))
#endif
namespace {
constexpr int D = CFG_D, NB = CFG_B, L = CFG_L, C = CFG_C, DEPTH = 2;
constexpr int TC = NB * C, TL = NB * L, T = TC + TL;
constexpr int PGD = D / 16, PW = 4 * PGD;
constexpr int RH = D / 256, RW = RH * 64, DL = D / 32, IL = D / 32, GL = D / 16, RC = 3 * RW + DL + IL + GL;
constexpr int QH = D / 256, KVH = QH / 4, AW = QH * 128, KVW = KVH * 128;
constexpr int IN_DIM = PW + RC + AW + 2 * KVW + 3 * D;
constexpr int OFF_XA = 0, OFF_RW = PW, OFF_Q = PW + RC, OFF_K = OFF_Q + AW, OFF_V = OFF_K + KVW, OFF_GA = OFF_V + KVW, OFF_GB = OFF_GA + D, OFF_GC = OFF_GB + D;
constexpr int DE = D / 4, NE = 32;
constexpr float NORM_EPS = 1e-6f, GN_EPS = 64e-5f;
constexpr int NT = 512, NW = NT / 64;
constexpr int LDS_BYTES = 147456;
static_assert(T % 256 == 0 && TC % 256 == 0 && IN_DIM % 256 == 0 && D % 256 == 0, "tile shapes");

typedef unsigned short bf16_t;
enum { IX = 0, IC, ICTX, ICCTX, IMODW, IMODB, INORM1, IWIN, IPOOLW, IPOOLS, IMU, IDW0, IDUP, IA0, IAUP, IGUP, IKK, IKA, IRK, ILNG, ILNB, ISINK, IPP, IPR, IPA, IWOUT, INORM2, IRGW, IRGB, IREW, IREB, IEWG, IEWU, IEWD, IFG, N_IN };

struct Params { const float* in[N_IN]; float* out; unsigned char* ws; int sw, pad; };

constexpr size_t A256(size_t x) { return (x + 255) & ~(size_t)255; }
constexpr size_t O_BAR = 0;
constexpr size_t O_ECNT = 16384;
constexpr size_t ZERO_BYTES = O_ECNT + 1024;
constexpr int UW = OFF_GA;
constexpr int KCAT = PW + RW + AW;
constexpr int RPAD = 2 * T + NE * 256;
constexpr size_t MAXS(size_t a, size_t b) { return a > b ? a : b; }
constexpr size_t O_X = ZERO_BYTES;
constexpr size_t O_MOD = O_X + A256((size_t)T * D * 4);
constexpr size_t O_HB = O_MOD + A256((size_t)DEPTH * (NB + 1) * 6 * D * 4);
constexpr size_t O_MBB = O_HB, O_H2B = O_HB;
constexpr size_t O_U = O_HB + A256((size_t)T * D * 2);
constexpr size_t O_POOLED = O_U + A256((size_t)T * UW * 4);
constexpr size_t O_LP = O_POOLED;
constexpr size_t O_WRT = O_LP + A256((size_t)DEPTH * NW * 12 * 4 * 1024);
constexpr int LKS = 12;
constexpr size_t O_QB = O_POOLED + A256((size_t)T * PW * 4);
static_assert(O_WRT + (size_t)DEPTH * (4 + NE) * D * 4 <= O_QB, "LoRA fragments and router table must fit the former pooled buffer");
constexpr size_t O_QRB = O_QB + A256((size_t)T * AW * 2);
constexpr size_t O_KB = O_QRB + A256((size_t)TL * AW * 2);
constexpr size_t O_VB = O_KB + A256((size_t)T * KVW * 2);
constexpr size_t O_KR = O_VB + A256((size_t)T * KVW * 2);
constexpr size_t O_RA = O_KR;
constexpr size_t O_V = O_RA;
constexpr size_t O_G = O_V + A256((size_t)T * RW * 4);
constexpr size_t O_BON = O_G + A256((size_t)T * RW * 4);
constexpr size_t O_Y = O_BON + A256((size_t)T * RH * 4);
constexpr size_t O_PACK = O_Y + A256((size_t)2 * T * RW * 4);
constexpr int REC = 1280;
constexpr size_t PACK_BYTES = (size_t)2 * T * RH * REC;
constexpr size_t O_RA_END1 = O_PACK + A256(PACK_BYTES);
constexpr size_t O_H2G = O_RA;
constexpr size_t O_ACTB = O_H2G + A256((size_t)RPAD * D * 2);
constexpr size_t O_YSB = O_ACTB + A256((size_t)RPAD * DE * 2);
constexpr size_t O_RA_END2 = O_YSB + A256((size_t)2 * T * D * 2);
constexpr size_t O_SG = MAXS(O_RA_END1, O_RA_END2);
constexpr size_t O_OCAT = O_SG + A256((size_t)T * 3 * D * 2);
constexpr size_t O_WTP = O_OCAT + A256((size_t)T * KCAT * 2);
constexpr size_t O_SLOTOF = O_WTP + A256((size_t)RPAD * 4);
constexpr size_t O_POS = O_SLOTOF + A256((size_t)RPAD * 4);
constexpr size_t O_EWT = O_POS + A256((size_t)2 * T * 4);
constexpr size_t O_EID = O_EWT + A256((size_t)2 * T * 4);
constexpr size_t O_ROPE = O_EID + A256((size_t)2 * T * 4);
constexpr size_t O_PWS = O_ROPE + A256((size_t)L * 128 * 4);
constexpr size_t O_WINT = O_PWS + A256((size_t)DEPTH * 4 * PGD * PGD * 4);
constexpr size_t O_WMT = O_WINT + A256((size_t)DEPTH * IN_DIM * D * 2);
constexpr size_t O_WOT = O_WMT + A256((size_t)DEPTH * D * KCAT * 2);
constexpr size_t O_EGU = O_WOT + A256((size_t)DEPTH * D * D * 2);
constexpr size_t O_ED = O_EGU + A256((size_t)DEPTH * NE * 2 * DE * D * 2);
constexpr size_t O_END = O_ED + A256((size_t)DEPTH * NE * D * DE * 2);
#define WSF(off) ((float*)(p.ws + (off)))
#define WSI(off) ((int*)(p.ws + (off)))
#define WSH(off) ((bf16_t*)(p.ws + (off)))

__device__ __forceinline__ float sigmoidf_(float x) { return 1.0f / (1.0f + expf(-x)); }
__device__ __forceinline__ float siluf_(float x) { return x * sigmoidf_(x); }
__device__ __forceinline__ float softplusf_(float x) { return fmaxf(x, 0.0f) + log1pf(expf(-fabsf(x))); }
#ifdef EMU
__device__ __forceinline__ bf16_t f2bf(float f) { unsigned u; __builtin_memcpy(&u, &f, 4); u += 0x7FFFu + ((u >> 16) & 1u); return (bf16_t)(u >> 16); }
__device__ __forceinline__ unsigned cvt_pk_bf16(float lo, float hi) { return (unsigned)f2bf(lo) | ((unsigned)f2bf(hi) << 16); }
#else
typedef float cv_f32x2 __attribute__((ext_vector_type(2)));
typedef __bf16 cv_bf16x2 __attribute__((ext_vector_type(2)));
__device__ __forceinline__ unsigned cvt_pk_bf16(float lo, float hi) { const cv_f32x2 v = {lo, hi}; return __builtin_bit_cast(unsigned, __builtin_convertvector(v, cv_bf16x2)); }
__device__ __forceinline__ bf16_t f2bf(float f) { return (bf16_t)(cvt_pk_bf16(f, 0.f) & 0xffffu); }
#endif
__device__ __forceinline__ float bf2f(bf16_t h) { unsigned u = ((unsigned)h) << 16; float f; __builtin_memcpy(&f, &u, 4); return f; }

__device__ __forceinline__ int ltid(int sw) {
#ifdef EMU
    (void)sw; return threadIdx.x;
#else
    int t;
    asm volatile("v_mbcnt_lo_u32_b32 %0, -1, 0\n\tv_mbcnt_hi_u32_b32 %0, -1, %0" : "=v"(t));
    return t | (sw << 6);
#endif
}
__device__ __forceinline__ void seq_info(int r, int& t, int& len, int& modrow) {
    if (r < TC) { t = r % C; len = C; modrow = NB; }
    else { const int q = r - TC; t = q % L; len = L; modrow = q / L; }
}
__device__ __forceinline__ float lane_xor(float v, int lane, int m) {
#ifdef EMU
    (void)lane; return __shfl_xor(v, m);
#else
    return __builtin_bit_cast(float, __builtin_amdgcn_ds_bpermute((lane ^ m) << 2, __builtin_bit_cast(int, v)));
#endif
}
__device__ __forceinline__ float wave_sum(float v, int lane) {
#pragma unroll
    for (int m = 32; m >= 1; m >>= 1) v += lane_xor(v, lane, m);
    return v;
}
__device__ __forceinline__ float wave_max(float v, int lane) {
#pragma unroll
    for (int m = 32; m >= 1; m >>= 1) v = fmaxf(v, lane_xor(v, lane, m));
    return v;
}
__device__ __forceinline__ float block_sum(float v, float* red, const int TX_) {
    v = wave_sum(v, TX_ & 63);
    __syncthreads();
    if ((TX_ & 63) == 0) red[TX_ >> 6] = v;
    __syncthreads();
    float s = 0.f;
#pragma unroll
    for (int i = 0; i < NW; ++i) s += red[i];
    return s;
}
#define PHASE_FN __device__ __forceinline__
#ifdef EMU
#define WAVE_SYNC() emu::wave_sync()
#define WAVE_FENCE()
#else
#define WAVE_SYNC() asm volatile("" ::: "memory")
#define WAVE_FENCE() asm volatile("" ::: "memory")
#endif
#ifdef EMU
#define ACC_PIN12(a)
#define ACC_PIN6(a)
#else
#define ACC_PIN6(a) asm volatile("" : "+v"((a)[0]), "+v"((a)[1]), "+v"((a)[2]), "+v"((a)[3]), "+v"((a)[4]), "+v"((a)[5]))
#define ACC_PIN12(a) asm volatile("" : "+v"((a)[0]), "+v"((a)[1]), "+v"((a)[2]), "+v"((a)[3]), "+v"((a)[4]), "+v"((a)[5]), "+v"((a)[6]), "+v"((a)[7]), "+v"((a)[8]), "+v"((a)[9]), "+v"((a)[10]), "+v"((a)[11]))
#endif

namespace pg8 {
typedef short bf16x8 __attribute__((ext_vector_type(8)));
typedef float f32x4 __attribute__((ext_vector_type(4)));
typedef unsigned u32x4 __attribute__((ext_vector_type(4)));
typedef unsigned u32x2 __attribute__((ext_vector_type(2)));
constexpr int BM = 256, BK = 64, HALF = 128, HTB = HALF * BK * 2, STAGE_BYTES = 8 * HTB, NXCD = 8, WGM = 8;
__host__ __device__ __forceinline__ int lds_byte(int r, int c) { const int st = (r >> 4) * 2 + (c >> 5), rr = r & 15, cc = c & 31, ob = rr * 64 + cc * 2; return st * 1024 + (ob ^ (((ob >> 9) & 1) << 5)); }
__host__ __device__ __forceinline__ void stage_rc(int b, int& R, int& Cc) { const int st = b / 1024, sb = b % 1024, swz = sb ^ (((sb >> 9) & 1) << 5); R = (st >> 1) * 16 + swz / 64; Cc = (st & 1) * 32 + (swz % 64) / 2; }
__host__ __device__ __forceinline__ int perm32(int rho) { const int n = rho >> 4, i = rho & 15; return 8 * (i >> 2) + 4 * n + (i & 3); }
struct Unit { const char* a; const char* b; int pm, pn; };

#ifdef EMU
#define PG8_GLDS(gp, lp) __builtin_memcpy((unsigned char*)(lp) + (threadIdx.x & 63) * 16, (gp), 16)
#define PG8_WAIT_V(n)
#define PG8_WAIT_L(n)
#define PG8_BAR __syncthreads()
#define PG8_SCHED
#define PG8_PRIO(x)
#define PG8_RFL(x) (x)
#define PG8_MEMFENCE
#define PG8_OPAQUE(x)
#else
#define PG8_GLDS(gp, lp) __builtin_amdgcn_global_load_lds((const unsigned*)(gp), (LAS unsigned*)(lp), 16, 0, 0)
#define PG8_WAIT_V(n) asm volatile("s_waitcnt vmcnt(" #n ")" ::: "memory")
#define PG8_WAIT_L(n) asm volatile("s_waitcnt lgkmcnt(" #n ")" ::: "memory")
#define PG8_BAR __builtin_amdgcn_s_barrier()
#define PG8_SCHED __builtin_amdgcn_sched_barrier(0)
#define PG8_PRIO(x) __builtin_amdgcn_s_setprio(x)
#define PG8_RFL(x) __builtin_amdgcn_readfirstlane(x)
#define PG8_MEMFENCE asm volatile("" ::: "memory")
#define PG8_OPAQUE(x) asm volatile("" : "+v"(x))
#endif

struct DenseOrder {
    static constexpr bool GATHER = false;
    const char* A; const char* Bt; size_t tstepA, tstepB; int nM, nN, nwg, G, c, pm0;
    __device__ void init(const void* A_, int lda, const void* Bt_, int ldb, int pm0_, int nM_, int nN_, int G_, int c_) {
        A = (const char*)A_; Bt = (const char*)Bt_; tstepA = (size_t)BM * lda * 2; tstepB = (size_t)BM * ldb * 2; pm0 = pm0_; nM = nM_; nN = nN_; nwg = nM * nN; G = G_; c = c_; }
    __device__ bool next(int i, Unit& u) const {
        const long Lx = (long)i * G + c; if (Lx >= nwg) return false;
        int wgid = (int)Lx; { const int q = nwg / NXCD, r = nwg % NXCD, xcd = wgid % NXCD, off = wgid / NXCD; wgid = (xcd < r ? xcd * (q + 1) : r * (q + 1) + (xcd - r) * q) + off; }
        const int nig = WGM * nN, gid = wgid / nig, fm = gid * WGM, gsz = (nM - fm) < WGM ? (nM - fm) : WGM;
        u.pm = pm0 + fm + ((wgid % nig) % gsz); u.pn = (wgid % nig) / gsz;
        u.a = A + (size_t)u.pm * tstepA; u.b = Bt + (size_t)u.pn * tstepB; return true;
    }
};

struct WinOrder {
    static constexpr bool GATHER = false;
    DenseOrder lat; const char* A; const char* Bt; size_t tstepA, tstepB; int nlat, nctx, G, c; bool all_ctx;
    __device__ void init(const void* A_, const void* Bt_, int lda, int ldb, int G_, int c_, bool all_ctx_) {
        A = (const char*)A_; Bt = (const char*)Bt_; tstepA = (size_t)BM * lda * 2; tstepB = (size_t)BM * ldb * 2; G = G_; c = c_; all_ctx = all_ctx_;
        lat.init(A_, lda, Bt_, ldb, all_ctx_ ? 0 : TC / BM, all_ctx_ ? T / BM : TL / BM, IN_DIM / BM, G_, c_);
        nlat = lat.nwg; nctx = all_ctx_ ? 0 : (TC / BM) * 7; }
    __device__ bool next(int i, Unit& u) const {
        const long Lx = (long)i * G + c;
        if (Lx < nlat) return lat.next(i, u);
        const int j = (int)(Lx - nlat); if (j >= nctx) return false;
        const int q = j % 7; u.pm = j / 7;
        u.pn = (q < 5) ? (OFF_RW + RW) / BM + q : OFF_K / BM + (q - 5);
        u.a = A + (size_t)u.pm * tstepA; u.b = Bt + (size_t)u.pn * tstepB; return true;
    }
};
template <class Epi, class Sched>
__device__ __forceinline__ void gemm_phase(LAS unsigned char* lds, const int lda, const int ldb, const int K, const Sched& S, const Epi& E, const int TX_) {
    const int tid = TX_, wid = PG8_RFL(tid >> 6), lane = tid & 63, wr = wid >> 2, wc = wid & 3, fr = lane & 15, fq = lane >> 4;
    const int nt = K / BK;
    constexpr bool GA = Sched::GATHER;
    unsigned voffA[2], voffB[2];
    int gaR[2], gaC[2];
#pragma unroll
    for (int i = 0; i < 2; ++i) { int R, Cc; stage_rc(tid * 16 + i * 8192, R, Cc); const int Rb = Epi::PERM ? ((R & ~31) + perm32(R & 31)) : R;
        voffA[i] = (unsigned)(R * lda + Cc) * 2u; voffB[i] = (unsigned)(Rb * ldb + Cc) * 2u; gaR[i] = R; gaC[i] = Cc; }
    unsigned vgc[2][2], vgn[2][2];
#define PG8_GAOFF(dst, pm_) do { if constexpr (GA) { _Pragma("unroll") for (int h_ = 0; h_ < 2; ++h_) _Pragma("unroll") for (int i_ = 0; i_ < 2; ++i_) \
        dst[h_][i_] = (S.src_row((pm_), h_ * HALF + gaR[i_]) * (unsigned)lda + (unsigned)gaC[i_]) * 2u; } } while (0)
#define PG8_STAGE_A(bufoff, gptr, h, nextsel) do { if constexpr (GA) { unsigned vs_[2] = {(nextsel) ? vgn[h][0] : vgc[h][0], (nextsel) ? vgn[h][1] : vgc[h][1]}; PG8_STAGE(bufoff, gptr, vs_); } \
        else { PG8_STAGE(bufoff, (gptr) + (h) * hstepA, voffA); } } while (0)
    const size_t kstep = (size_t)(BK * 2);
    const size_t hstepA = (size_t)HALF * lda * 2, hstepB = (size_t)HALF * ldb * 2;
    const unsigned ldsw = (unsigned)wid * 1024u;
    const int aoff = lds_byte(wr * 64 + fr, fq * 8), boff = lds_byte(wc * 32 + fr, fq * 8);
#define PG8_SA(b, h) (((b) * 2 + (h)) * HTB)
#define PG8_SB(b, h) ((4 + (b) * 2 + (h)) * HTB)
#define PG8_STAGE(bufoff, gbase, voff) do { _Pragma("unroll") for (int _i = 0; _i < 2; ++_i) PG8_GLDS((const char*)(gbase) + (voff)[_i], lds + (bufoff) + ldsw + _i * 8192); } while (0)
#define PG8_LDA(dst, b, h) do { _Pragma("unroll") for (int m = 0; m < 4; ++m) _Pragma("unroll") for (int k = 0; k < 2; ++k) dst[m][k] = *(const LAS bf16x8*)(lds + PG8_SA(b, h) + aoff + m * 2048 + k * 1024); } while (0)
#define PG8_LDB(dst, b, h) do { _Pragma("unroll") for (int n = 0; n < 2; ++n) _Pragma("unroll") for (int k = 0; k < 2; ++k) dst[n][k] = *(const LAS bf16x8*)(lds + PG8_SB(b, h) + boff + n * 2048 + k * 1024); } while (0)
#define PG8_MMA(ai, bj, At, Bt) do { PG8_PRIO(1); _Pragma("unroll") for (int m = 0; m < 4; ++m) _Pragma("unroll") for (int n = 0; n < 2; ++n) _Pragma("unroll") for (int k = 0; k < 2; ++k) \
        acc[ai][bj][m][n] = __builtin_amdgcn_mfma_f32_16x16x32_bf16(Bt[n][k], At[m][k], acc[ai][bj][m][n], 0, 0, 0); PG8_PRIO(0); } while (0)
    Unit cur, nxt; int ui = 0;
    if (!S.next(0, cur)) return;
    f32x4 acc[2][2][4][2];
#pragma unroll
    for (int a = 0; a < 2; ++a)
#pragma unroll
        for (int b = 0; b < 2; ++b)
#pragma unroll
            for (int m = 0; m < 4; ++m)
#pragma unroll
                for (int n = 0; n < 2; ++n) acc[a][b][m][n] = (f32x4){0.f, 0.f, 0.f, 0.f};
    bf16x8 At[4][2], B0[2][2], B1[2][2];
    const char* cA = cur.a; const char* cB = cur.b;
    PG8_GAOFF(vgc, cur.pm);
    PG8_STAGE(PG8_SB(0, 0), cB, voffB); PG8_STAGE_A(PG8_SA(0, 0), cA, 0, false); PG8_STAGE(PG8_SB(0, 1), cB + hstepB, voffB); PG8_STAGE_A(PG8_SA(0, 1), cA, 1, false);
    if (wr == 1) PG8_BAR;
    PG8_WAIT_V(4); PG8_BAR;
    PG8_STAGE(PG8_SB(1, 0), cB + kstep, voffB); PG8_STAGE_A(PG8_SA(1, 0), cA + kstep, 0, false); PG8_STAGE(PG8_SB(1, 1), cB + hstepB + kstep, voffB);
    PG8_WAIT_V(6); PG8_BAR;
    for (;;) {
        const bool has_next = S.next(ui + 1, nxt);
        const char* nA = has_next ? nxt.a : cA; const char* nB = has_next ? nxt.b : cB;
        if (has_next) PG8_GAOFF(vgn, nxt.pm); else { if constexpr (GA) { vgn[0][0] = vgc[0][0]; vgn[0][1] = vgc[0][1]; vgn[1][0] = vgc[1][0]; vgn[1][1] = vgc[1][1]; } }
        int t = 0;
#pragma unroll 1
        for (int seg = 0; seg < Epi::NSEG; ++seg) {
        const int tend = Epi::seg_end(seg, nt);
#pragma unroll 1
        for (; t < tend; t += 2) {
            const bool last = (t == nt - 2);
            const char* a1 = cA + (size_t)(t + 1) * kstep;
            const char* a2 = last ? nA : cA + (size_t)(t + 2) * kstep; const char* b2 = last ? nB : cB + (size_t)(t + 2) * kstep;
            const char* a3 = a2 + kstep; const char* b3 = b2 + kstep;
            PG8_LDB(B0, 0, 0); PG8_SCHED; PG8_LDA(At, 0, 0); PG8_STAGE_A(PG8_SA(1, 1), a1, 1, false);
            PG8_WAIT_L(8); PG8_BAR; PG8_WAIT_L(0); PG8_MMA(0, 0, At, B0); PG8_BAR; PG8_SCHED;
            PG8_LDB(B1, 0, 1); PG8_STAGE(PG8_SB(0, 0), b2, voffB);
            PG8_BAR; PG8_WAIT_L(0); PG8_MMA(0, 1, At, B1); PG8_BAR;
            PG8_LDA(At, 0, 1); PG8_STAGE_A(PG8_SA(0, 0), a2, 0, last);
            PG8_BAR; PG8_WAIT_L(0); PG8_MMA(1, 0, At, B0); PG8_BAR; PG8_SCHED;
            PG8_STAGE(PG8_SB(0, 1), b2 + hstepB, voffB);
            PG8_WAIT_V(6); PG8_BAR; PG8_MMA(1, 1, At, B1); PG8_BAR;
            PG8_LDB(B0, 1, 0); PG8_SCHED; PG8_LDA(At, 1, 0); PG8_STAGE_A(PG8_SA(0, 1), a2, 1, last);
            PG8_WAIT_L(8); PG8_BAR; PG8_WAIT_L(0); PG8_MMA(0, 0, At, B0); PG8_BAR; PG8_SCHED;
            PG8_LDB(B1, 1, 1); PG8_STAGE(PG8_SB(1, 0), b3, voffB);
            PG8_BAR; PG8_WAIT_L(0); PG8_MMA(0, 1, At, B1); PG8_BAR;
            PG8_LDA(At, 1, 1); PG8_STAGE_A(PG8_SA(1, 0), a3, 0, last);
            PG8_BAR; PG8_WAIT_L(0); PG8_MMA(1, 0, At, B0); PG8_BAR; PG8_SCHED;
            PG8_STAGE(PG8_SB(1, 1), b3 + hstepB, voffB);
            PG8_WAIT_V(6); PG8_BAR; PG8_MMA(1, 1, At, B1); PG8_BAR;
        }
        if constexpr (Epi::NSEG > 1) { if (seg + 1 < Epi::NSEG) E.mid(acc, cur, seg, wr, wc, fr, fq); }
        }
        E(acc, cur, wr, wc, fr, fq);
        if (!has_next) break;
#pragma unroll
        for (int a = 0; a < 2; ++a)
#pragma unroll
            for (int b = 0; b < 2; ++b)
#pragma unroll
                for (int m = 0; m < 4; ++m)
#pragma unroll
                    for (int n = 0; n < 2; ++n) acc[a][b][m][n] = (f32x4){0.f, 0.f, 0.f, 0.f};
        cur = nxt; cA = nA; cB = nB; ++ui;
        if constexpr (GA) { vgc[0][0] = vgn[0][0]; vgc[0][1] = vgn[0][1]; vgc[1][0] = vgn[1][0]; vgc[1][1] = vgn[1][1]; }
    }
    PG8_WAIT_V(0);
    if (wr == 0) PG8_BAR;
    PG8_BAR;
#undef PG8_SA
#undef PG8_SB
#undef PG8_STAGE
#undef PG8_STAGE_A
#undef PG8_GAOFF
#undef PG8_LDA
#undef PG8_LDB
#undef PG8_MMA
}

__device__ __forceinline__ unsigned pk_bf16(float lo, float hi) { return cvt_pk_bf16(lo, hi); }
__device__ __forceinline__ float frcp(float x) {
#ifdef EMU
    return 1.0f / x;
#else
    return __builtin_amdgcn_rcpf(x);
#endif
}
__device__ __forceinline__ float fsig(float x) { return frcp(1.0f + __expf(-x)); }

__device__ __forceinline__ float lane_swap1(float v) {
#ifdef EMU
    return __shfl_xor(v, 1);
#else
    return __builtin_bit_cast(float, __builtin_amdgcn_update_dpp(0, __builtin_bit_cast(int, v), 0xB1, 0xf, 0xf, false));
#endif
}
__device__ __forceinline__ f32x4 lane_swap1(f32x4 v) { const float a = v[0], b = v[1], c = v[2], d = v[3]; f32x4 r; r[0] = lane_swap1(a); r[1] = lane_swap1(b); r[2] = lane_swap1(c); r[3] = lane_swap1(d); return r; }
__device__ __forceinline__ void pair_rows(const f32x4& A, const f32x4& B, bool odd, f32x4& S1, f32x4& S2) {
    const f32x4 X = lane_swap1(A), Y = lane_swap1(B);
    S1 = odd ? Y : A; S2 = odd ? B : X;
}
struct EpiWin {
    static constexpr bool PERM = true; static constexpr int NSEG = 1;
    static __device__ __forceinline__ int seg_end(int, int nt) { return nt; }
    float* U; bf16_t* SG;
    __device__ __forceinline__ void operator()(const f32x4 (&acc)[2][2][4][2], const Unit& u, int wr, int wc, int fr_in, int fq_in) const {
        int fr = fr_in, fq = fq_in; PG8_OPAQUE(fr); PG8_OPAQUE(fq);
        const int row0 = u.pm * BM + wr * 64 + fr, col0 = u.pn * BM + wc * 32 + 8 * fq;
        if (u.pn * BM >= OFF_GA) {
#pragma unroll
            for (int ai = 0; ai < 2; ++ai)
#pragma unroll
                for (int m = 0; m < 4; ++m) { bf16_t* rowp = SG + (size_t)(row0 + ai * HALF + m * 16) * (3 * D) + (col0 - OFF_GA);
#pragma unroll
                    for (int bj = 0; bj < 2; ++bj) { const f32x4 v0 = acc[ai][bj][m][0], v1 = acc[ai][bj][m][1]; u32x4 o;
                        o[0] = pk_bf16(fsig(v0[0]), fsig(v0[1])); o[1] = pk_bf16(fsig(v0[2]), fsig(v0[3])); o[2] = pk_bf16(fsig(v1[0]), fsig(v1[1])); o[3] = pk_bf16(fsig(v1[2]), fsig(v1[3]));
                        *(u32x4*)(rowp + bj * HALF) = o; } }
        } else {
            const bool odd = fr & 1;
#pragma unroll
            for (int ai = 0; ai < 2; ++ai)
#pragma unroll
                for (int m = 0; m < 4; ++m) { float* pe = U + (size_t)((row0 + ai * HALF + m * 16) & ~1) * UW + col0 + (odd ? 4 : 0);
#pragma unroll
                    for (int bj = 0; bj < 2; ++bj) { f32x4 S1, S2; pair_rows(acc[ai][bj][m][0], acc[ai][bj][m][1], odd, S1, S2);
                        *(f32x4*)(pe + bj * HALF) = S1; *(f32x4*)(pe + UW + bj * HALF) = S2; } }
        }
    }
};
struct EpiMerge {
    static constexpr bool PERM = true; static constexpr int NSEG = 3;
    static __device__ __forceinline__ int seg_end(int seg, int nt) { return seg == 0 ? PW / BK : (seg == 1 ? (PW + RW) / BK : nt); }
    const bf16_t* SG; bf16_t* O;
    __device__ __forceinline__ void mid(f32x4 (&acc)[2][2][4][2], const Unit& u, int which, int wr, int wc, int fr_in, int fq_in) const {
        int fr = fr_in, fq = fq_in; PG8_OPAQUE(fr); PG8_OPAQUE(fq);
        const int row0 = u.pm * BM + wr * 64 + fr, col0 = u.pn * BM + wc * 32 + 8 * fq;
#pragma unroll
        for (int ai = 0; ai < 2; ++ai)
#pragma unroll
            for (int m = 0; m < 4; ++m) { const bf16_t* rowp = SG + (size_t)(row0 + ai * HALF + m * 16) * (3 * D) + which * D + col0;
#pragma unroll
                for (int bj = 0; bj < 2; ++bj) {
                    const uint4 nu = *(const uint4*)(rowp + bj * HALF), de = *(const uint4*)(rowp + D + bj * HALF);
                    const unsigned nw[4] = {nu.x, nu.y, nu.z, nu.w}, dw[4] = {de.x, de.y, de.z, de.w};
#pragma unroll
                    for (int q = 0; q < 4; ++q) {
                        const float n0 = bf2f((bf16_t)(nw[q] & 0xffffu)), n1 = bf2f((bf16_t)(nw[q] >> 16)), d0 = bf2f((bf16_t)(dw[q] & 0xffffu)), d1 = bf2f((bf16_t)(dw[q] >> 16));
                        acc[ai][bj][m][q >> 1][2 * (q & 1)] *= n0 * frcp(d0); acc[ai][bj][m][q >> 1][2 * (q & 1) + 1] *= n1 * frcp(d1); } }
                PG8_MEMFENCE; }
    }
    __device__ __forceinline__ void operator()(const f32x4 (&acc)[2][2][4][2], const Unit& u, int wr, int wc, int fr_in, int fq_in) const {
        int fr = fr_in, fq = fq_in; PG8_OPAQUE(fr); PG8_OPAQUE(fq);
        const int row0 = u.pm * BM + wr * 64 + fr, col0 = u.pn * BM + wc * 32 + 8 * fq;
#pragma unroll
        for (int ai = 0; ai < 2; ++ai)
#pragma unroll
            for (int m = 0; m < 4; ++m) { const size_t ro = (size_t)(row0 + ai * HALF + m * 16);
#pragma unroll
                for (int bj = 0; bj < 2; ++bj) {
                    const uint4 sc = *(const uint4*)(SG + ro * (3 * D) + 2 * D + col0 + bj * HALF);
                    const unsigned sw[4] = {sc.x, sc.y, sc.z, sc.w}; unsigned ow[4];
#pragma unroll
                    for (int q = 0; q < 4; ++q) { const float s0 = bf2f((bf16_t)(sw[q] & 0xffffu)), s1 = bf2f((bf16_t)(sw[q] >> 16));
                        ow[q] = pk_bf16(acc[ai][bj][m][q >> 1][2 * (q & 1)] * s0, acc[ai][bj][m][q >> 1][2 * (q & 1) + 1] * s1); }
                    *(uint4*)(O + ro * D + col0 + bj * HALF) = make_uint4(ow[0], ow[1], ow[2], ow[3]); }
                PG8_MEMFENCE; }
    }
};
struct EpiWout {
    static constexpr bool PERM = false; static constexpr int NSEG = 1;
    static __device__ __forceinline__ int seg_end(int, int nt) { return nt; }
    float* X; const float* MODL; const float* inC; const float* inX;
    __device__ __forceinline__ void operator()(const f32x4 (&acc)[2][2][4][2], const Unit& u, int wr, int wc, int fr_in, int fq_in) const {
        int fr = fr_in, fq = fq_in; PG8_OPAQUE(fr); PG8_OPAQUE(fq);
        const int row0 = u.pm * BM + wr * 64 + fr, col0 = u.pn * BM + wc * 32 + 4 * fq;
        const int mr = (u.pm < TC / BM) ? NB : (u.pm - TC / BM) / (L / BM);
        const float* g1 = MODL + (size_t)mr * 6 * D + 2 * D + col0;
        f32x4 gv[2][2];
#pragma unroll
        for (int bj = 0; bj < 2; ++bj)
#pragma unroll
            for (int n = 0; n < 2; ++n) gv[bj][n] = *(const f32x4*)(g1 + bj * HALF + n * 16);
#pragma unroll
        for (int ai = 0; ai < 2; ++ai)
#pragma unroll
            for (int m = 0; m < 4; ++m) { const int row = row0 + ai * HALF + m * 16; float* rowp = X + (size_t)row * D + col0;
                const float* srcp = inX ? ((u.pm < TC / BM) ? inC + (size_t)row * D + col0 : inX + (size_t)(row - TC) * D + col0) : rowp;
#pragma unroll
                for (int bj = 0; bj < 2; ++bj)
#pragma unroll
                    for (int n = 0; n < 2; ++n) { *(f32x4*)(rowp + bj * HALF + n * 16) = *(const f32x4*)(srcp + bj * HALF + n * 16) + gv[bj][n] * acc[ai][bj][m][n]; } }
    }
};
struct EpiSwiglu {
    static constexpr bool PERM = true; static constexpr int NSEG = 1;
    static __device__ __forceinline__ int seg_end(int, int nt) { return nt; }
    bf16_t* ACT; const float* WTP;
    __device__ __forceinline__ void operator()(const f32x4 (&acc)[2][2][4][2], const Unit& u, int wr, int wc, int fr_in, int fq_in) const {
        int fr = fr_in, fq = fq_in; PG8_OPAQUE(fr); PG8_OPAQUE(fq);
        const int row0 = u.pm * BM + wr * 64 + fr, col0 = u.pn * HALF + wc * 32 + 8 * fq;
#pragma unroll
        for (int ai = 0; ai < 2; ++ai)
#pragma unroll
            for (int m = 0; m < 4; ++m) { const size_t ro = (size_t)(row0 + ai * HALF + m * 16); const float wt = WTP[ro]; unsigned ow[4];
#pragma unroll
                for (int q = 0; q < 4; ++q) { const int n = q >> 1, j = 2 * (q & 1);
                    const float g0 = acc[ai][0][m][n][j], g1 = acc[ai][0][m][n][j + 1], u0 = acc[ai][1][m][n][j], u1 = acc[ai][1][m][n][j + 1];
                    ow[q] = pk_bf16(g0 * fsig(g0) * u0 * wt, g1 * fsig(g1) * u1 * wt); }
                *(uint4*)(ACT + ro * DE + col0) = make_uint4(ow[0], ow[1], ow[2], ow[3]); PG8_MEMFENCE; }
    }
};
struct EpiDown {
    static constexpr bool PERM = true; static constexpr int NSEG = 1;
    static __device__ __forceinline__ int seg_end(int, int nt) { return nt; }
    bf16_t* YSB; const int* SLOTOF;
    __device__ __forceinline__ void operator()(const f32x4 (&acc)[2][2][4][2], const Unit& u, int wr, int wc, int fr_in, int fq_in) const {
        int fr = fr_in, fq = fq_in; PG8_OPAQUE(fr); PG8_OPAQUE(fq);
        const int row0 = u.pm * BM + wr * 64 + fr, col0 = u.pn * BM + wc * 32 + 8 * fq;
#pragma unroll
        for (int ai = 0; ai < 2; ++ai)
#pragma unroll
            for (int m = 0; m < 4; ++m) { const int slot = SLOTOF[row0 + ai * HALF + m * 16];
                if (slot >= 0) {
#pragma unroll
                    for (int bj = 0; bj < 2; ++bj) { unsigned ow[4];
#pragma unroll
                        for (int q = 0; q < 4; ++q) ow[q] = pk_bf16(acc[ai][bj][m][q >> 1][2 * (q & 1)], acc[ai][bj][m][q >> 1][2 * (q & 1) + 1]);
                        *(uint4*)(YSB + (size_t)slot * D + col0 + bj * HALF) = make_uint4(ow[0], ow[1], ow[2], ow[3]); } }
                PG8_MEMFENCE; }
    }
};
struct MoeOrder {
    static constexpr bool GATHER = false;
    const char* A; const char* Bt; size_t tstepA, estepB, tstepB; int nN, G, c; const LAS int* toff;
    __device__ bool next(int i, Unit& u) const {
        const int Lx = i * G + c; const int total = toff[NE] * nN; if (Lx >= total) return false;
        const int rt = Lx / nN, pn = Lx % nN; int e = 0;
        for (int q = 1; q < NE; ++q) e = (rt >= toff[q]) ? q : e;
        u.pm = rt; u.pn = pn; u.a = A + (size_t)rt * tstepA; u.b = Bt + (size_t)e * estepB + (size_t)pn * tstepB; return true;
    }
};
struct MoeGatherOrder {
    static constexpr bool GATHER = true;
    const char* A; const char* Bt; size_t estepB, tstepB; int nN, G, c; const LAS int* toff; const int* slotof;
    __device__ bool next(int i, Unit& u) const {
        const int Lx = i * G + c; const int total = toff[NE] * nN; if (Lx >= total) return false;
        const int rt = Lx / nN, pn = Lx % nN; int e = 0;
        for (int q = 1; q < NE; ++q) e = (rt >= toff[q]) ? q : e;
        u.pm = rt; u.pn = pn; u.a = A; u.b = Bt + (size_t)e * estepB + (size_t)pn * tstepB; return true;
    }
    __device__ __forceinline__ unsigned src_row(int pm, int r) const { const int sl = slotof[pm * BM + r]; return (unsigned)(sl < 0 ? 0 : (sl >> 1)); }
};
}

__device__ __forceinline__ void conv_tile(const float* src, int ld_src, bf16_t* dst, int ld_dst, int kt, float* lds, const int TX_) {
    const int tid = TX_;
    float* tb = lds;
    __syncthreads();
#pragma unroll
    for (int i = 0; i < 4; ++i) {
        const int idx = tid + i * NT, kr = idx >> 4, c4 = (idx & 15) * 4;
        const float4 v = *(const float4*)(src + (size_t)(kt * 128 + kr) * ld_src + c4);
        tb[kr * 65 + c4] = v.x; tb[kr * 65 + c4 + 1] = v.y; tb[kr * 65 + c4 + 2] = v.z; tb[kr * 65 + c4 + 3] = v.w;
    }
    __syncthreads();
    const int n = tid >> 3, kq = (tid & 7) * 16;
    unsigned w[8];
#pragma unroll
    for (int j = 0; j < 8; ++j) { const unsigned lo = f2bf(tb[(kq + 2 * j) * 65 + n]), hi = f2bf(tb[(kq + 2 * j + 1) * 65 + n]); w[j] = lo | (hi << 16); }
    uint4* dp = (uint4*)(dst + (size_t)n * ld_dst + kt * 128 + kq);
    dp[0] = make_uint4(w[0], w[1], w[2], w[3]); dp[1] = make_uint4(w[4], w[5], w[6], w[7]);
}
PHASE_FN void ph_conv_win0(const Params& p, float* lds) {
    const int TX_ = ltid(p.sw);
    const float* src = p.in[IWIN]; bf16_t* dst = WSH(O_WINT);
    for (int it = blockIdx.x; it < (D / 128) * (IN_DIM / 64); it += gridDim.x) { const int kt = it % (D / 128), nt = it / (D / 128); conv_tile(src + nt * 64, IN_DIM, dst + (size_t)nt * 64 * D, D, kt, lds, TX_); }
    __syncthreads();
}
PHASE_FN void ph_conv_layer(const Params& p, int l, float* lds, bool with_win) {
    const int TX_ = ltid(p.sw);
    const int G = gridDim.x; int base = 0;
#define CONV_JOB(NTILES, ...) { const int start_ = ((int)blockIdx.x - base % G + G) % G; for (int it = start_; it < (NTILES); it += G) { __VA_ARGS__ } base += (NTILES); }
    if (with_win) {
        const float* src = p.in[IWIN] + (size_t)l * D * IN_DIM; bf16_t* dst = WSH(O_WINT) + (size_t)l * IN_DIM * D;
        CONV_JOB((D / 128) * (IN_DIM / 64), { const int kt = it % (D / 128), nt = it / (D / 128); conv_tile(src + nt * 64, IN_DIM, dst + (size_t)nt * 64 * D, D, kt, lds, TX_); })
    }
    {
        bf16_t* dst = WSH(O_WMT) + (size_t)l * D * KCAT;
        const float* s0 = p.in[IPP] + (size_t)l * PW * D; const float* s1 = p.in[IPR] + (size_t)l * RW * D; const float* s2 = p.in[IPA] + (size_t)l * AW * D;
        CONV_JOB((PW / 128) * (D / 64), { const int kt = it % (PW / 128), nt = it / (PW / 128); conv_tile(s0 + nt * 64, D, dst + (size_t)nt * 64 * KCAT, KCAT, kt, lds, TX_); })
        CONV_JOB((RW / 128) * (D / 64), { const int kt = it % (RW / 128), nt = it / (RW / 128); conv_tile(s1 + nt * 64, D, dst + (size_t)nt * 64 * KCAT + PW, KCAT, kt, lds, TX_); })
        CONV_JOB((AW / 128) * (D / 64), { const int kt = it % (AW / 128), nt = it / (AW / 128); conv_tile(s2 + nt * 64, D, dst + (size_t)nt * 64 * KCAT + PW + RW, KCAT, kt, lds, TX_); })
    }
    {
        const float* src = p.in[IWOUT] + (size_t)l * D * D; bf16_t* dst = WSH(O_WOT) + (size_t)l * D * D;
        CONV_JOB((D / 128) * (D / 64), { const int kt = it % (D / 128), nt = it / (D / 128); conv_tile(src + nt * 64, D, dst + (size_t)nt * 64 * D, D, kt, lds, TX_); })
    }
    {
        constexpr int TPE = (D / 128) * (DE / 64);
        CONV_JOB(NE * 2 * TPE, { const int e = it / (2 * TPE), rem = it % (2 * TPE), which = rem / TPE, r2 = rem % TPE, kt = r2 % (D / 128), nt = r2 / (D / 128);
            const float* src = p.in[which ? IEWU : IEWG] + ((size_t)l * NE + e) * D * DE + nt * 64;
            const int drow = (nt >> 1) * 256 + which * 128 + (nt & 1) * 64;
            conv_tile(src, DE, WSH(O_EGU) + (((size_t)l * NE + e) * 2 * DE + drow) * D, D, kt, lds, TX_); })
    }
    {
        constexpr int TPE = (DE / 128) * (D / 64);
        CONV_JOB(NE * TPE, { const int e = it / TPE, r2 = it % TPE, kt = r2 % (DE / 128), nt = r2 / (DE / 128);
            conv_tile(p.in[IEWD] + ((size_t)l * NE + e) * DE * D + nt * 64, D, WSH(O_ED) + (((size_t)l * NE + e) * D + nt * 64) * DE, DE, kt, lds, TX_); })
    }
#undef CONV_JOB
    __syncthreads();
}

PHASE_FN void ph_copy(const Params& p) {
    const int TX_ = ltid(p.sw);
    const int gt = blockIdx.x * NT + TX_, gs = gridDim.x * NT;
    float4* X4 = (float4*)WSF(O_X);
    const float4* c4 = (const float4*)p.in[ICTX]; const float4* x4 = (const float4*)p.in[IX];
    for (long i = gt; i < (long)T * D / 4; i += gs) X4[i] = (i < (long)TC * D / 4) ? c4[i] : x4[i - (long)TC * D / 4];
}
PHASE_FN void ph_rope_table(const Params& p) {
    const int TX_ = ltid(p.sw);
    const int gt = blockIdx.x * NT + TX_, gs = gridDim.x * NT;
    for (int i = gt; i < L * 64; i += gs) {
        const int t = i >> 6, j = i & 63, ax = j >> 5, f = j & 31;
        const float inv = powf(10000.0f, -(float)(2 * f) / 64.0f);
        const float ang = (ax == 0 ? (float)(t / 64) : (float)(t % 64)) * inv;
        WSF(O_ROPE)[(size_t)t * 128 + j] = cosf(ang); WSF(O_ROPE)[(size_t)t * 128 + 64 + j] = sinf(ang);
    }
}
PHASE_FN void ph_pws(const Params& p) {
    const int TX_ = ltid(p.sw);
    for (int i = blockIdx.x * NT + TX_; i < DEPTH * 4 * PGD * PGD; i += gridDim.x * NT) {
        const int d = i % PGD, g = (i / (PGD * PGD)) % 4, l = i / (4 * PGD * PGD);
        WSF(O_PWS)[i] = p.in[IPOOLW][i] * p.in[IPOOLS][l * PW + g * PGD + d];
    }
}
PHASE_FN void ph_lora_pack(const Params& p) {
    const int TX_ = ltid(p.sw);
    const float* pgu = p.in[IGUP]; const float* pdu = p.in[IDUP]; const float* pau = p.in[IAUP];
#ifndef EMU
    asm volatile("" : "+s"(pgu), "+s"(pdu), "+s"(pau));
#endif
    for (int i = blockIdx.x * NT + TX_; i < DEPTH * NW * LKS * 4 * 64; i += gridDim.x * NT) {
        const int lane = i & 63, nt = (i >> 6) & 3, ks = (i >> 8) % LKS, w = (i / (256 * LKS)) % NW, l = i / (256 * LKS * NW);
        const int ch = w * 64 + (lane & 15) * 4 + nt;
        const float* src; int k0;
        if (ks < 4) { src = pgu + (size_t)l * GL * RW; k0 = ks * 32; }
        else if (ks < 8) { src = pdu + (size_t)(l * 2 + ((ks - 4) >> 1)) * DL * RW; k0 = ((ks - 4) & 1) * 32; }
        else { src = pau + (size_t)(l * 2 + ((ks - 8) >> 1)) * IL * RW; k0 = ((ks - 8) & 1) * 32; }
        k0 += (lane >> 4) * 8;
        const float* q = src + (size_t)k0 * RW + ch;
        const float x0 = q[0], x1 = q[RW], x2 = q[2 * RW], x3 = q[3 * RW], x4 = q[4 * RW], x5 = q[5 * RW], x6 = q[6 * RW], x7 = q[7 * RW];
        const bf16_t h0 = f2bf(x0), h1 = f2bf(x1), h2 = f2bf(x2), h3 = f2bf(x3), h4 = f2bf(x4), h5 = f2bf(x5), h6 = f2bf(x6), h7 = f2bf(x7);
        uint4 hi;
        hi.x = (unsigned)h0 | ((unsigned)h1 << 16); hi.y = (unsigned)h2 | ((unsigned)h3 << 16); hi.z = (unsigned)h4 | ((unsigned)h5 << 16); hi.w = (unsigned)h6 | ((unsigned)h7 << 16);
        ((uint4*)(p.ws + O_LP + (size_t)(i >> 6) * 1024))[lane] = hi;
    }
}
PHASE_FN void ph_router_pack(const Params& p) {
    const int TX_ = ltid(p.sw);
    for (int i = blockIdx.x * NT + TX_; i < DEPTH * (4 + NE) * D; i += gridDim.x * NT) {
        const int k = i % D, q = (i / D) % (4 + NE), l = i / (D * (4 + NE));
        WSF(O_WRT)[i] = (q < 4) ? p.in[IRGW][((size_t)l * D + k) * 4 + q] : p.in[IREW][((size_t)l * D + k) * NE + (q - 4)];
    }
}
PHASE_FN void ph_mod(const Params& p, float* lds) {
    const int TX_ = ltid(p.sw);
    float* sl = lds;
    float* red = lds + (NB + 1) * D;
    const int tid = TX_, kg = tid >> 3, cq = tid & 7;
    const int nitems = DEPTH * 6 * D / 32;
    if ((int)blockIdx.x < nitems) {
        for (int i = tid; i < (NB + 1) * D; i += NT) sl[i] = siluf_(i < NB * D ? p.in[IC][i] : p.in[ICCTX][i - NB * D]);
        __syncthreads();
        for (int it = blockIdx.x; it < nitems; it += gridDim.x) {
            const int l = it / (6 * D / 32), n0 = (it % (6 * D / 32)) * 32;
            float acc[NB + 1][4];
#pragma unroll
            for (int j = 0; j <= NB; ++j)
#pragma unroll
                for (int q = 0; q < 4; ++q) acc[j][q] = 0.f;
            const float* w = p.in[IMODW] + (size_t)l * D * 6 * D + n0 + cq * 4;
#pragma unroll 1
            for (int k0 = kg; k0 < D; k0 += 64 * 8) {
                float4 wv[8];
#pragma unroll
                for (int u = 0; u < 8; ++u) wv[u] = *(const float4*)(w + (size_t)(k0 + 64 * u) * 6 * D);
#pragma unroll
                for (int u = 0; u < 8; ++u)
#pragma unroll
                    for (int j = 0; j <= NB; ++j) { const float sv = sl[j * D + k0 + 64 * u]; acc[j][0] += sv * wv[u].x; acc[j][1] += sv * wv[u].y; acc[j][2] += sv * wv[u].z; acc[j][3] += sv * wv[u].w; }
            }
            __syncthreads();
#pragma unroll
            for (int j = 0; j <= NB; ++j)
#pragma unroll
                for (int q = 0; q < 4; ++q) red[(kg * (NB + 1) + j) * 32 + cq * 4 + q] = acc[j][q];
            __syncthreads();
            if (tid < (NB + 1) * 32) {
                const int j = tid / 32, cc = tid % 32;
                float sum = 0.f;
                for (int g = 0; g < 64; ++g) sum += red[(g * (NB + 1) + j) * 32 + cc];
                WSF(O_MOD)[((size_t)l * (NB + 1) + j) * 6 * D + n0 + cc] = sum + p.in[IMODB][l * 6 * D + n0 + cc];
            }
        }
    }
    __syncthreads();
}
PHASE_FN void ph_norm1(const Params& p, int l, int mode, bool dry = false) {
    const int TX_ = ltid(p.sw);
    const int wave = TX_ >> 6, lane = TX_ & 63;
    const int r_begin = (mode == 2) ? TC : 0;
    const int lp = (mode == 2) ? DEPTH - 1 : l - 1;
    for (int r = r_begin + blockIdx.x * NW + wave; r < T; r += gridDim.x * NW) {
        int t, len, mr; seq_info(r, t, len, mr);
        float* xr = WSF(O_X) + (size_t)r * D;
        const float* xsrc = (mode == 0 && l == 0) ? ((r < TC) ? p.in[ICTX] + (size_t)r * D : p.in[IX] + (size_t)(r - TC) * D) : xr;
        const bool comb = (lp >= 0) && (lp != DEPTH - 1 || r >= TC);
        float4 v[D / 256];
        float ss = 0.f;
#pragma unroll
        for (int i = 0; i < D / 256; ++i) {
            const int c = (i * 64 + lane) * 4;
            float4 x = *(const float4*)(xsrc + c);
            if (comb) {
                const float4 g2 = *(const float4*)(WSF(O_MOD) + ((size_t)lp * (NB + 1) + mr) * 6 * D + 5 * D + c);
                const uint2 y0 = *(const uint2*)(WSH(O_YSB) + (size_t)(2 * r) * D + c), y1 = *(const uint2*)(WSH(O_YSB) + (size_t)(2 * r + 1) * D + c);
                x.x += g2.x * (bf2f((bf16_t)(y0.x & 0xffffu)) + bf2f((bf16_t)(y1.x & 0xffffu))); x.y += g2.y * (bf2f((bf16_t)(y0.x >> 16)) + bf2f((bf16_t)(y1.x >> 16)));
                x.z += g2.z * (bf2f((bf16_t)(y0.y & 0xffffu)) + bf2f((bf16_t)(y1.y & 0xffffu))); x.w += g2.w * (bf2f((bf16_t)(y0.y >> 16)) + bf2f((bf16_t)(y1.y >> 16)));
                if (!dry) *(float4*)(xr + c) = x;
            }
            v[i] = x; ss += x.x * x.x + x.y * x.y + x.z * x.z + x.w * x.w;
        }
        ss = wave_sum(ss, lane);
        const float rs = rsqrtf(ss / (float)D + NORM_EPS);
#pragma unroll
        for (int i = 0; i < D / 256; ++i) {
            const int c = (i * 64 + lane) * 4;
            if (mode == 2) {
                const float4 g = *(const float4*)(p.in[IFG] + c);
                *(float4*)(p.out + (size_t)(r - TC) * D + c) = make_float4(v[i].x * rs * g.x, v[i].y * rs * g.y, v[i].z * rs * g.z, v[i].w * rs * g.w);
            } else {
                const float* md = WSF(O_MOD) + ((size_t)l * (NB + 1) + mr) * 6 * D;
                const float4 g = *(const float4*)(p.in[INORM1] + l * D + c), sh = *(const float4*)(md + c), sc = *(const float4*)(md + D + c);
                const float h0 = (v[i].x * rs * g.x) * (1.0f + sc.x) + sh.x, h1 = (v[i].y * rs * g.y) * (1.0f + sc.y) + sh.y;
                const float h2 = (v[i].z * rs * g.z) * (1.0f + sc.z) + sh.z, h3 = (v[i].w * rs * g.w) * (1.0f + sc.w) + sh.w;
                uint2 o; o.x = (unsigned)f2bf(h0) | ((unsigned)f2bf(h1) << 16); o.y = (unsigned)f2bf(h2) | ((unsigned)f2bf(h3) << 16);
                *(uint2*)(WSH(O_HB) + (size_t)r * D + c) = o;
            }
        }
    }
}

constexpr int GT_M = NT / 4;
__device__ __forceinline__ void gemm_tile(const float* A, int lda, const int* aidx, int ashift, int mvalid, int m0, const float* B, int ldb, int n0, int K, float (&acc)[4][4], float* lds, const int TX_) {
    float* As = lds;
    float* Bs = lds + 16 * (GT_M + 4);
    const int tid = TX_, tx = tid & 15, ty = tid >> 4;
    const int ar = tid >> 2, ak = (tid & 3) * 4;
    const int bk = (tid & 255) >> 4, bn = (tid & 15) * 4;
    const bool avalid = (m0 + ar) < mvalid;
    long arow = 0;
    if (avalid) arow = aidx ? (long)(aidx[m0 + ar] >> ashift) : (long)(m0 + ar);
    const float* ap = A + arow * lda + ak;
    const float* bp = B + (size_t)bk * ldb + n0 + bn;
    for (int k0 = 0; k0 < K; k0 += 16) {
        float a0 = 0.f, a1 = 0.f, a2 = 0.f, a3 = 0.f;
        if (avalid) { a0 = ap[k0]; a1 = ap[k0 + 1]; a2 = ap[k0 + 2]; a3 = ap[k0 + 3]; }
        float b0 = 0.f, b1 = 0.f, b2 = 0.f, b3 = 0.f;
        if (tid < 256) { const float* bq = bp + (size_t)k0 * ldb; b0 = bq[0]; b1 = bq[1]; b2 = bq[2]; b3 = bq[3]; }
        __syncthreads();
        As[ak * (GT_M + 4) + ar] = a0; As[(ak + 1) * (GT_M + 4) + ar] = a1; As[(ak + 2) * (GT_M + 4) + ar] = a2; As[(ak + 3) * (GT_M + 4) + ar] = a3;
        if (tid < 256) { Bs[bk * 68 + bn] = b0; Bs[bk * 68 + bn + 1] = b1; Bs[bk * 68 + bn + 2] = b2; Bs[bk * 68 + bn + 3] = b3; }
        __syncthreads();
#pragma unroll
        for (int k = 0; k < 16; ++k) {
            float a[4], b[4];
#pragma unroll
            for (int i = 0; i < 4; ++i) { a[i] = As[k * (GT_M + 4) + 4 * ty + i]; b[i] = Bs[k * 68 + 4 * tx + i]; }
#pragma unroll
            for (int i = 0; i < 4; ++i)
#pragma unroll
                for (int j = 0; j < 4; ++j) acc[i][j] += a[i] * b[j];
        }
    }
    __syncthreads();
}
#define ZERO_ACC(a) { _Pragma("unroll") for (int i_ = 0; i_ < 4; ++i_) _Pragma("unroll") for (int j_ = 0; j_ < 4; ++j_) a[i_][j_] = 0.f; }

PHASE_FN void ph_fold(const Params& p, int l, float* lds) {
    const int TX_ = ltid(p.sw);
    const int tx = TX_ & 15, ty = TX_ >> 4;
    static_assert(PGD == GT_M, "fold tile");
    for (int it = blockIdx.x; it < 4 * (D / 64); it += gridDim.x) {
        const int g = it / (D / 64), n0 = (it % (D / 64)) * 64;
        float acc[4][4]; ZERO_ACC(acc);
        gemm_tile(WSF(O_PWS) + ((size_t)l * 4 + g) * PGD * PGD, PGD, nullptr, 0, PGD, 0, p.in[IPP] + ((size_t)l * PW + g * PGD) * D, D, n0, PGD, acc, lds, TX_);
#pragma unroll
        for (int i = 0; i < 4; ++i)
#pragma unroll
            for (int j = 0; j < 4; ++j) WSH(O_WMT)[(size_t)l * D * KCAT + (size_t)(n0 + 4 * tx + j) * KCAT + g * PGD + 4 * ty + i] = f2bf(acc[i][j]);
    }
}
PHASE_FN void ph_win(const Params& p, int l, LAS unsigned char* lds) {
    static_assert((OFF_RW + RW) % 256 == 0 && (OFF_RW + RC) % 256 == 0 && OFF_K % 256 == 0 && KVW == 256, "column tiles of the context-only subset");
    pg8::WinOrder S; S.init(WSH(O_HB), WSH(O_WINT) + (size_t)l * IN_DIM * D, D, D, gridDim.x, blockIdx.x, l != DEPTH - 1);
    pg8::EpiWin E{WSF(O_U), WSH(O_SG)};
    pg8::gemm_phase<pg8::EpiWin, pg8::WinOrder>(lds, D, D, D, S, E, ltid(p.sw));
}

__device__ __forceinline__ float dpp_sum16(float v);
#ifdef EMU
__device__ __forceinline__ float wave_total63(float v) { for (int m = 32; m >= 1; m >>= 1) v += __shfl_xor(v, m); return v; }
__device__ __forceinline__ float wave_bcast63(float v) { return __shfl(v, 63); }
#else
template <int CTRL, int RMASK> __device__ __forceinline__ float dpp_mov_rm(float v) { return __builtin_bit_cast(float, __builtin_amdgcn_update_dpp(0, __builtin_bit_cast(int, v), CTRL, RMASK, 0xf, false)); }
__device__ __forceinline__ float wave_total63(float v) {
    v = dpp_sum16(v); v += dpp_mov_rm<0x142, 0xa>(v); v += dpp_mov_rm<0x143, 0xc>(v); return v;
}
__device__ __forceinline__ float wave_bcast63(float v) { return __builtin_bit_cast(float, __builtin_amdgcn_readlane(__builtin_bit_cast(int, v), 63)); }
#endif
#ifdef EMU
struct BufRsrc { const char* p; };
__device__ __forceinline__ BufRsrc make_rsrc(const void* p, size_t) { return BufRsrc{(const char*)p}; }
__device__ __forceinline__ float buf_load4(BufRsrc r, int voff, int soff) { return *(const float*)(r.p + voff + soff); }
__device__ __forceinline__ pg8::bf16x8 buf_load16(BufRsrc r, int voff, int soff) { return *(const pg8::bf16x8*)(r.p + voff + soff); }
#else
typedef __amdgpu_buffer_rsrc_t BufRsrc;
__device__ __forceinline__ BufRsrc make_rsrc(const void* p, size_t bytes) { return __builtin_amdgcn_make_buffer_rsrc((void*)p, 0, (int)bytes, 0x00020000); }
__device__ __forceinline__ float buf_load4(BufRsrc r, int voff, int soff) { return __builtin_bit_cast(float, __builtin_amdgcn_raw_buffer_load_b32(r, voff, soff, 0)); }
__device__ __forceinline__ pg8::bf16x8 buf_load16(BufRsrc r, int voff, int soff) { return __builtin_bit_cast(pg8::bf16x8, __builtin_amdgcn_raw_buffer_load_b128(r, voff, soff, 0)); }
#endif
constexpr int PR = 9;
constexpr int LAS_A = 264;
static_assert(DL == 64 && IL == 64 && GL == 128 && RC == 3 * RW + 256, "LoRA geometry");
static_assert(RW == NT, "prep geometry");
PHASE_FN void ph_prep(const Params& p, int l, float* lds) {
    const int TX_ = ltid(p.sw);
    float* us = lds;
    bf16_t* Ahi = (bf16_t*)(us + PR * RC);
    bf16_t* Alo = Ahi + 16 * LAS_A;
    const int tid0 = TX_;
    for (int i = tid0; i < 16 * LAS_A; i += NT) { Ahi[i] = 0; Alo[i] = 0; }
    const float* U = WSF(O_U);
    const float* mu = p.in[IMU] + l * RC;
    for (int grp = blockIdx.x; grp < (T + PR - 1) / PR; grp += gridDim.x) {
        const int r0 = grp * PR, nr = min(PR, T - r0);
        int tid = tid0; PG8_OPAQUE(tid);
        const int lane = tid & 63;
        __syncthreads();
#if PROBE_MASK & 0x10000000
        for (int rep1_ = 0; rep1_ < 2; ++rep1_) {
        PG8_OPAQUE(rep1_);
#endif
        {
            const int ch = tid, gi = ch / PGD, hw = 1 << gi;
            float xv[PR + 16];
#pragma unroll
            for (int q = 0; q < PR + 16; ++q) { const int row = r0 - 8 + q; xv[q] = (row >= 0 && row < T) ? U[(size_t)row * UW + OFF_XA + ch] : 0.f; }
#pragma unroll
            for (int rr = 0; rr < PR; ++rr) if (rr < nr) {
                const int r = r0 + rr; int t, len, mr; seq_info(r, t, len, mr);
                float sacc = 0.f;
#pragma unroll
                for (int dq = -8; dq < 8; ++dq) { const int tt = t + dq; const bool ok = dq >= -hw && dq < hw && tt >= 0 && tt < len; sacc += ok ? xv[8 + rr + dq] : 0.f; }
                const int lo = max(t - hw, 0), hi = min(t + hw, len);
                WSH(O_OCAT)[(size_t)r * KCAT + ch] = f2bf(sacc * pg8::frcp((float)(hi - lo)) - xv[8 + rr]);
            }
        }
        WAVE_FENCE();
        for (int q = tid; q < PR * (QH + KVH) * 8; q += NT) {
            const int fo = q & 3, ax = (q >> 2) & 1, hh = (q >> 3) % (QH + KVH), rr = q / (8 * (QH + KVH)), e1 = ax * 64 + fo * 8;
            const int soff = (hh < QH) ? (OFF_Q + hh * 128) : (OFF_K + (hh - QH) * 128);
            if (rr < nr) {
                const int r = r0 + rr; int t, len, mr; seq_info(r, t, len, mr); const bool lat = r >= TC;
                const float* src = U + (size_t)r * UW + soff + e1;
                const pg8::f32x4 xa0 = *(const pg8::f32x4*)src, xa1 = *(const pg8::f32x4*)(src + 4), xb0 = *(const pg8::f32x4*)(src + 32), xb1 = *(const pg8::f32x4*)(src + 36);
                const float* rt = WSF(O_ROPE) + (size_t)(lat ? t : 0) * 128 + ax * 32 + fo * 8;
                const pg8::f32x4 c0 = *(const pg8::f32x4*)rt, c1 = *(const pg8::f32x4*)(rt + 4), s0 = *(const pg8::f32x4*)(rt + 64), s1 = *(const pg8::f32x4*)(rt + 68);
                pg8::f32x4 ya0 = xa0, ya1 = xa1, yb0 = xb0, yb1 = xb1;
                if (lat) { ya0 = xa0 * c0 - xb0 * s0; ya1 = xa1 * c1 - xb1 * s1; yb0 = xa0 * s0 + xb0 * c0; yb1 = xa1 * s1 + xb1 * c1; }
#define PK8(lo_, hi_) pg8::u32x4{pg8::pk_bf16((lo_)[0], (lo_)[1]), pg8::pk_bf16((lo_)[2], (lo_)[3]), pg8::pk_bf16((hi_)[0], (hi_)[1]), pg8::pk_bf16((hi_)[2], (hi_)[3])}
                if (hh < QH) {
                    bf16_t* qu = WSH(O_QB) + (size_t)r * AW + hh * 128 + e1; *(pg8::u32x4*)qu = PK8(xa0, xa1); *(pg8::u32x4*)(qu + 32) = PK8(xb0, xb1);
                    if (lat) { bf16_t* qr = WSH(O_QRB) + (size_t)(r - TC) * AW + hh * 128 + e1; *(pg8::u32x4*)qr = PK8(ya0, ya1); *(pg8::u32x4*)(qr + 32) = PK8(yb0, yb1); }
                } else {
                    bf16_t* kd = WSH(O_KB) + (size_t)r * KVW + (hh - QH) * 128 + e1; *(pg8::u32x4*)kd = PK8(ya0, ya1); *(pg8::u32x4*)(kd + 32) = PK8(yb0, yb1);
                }
#undef PK8
            }
        }
        WAVE_FENCE();
#pragma unroll 2
        for (int i = tid; i < nr * (KVW / 4); i += NT) {
            const int rr = i / (KVW / 4), c4 = (i % (KVW / 4)) * 4, r = r0 + rr;
            const float4 v = *(const float4*)(U + (size_t)r * UW + OFF_V + c4);
            uint2 o; o.x = pg8::pk_bf16(v.x, v.y); o.y = pg8::pk_bf16(v.z, v.w);
            *(uint2*)(WSH(O_VB) + (size_t)r * KVW + c4) = o;
        }
        WAVE_FENCE();
        if (tid < RC / 4) {
            const int c4 = tid * 4;
            float4 uv[PR + 2];
#pragma unroll
            for (int q = 0; q < PR + 2; ++q) { const int row = r0 - 1 + q; uv[q] = (row >= 0 && row < T) ? *(const float4*)(U + (size_t)row * UW + OFF_RW + c4) : make_float4(0.f, 0.f, 0.f, 0.f); }
            const float4 m4 = *(const float4*)(mu + c4);
#pragma unroll
            for (int rr = 0; rr < PR; ++rr) if (rr < nr) {
                const int r = r0 + rr; int t, len, mr; seq_info(r, t, len, mr);
                const float4 u0 = uv[rr + 1];
                const float4 up = (t > 0) ? uv[rr] : make_float4(0.f, 0.f, 0.f, 0.f), un = (t < len - 1) ? uv[rr + 2] : make_float4(0.f, 0.f, 0.f, 0.f);
                float* d = us + rr * RC + c4;
                d[0] = u0.x + m4.x * (0.5f * (up.x + un.x) - u0.x); d[1] = u0.y + m4.y * (0.5f * (up.y + un.y) - u0.y);
                d[2] = u0.z + m4.z * (0.5f * (up.z + un.z) - u0.z); d[3] = u0.w + m4.w * (0.5f * (up.w + un.w) - u0.w);
            }
        }
#if PROBE_MASK & 0x10000000
        }
#endif
        __syncthreads();
        for (int i = tid; i < PR * 256; i += NT) {
            const int rr = i >> 8, j = i & 255;
            const float v = (rr < nr) ? us[rr * RC + 3 * RW + j] : 0.f;
            const float tv = (j < DL) ? 1.0f - 2.0f * pg8::frcp(1.0f + __expf(2.0f * v)) : ((j < DL + IL) ? v : pg8::fsig(v));
            const bf16_t h = f2bf(tv);
            const int ar = 4 * (rr / 3) + rr % 3;
            Ahi[ar * LAS_A + j] = h; Alo[ar * LAS_A + j] = f2bf(tv - bf2f(h));
        }
        __syncthreads();
#ifdef EMU
        const int hd = tid >> 6;
#else
        const int hd = p.sw;
#endif
        const int mrow = lane & 15, kg = lane >> 4;
        pg8::f32x4 aG[4], aW0[4], aW1[4], aA0[4], aA1[4];
#pragma unroll
        for (int nt = 0; nt < 4; ++nt) {
            const int chn = hd * 64 + 4 * mrow + nt;
            const float w00 = p.in[IDW0][(l * 2 + 0) * RW + chn], w01 = p.in[IDW0][(l * 2 + 1) * RW + chn], a00 = p.in[IA0][(l * 2 + 0) * RW + chn], a01 = p.in[IA0][(l * 2 + 1) * RW + chn];
            aG[nt] = pg8::f32x4{0.f, 0.f, 0.f, 0.f}; aW0[nt] = pg8::f32x4{w00, w00, w00, w00}; aW1[nt] = pg8::f32x4{w01, w01, w01, w01};
            aA0[nt] = pg8::f32x4{a00, a00, a00, a00}; aA1[nt] = pg8::f32x4{a01, a01, a01, a01};
        }
        {
            const BufRsrc rlp = make_rsrc(p.ws + O_LP + (size_t)(l * NW + hd) * LKS * 4 * 1024, (size_t)LKS * 4 * 1024);
            const int vo = lane * 16;
            const bf16_t* arow_h = Ahi + mrow * LAS_A + kg * 8; const bf16_t* arow_l = Alo + mrow * LAS_A + kg * 8;
            pg8::bf16x8 bh[2][4];
#pragma unroll
            for (int nt = 0; nt < 4; ++nt) bh[0][nt] = buf_load16(rlp, vo, nt * 1024);
#pragma unroll
            for (int ks = 0; ks < LKS; ++ks) {
                const int cur = ks & 1, nxt = cur ^ 1;
                if (ks + 1 < LKS) {
#pragma unroll
                    for (int nt = 0; nt < 4; ++nt) bh[nxt][nt] = buf_load16(rlp, vo, ((ks + 1) * 4 + nt) * 1024);
                }
                const int kb = (ks < 4) ? 128 + 32 * ks : ((ks < 8) ? 32 * ((ks - 4) & 1) : 64 + 32 * ((ks - 8) & 1));
                const pg8::bf16x8 ah = *(const pg8::bf16x8*)(arow_h + kb), al = *(const pg8::bf16x8*)(arow_l + kb);
#pragma unroll
                for (int nt = 0; nt < 4; ++nt) {
                    pg8::f32x4& acc = (ks < 4) ? aG[nt] : ((ks < 6) ? aW0[nt] : ((ks < 8) ? aW1[nt] : ((ks < 10) ? aA0[nt] : aA1[nt])));
                    acc = __builtin_amdgcn_mfma_f32_16x16x32_bf16(ah, bh[cur][nt], acc, 0, 0, 0);
                    acc = __builtin_amdgcn_mfma_f32_16x16x32_bf16(al, bh[cur][nt], acc, 0, 0, 0);
                }
                WAVE_FENCE();
            }
        }
        float ssq[3] = {0.f, 0.f, 0.f}, bsm[3] = {0.f, 0.f, 0.f};
#pragma unroll
        for (int nt = 0; nt < 4; ++nt) {
            const int chn = hd * 64 + 4 * mrow + nt;
            const float kkc = p.in[IKK][l * RW + chn], kac = p.in[IKA][l * RW + chn], rkc = p.in[IRK][l * RW + chn];
#pragma unroll
            for (int i = 0; i < 3; ++i) {
                const int rr = kg * 3 + i;
                const float rv = us[rr * RC + chn], kv = us[rr * RC + RW + chn];
                aW0[nt][i] = __expf(-0.6065306597f * pg8::frcp(1.0f + __expf(-aW0[nt][i]))); aW1[nt][i] = __expf(-0.6065306597f * pg8::frcp(1.0f + __expf(-aW1[nt][i])));
                const float a0 = pg8::fsig(aA0[nt][i]), a1 = pg8::fsig(aA1[nt][i]);
                aA0[nt][i] = a0; aA1[nt][i] = a1;
                const float key0 = kv * (1.0f + (a0 - 1.0f) * kac), key1 = kv * (1.0f + (a1 - 1.0f) * kac);
                const float kkr = kv * kkc;
                ssq[i] += kkr * kkr; bsm[i] += rv * (key0 + key1) * rkc;
            }
        }
#pragma unroll
        for (int i = 0; i < 3; ++i) { ssq[i] = dpp_sum16(ssq[i]); bsm[i] = dpp_sum16(bsm[i]); }
        const int ch4 = hd * 64 + 4 * mrow;
        const pg8::f32x4 kkc4 = *(const pg8::f32x4*)(p.in[IKK] + l * RW + ch4), kac4 = *(const pg8::f32x4*)(p.in[IKA] + l * RW + ch4);
#pragma unroll
        for (int i = 0; i < 3; ++i) {
            const int rr = kg * 3 + i;
            if (kg < 3 && rr < nr) {
                const int r = r0 + rr;
                const float inv = pg8::frcp(fmaxf(sqrtf(ssq[i]), 1e-12f));
                const pg8::f32x4 rv = *(const pg8::f32x4*)(us + rr * RC + ch4), kv = *(const pg8::f32x4*)(us + rr * RC + RW + ch4), vv = *(const pg8::f32x4*)(us + rr * RC + 2 * RW + ch4);
                pg8::f32x4 w0, w1, a0, a1, gg;
#pragma unroll
                for (int nt = 0; nt < 4; ++nt) { w0[nt] = aW0[nt][i]; w1[nt] = aW1[nt][i]; a0[nt] = aA0[nt][i]; a1[nt] = aA1[nt][i]; gg[nt] = aG[nt][i]; }
                const pg8::f32x4 key0 = kv * (1.0f + (a0 - 1.0f) * kac4), key1 = kv * (1.0f + (a1 - 1.0f) * kac4), kn = kv * kkc4 * inv;
                pg8::u32x2 rb, vb; rb[0] = pg8::pk_bf16(rv[0], rv[1]); rb[1] = pg8::pk_bf16(rv[2], rv[3]); vb[0] = pg8::pk_bf16(vv[0], vv[1]); vb[1] = pg8::pk_bf16(vv[2], vv[3]);
                unsigned char* pk0 = p.ws + O_PACK + (((size_t)0 * T + r) * RH + hd) * REC + 16 * mrow;
                unsigned char* pk1 = p.ws + O_PACK + (((size_t)1 * T + r) * RH + hd) * REC + 16 * mrow;
                *(pg8::f32x4*)pk0 = w0; *(pg8::f32x4*)(pk0 + 256) = key0; *(pg8::f32x4*)(pk0 + 512) = kn * a0; *(pg8::f32x4*)(pk0 + 768) = kn;
                *(pg8::u32x2*)(pk0 + 1024 - 8 * mrow) = rb; *(pg8::u32x2*)(pk0 + 1152 - 8 * mrow) = vb;
                *(pg8::f32x4*)pk1 = w1; *(pg8::f32x4*)(pk1 + 256) = key1; *(pg8::f32x4*)(pk1 + 512) = kn * a1; *(pg8::f32x4*)(pk1 + 768) = kn;
                *(pg8::u32x2*)(pk1 + 1024 - 8 * mrow) = rb; *(pg8::u32x2*)(pk1 + 1152 - 8 * mrow) = vb;
                *(pg8::f32x4*)(WSF(O_V) + (size_t)r * RW + ch4) = vv;
                *(pg8::f32x4*)(WSF(O_G) + (size_t)r * RW + ch4) = gg;
                if (mrow == 0) WSF(O_BON)[(size_t)r * RH + hd] = 0.5f * bsm[i];
            }
            WAVE_FENCE();
        }
    }
    __syncthreads();
}

constexpr int SCAN_RING = 16, SCAN_SLOT = REC;
static_assert((C + L) % SCAN_RING == 0 && C % SCAN_RING == 0 && SCAN_RING == 16, "scan ring depth");
#ifdef EMU
__device__ __forceinline__ float dpp_sum16(float v) { v += __shfl_xor(v, 1); v += __shfl_xor(v, 2); v += __shfl_xor(v, 4); v += __shfl_xor(v, 8); return v; }
static thread_local unsigned char* emu_m0[16];
__device__ __forceinline__ void scan_set_m0(unsigned char* slot) { emu_m0[threadIdx.x >> 6] = slot; }
__device__ __forceinline__ void scan_dma2(int q, BufRsrc rs, int voff, int voffb, int soff_adj) {
    __builtin_memcpy(emu_m0[threadIdx.x >> 6] + q * 1280 + voff, rs.p + soff_adj + q * 1280 + voff, 16);
    __builtin_memcpy(emu_m0[threadIdx.x >> 6] + q * 1280 + 1024 + voffb, rs.p + soff_adj + q * 1280 + 1024 + voffb, 4);
}
#define SCAN_WAIT(n) emu::wave_sync()
#define SCAN_SGPR_SETTLE(rs_, so_) ((void)0)
__device__ __forceinline__ float row_push(float keep, float v, int kq) { const float up = __shfl(keep, (int)(threadIdx.x & 63) - 1); return kq ? up : v; }
__device__ __forceinline__ void scan_store(float* q, float v) { *q = v; }
#else
template <int CTRL> __device__ __forceinline__ float dpp_mov(float v) { return __builtin_bit_cast(float, __builtin_amdgcn_update_dpp(0, __builtin_bit_cast(int, v), CTRL, 0xf, 0xf, false)); }
__device__ __forceinline__ float dpp_sum16(float v) {
    v += dpp_mov<0xB1>(v); v += dpp_mov<0x4E>(v); v += dpp_mov<0x141>(v); v += dpp_mov<0x140>(v); return v;
}
__device__ __forceinline__ void scan_set_m0(LAS unsigned char* slot) { const unsigned dst = (unsigned)(uintptr_t)slot; asm volatile("s_mov_b32 m0, %0\n\ts_nop 0" :: "s"(dst) : "memory", "m0"); }
__device__ __forceinline__ void scan_dma2(int q, BufRsrc rs, int voff, int voffb, int soff_adj) {
    if (q == 0) asm volatile("buffer_load_dwordx4 %0, %2, %3 offen lds\n\tbuffer_load_dword %1, %2, %3 offen offset:1024 lds" :: "v"(voff), "v"(voffb), "s"(rs), "s"(soff_adj) : "memory");
    else if (q == 1) asm volatile("buffer_load_dwordx4 %0, %2, %3 offen offset:1280 lds\n\tbuffer_load_dword %1, %2, %3 offen offset:2304 lds" :: "v"(voff), "v"(voffb), "s"(rs), "s"(soff_adj) : "memory");
    else asm volatile("buffer_load_dwordx4 %0, %2, %3 offen offset:2560 lds\n\tbuffer_load_dword %1, %2, %3 offen offset:3584 lds" :: "v"(voff), "v"(voffb), "s"(rs), "s"(soff_adj) : "memory");
}
#define SCAN_WAIT(n) asm volatile("s_waitcnt vmcnt(" #n ")" ::: "memory")
#define SCAN_SGPR_SETTLE(rs_, so_) asm volatile("s_nop 4" :: "s"(rs_), "s"(so_) : "memory")
__device__ __forceinline__ float row_push(float keep, float v, int) {
    return __builtin_bit_cast(float, __builtin_amdgcn_update_dpp(__builtin_bit_cast(int, v), __builtin_bit_cast(int, keep), 0x111, 0xf, 0xf, false));
}
__device__ __forceinline__ void scan_store(float* q, float v) { asm volatile("global_store_dword %0, %1, off" :: "v"(q), "v"(v) : "memory"); }
#endif
__device__ __forceinline__ int scan_row(int s, int d, int b) {
    const int in_ctx = s < C;
    const int len = in_ctx ? C : L, base = in_ctx ? b * C : TC + b * L, t = in_ctx ? s : s - C;
    return base + (d == 0 ? t : len - 1 - t);
}
typedef float sc_f2 __attribute__((ext_vector_type(2)));
__device__ __forceinline__ sc_f2 sc_fma2(sc_f2 a, sc_f2 b, sc_f2 c) {
#ifdef EMU
    return sc_f2{a[0] * b[0] + c[0], a[1] * b[1] + c[1]};
#else
    return __builtin_elementwise_fma(a, b, c);
#endif
}
struct ScanOps { pg8::f32x4 w, k, b, kk, r; float v; };
__device__ __forceinline__ pg8::f32x4 bf4_to_f32(pg8::u32x2 q) {
    pg8::f32x4 o; o[0] = __builtin_bit_cast(float, q[0] << 16); o[1] = __builtin_bit_cast(float, q[0] & 0xffff0000u); o[2] = __builtin_bit_cast(float, q[1] << 16); o[3] = __builtin_bit_cast(float, q[1] & 0xffff0000u); return o;
}
__device__ __forceinline__ ScanOps scan_read(const LAS unsigned char* slot, int kq, int vrow) {
    ScanOps o;
    o.w = *(const LAS pg8::f32x4*)(slot + kq * 16); o.k = *(const LAS pg8::f32x4*)(slot + 256 + kq * 16); o.b = *(const LAS pg8::f32x4*)(slot + 512 + kq * 16); o.kk = *(const LAS pg8::f32x4*)(slot + 768 + kq * 16);
    o.r = bf4_to_f32(*(const LAS pg8::u32x2*)(slot + 1024 + kq * 8));
    o.v = bf2f(*(const LAS bf16_t*)(slot + 1152 + vrow * 2)); return o;
}
struct ConvTile { const float* src; bf16_t* dst; int ld_src, ld_dst; };
__device__ __forceinline__ int conv_total(int l) {
    return (KCAT / 64) * (D / 64) + (D / 64) * (D / 64) + NE * 2 * (D / 64) * (DE / 64) + NE * (DE / 64) * (D / 64) + ((l + 1 < DEPTH) ? (D / 64) * (IN_DIM / 64) : 0);
}
__device__ __forceinline__ ConvTile conv_tile_of(const Params& p, int l, int it) {
    ConvTile c;
    const float* ppp = p.in[IPP]; const float* ppr = p.in[IPR]; const float* ppa = p.in[IPA]; const float* pwg = p.in[IEWG]; const float* pwu = p.in[IEWU];
#ifndef EMU
    asm volatile("" : "+s"(ppp), "+s"(ppr), "+s"(ppa), "+s"(pwg), "+s"(pwu));
#endif
    constexpr int N0 = (PW / 64) * (D / 64), N1 = N0 + (RW / 64) * (D / 64), N2 = N1 + (AW / 64) * (D / 64), N3 = N2 + (D / 64) * (D / 64);
    constexpr int TPE1 = (D / 64) * (DE / 64), N4 = N3 + NE * 2 * TPE1, TPE2 = (DE / 64) * (D / 64), N5 = N4 + NE * TPE2;
    if (it < N2) {
        const int j = it < N0 ? it : (it < N1 ? it - N0 : it - N1);
        const int nk = it < N0 ? PW / 64 : (it < N1 ? RW / 64 : AW / 64), koff = it < N0 ? 0 : (it < N1 ? PW : PW + RW);
        const float* sb = it < N0 ? ppp + (size_t)l * PW * D : (it < N1 ? ppr + (size_t)l * RW * D : ppa + (size_t)l * AW * D);
        const int kt = j % nk, nt = j / nk;
        c.src = sb + (size_t)kt * 64 * D + nt * 64; c.ld_src = D; c.dst = WSH(O_WMT) + (size_t)l * D * KCAT + (size_t)nt * 64 * KCAT + koff + kt * 64; c.ld_dst = KCAT;
    } else if (it < N3) {
        const int j = it - N2, kt = j % (D / 64), nt = j / (D / 64);
        c.src = p.in[IWOUT] + (size_t)l * D * D + (size_t)kt * 64 * D + nt * 64; c.ld_src = D; c.dst = WSH(O_WOT) + (size_t)l * D * D + (size_t)nt * 64 * D + kt * 64; c.ld_dst = D;
    } else if (it < N4) {
        const int j = it - N3, e = j / (2 * TPE1), rem = j % (2 * TPE1), which = rem / TPE1, r2 = rem % TPE1, kt = r2 % (D / 64), nt = r2 / (D / 64);
        c.src = (which ? pwu : pwg) + ((size_t)l * NE + e) * D * DE + (size_t)kt * 64 * DE + nt * 64; c.ld_src = DE;
        const int drow = (nt >> 1) * 256 + which * 128 + (nt & 1) * 64;
        c.dst = WSH(O_EGU) + (((size_t)l * NE + e) * 2 * DE + drow) * D + kt * 64; c.ld_dst = D;
    } else if (it < N5) {
        const int j = it - N4, e = j / TPE2, r2 = j % TPE2, kt = r2 % (DE / 64), nt = r2 / (DE / 64);
        c.src = p.in[IEWD] + ((size_t)l * NE + e) * DE * D + (size_t)kt * 64 * D + nt * 64; c.ld_src = D; c.dst = WSH(O_ED) + (((size_t)l * NE + e) * D + nt * 64) * DE + kt * 64; c.ld_dst = DE;
    } else {
        const int j = it - N5, kt = j % (D / 64), nt = j / (D / 64);
        c.src = p.in[IWIN] + (size_t)(l + 1) * D * IN_DIM + (size_t)kt * 64 * IN_DIM + nt * 64; c.ld_src = IN_DIM; c.dst = WSH(O_WINT) + (size_t)(l + 1) * IN_DIM * D + (size_t)nt * 64 * D + kt * 64; c.ld_dst = D;
    }
    return c;
}
__device__ __forceinline__ void conv_load(const ConvTile& c, int lane, float (&v)[64]) {
    const BufRsrc rs = make_rsrc(c.src, (size_t)64 * c.ld_src * 4);
#pragma unroll
    for (int k = 0; k < 64; ++k) v[k] = buf_load4(rs, lane * 4, k * c.ld_src * 4);
}
__device__ __forceinline__ void conv_emit(const ConvTile& c, int lane, const float (&v)[64]) {
#ifdef EMU
    bf16_t* q = c.dst + (size_t)lane * c.ld_dst;
#pragma unroll
    for (int j = 0; j < 8; ++j)
        *(uint4*)(q + 8 * j) = make_uint4(pg8::pk_bf16(v[8 * j], v[8 * j + 1]), pg8::pk_bf16(v[8 * j + 2], v[8 * j + 3]), pg8::pk_bf16(v[8 * j + 4], v[8 * j + 5]), pg8::pk_bf16(v[8 * j + 6], v[8 * j + 7]));
#else
    const BufRsrc rd = make_rsrc(c.dst, (size_t)64 * c.ld_dst * 2);
    const int vo = lane * c.ld_dst * 2;
#pragma unroll
    for (int j = 0; j < 8; ++j) {
        pg8::u32x4 w; w[0] = pg8::pk_bf16(v[8 * j], v[8 * j + 1]); w[1] = pg8::pk_bf16(v[8 * j + 2], v[8 * j + 3]); w[2] = pg8::pk_bf16(v[8 * j + 4], v[8 * j + 5]); w[3] = pg8::pk_bf16(v[8 * j + 6], v[8 * j + 7]);
        __builtin_amdgcn_raw_buffer_store_b128(w, rd, vo + 16 * j, 0, 0);
    }
#endif
}
__device__ __forceinline__ void conv_role(const Params& p, int l, int cw, int ncw, int lane) {
    constexpr int NFOLD = (PW / 64) * (D / 64);
    const int total = conv_total(l);
    cw += NFOLD;
    while (cw >= NFOLD + ncw) cw -= ncw;
    if (cw >= total) return;
    float va[64], vb[64];
    ConvTile ca = conv_tile_of(p, l, cw);
    conv_load(ca, lane, va);
#pragma unroll 1
    for (int it = cw; it < total; it += ncw) {
        const int nx = it + ncw;
        const ConvTile cb = conv_tile_of(p, l, nx < total ? nx : it);
        conv_load(cb, lane, vb);
        conv_emit(ca, lane, va);
        ca = cb;
#pragma unroll
        for (int i = 0; i < 64; ++i) va[i] = vb[i];
    }
}
PHASE_FN void ph_scan(const Params& p, int l, LAS unsigned char* lds) {
    (void)l;
    const int TX_ = ltid(p.sw);
#ifdef EMU
    const int wave = TX_ >> 6;
#else
    const int wave = p.sw;
#endif
    const int lane = TX_ & 63, g = lane >> 4, kq = lane & 15;
    constexpr int NS = C + L, nitems = 2 * NB * RH * 16;
    const BufRsrc rs = make_rsrc((const unsigned char*)WSF(O_PACK) - 4096, PACK_BYTES + 4096);
    if (wave < 4) {
        LAS unsigned char* ring = lds + wave * (SCAN_RING * SCAN_SLOT);
        const bool xcd_deal = (gridDim.x % 8 == 0) && (nitems % (8 * 16) == 0) && (gridDim.x * 4 == nitems);
#if PROBE_MASK & 0x200000
        for (int rep_ = 0; rep_ < 2; ++rep_)
#endif
        for (int it0 = wave * gridDim.x + blockIdx.x; it0 < nitems; it0 += 4 * gridDim.x) {
            int item = it0;
            if (xcd_deal) { const int x = blockIdx.x % 8, slot = (blockIdx.x / 8) * 4 + wave;
                item = (x + 8 * (slot >> 4)) * 16 + (slot & 15); }
            const int chain = item >> 4, rg = item & 15;
            const int d = chain / (NB * RH), b = (chain / RH) % NB, h = chain % RH;
            const int vrow = rg * 4 + g;
            const int dstep = (d == 0 ? 1 : -1) * RH * REC;
#define SCAN_SOFF(s) ((int)((((size_t)d * T + scan_row((s), d, b)) * RH + h) * REC))
            const int voff = lane * 16;
            const int dstepA = dstep - SCAN_SLOT, dstepB = dstep + 2 * SCAN_SLOT;
            const int voffb = lane * 4;
            {
                int so = SCAN_SOFF(0) + 4096;
                SCAN_SGPR_SETTLE(rs, so);
#pragma unroll
                for (int j = 0; j < SCAN_RING; ++j) { if (j % 3 == 0) scan_set_m0(ring + j * SCAN_SLOT); scan_dma2(j % 3, rs, voff, voffb, so); so += ((j + 1) % 3) ? dstepA : dstepB; }
            }
            float S0 = 0.f, S1 = 0.f, S2 = 0.f, S3 = 0.f;
            float* Yb = WSF(O_Y) + (size_t)d * T * RW + h * 64 + vrow;
            SCAN_WAIT(30);
            ScanOps cur = scan_read(ring, kq, vrow);
            float yprev = 0.f, ykA = 0.f;
#pragma unroll 1
            for (int s0 = 0; s0 < NS; s0 += SCAN_RING) {
                const int sn0 = (s0 + SCAN_RING < NS) ? s0 + SCAN_RING : s0;
                int so = SCAN_SOFF(sn0) + 4096;
                SCAN_SGPR_SETTLE(rs, so);
#pragma unroll
                for (int j = 0; j < SCAN_RING; ++j) {
                    SCAN_WAIT(28);
                    const ScanOps nxt = scan_read(ring + ((j + 1) % SCAN_RING) * SCAN_SLOT, kq, vrow);
                    const sc_f2 Sa = {S0, S1}, Sb = {S2, S3};
                    const sc_f2 d2 = sc_fma2(Sb, sc_f2{cur.kk[2], cur.kk[3]}, Sa * sc_f2{cur.kk[0], cur.kk[1]});
                    float dot = d2[0] + d2[1];
                    const float t0 = S0 * cur.w[0] + cur.v * cur.k[0], t1 = S1 * cur.w[1] + cur.v * cur.k[1], t2 = S2 * cur.w[2] + cur.v * cur.k[2], t3 = S3 * cur.w[3] + cur.v * cur.k[3];
                    dot = dpp_sum16(dot);
                    const float yred = dpp_sum16(yprev);
                    ykA = row_push(ykA, yred, kq);
                    S0 = t0 - dot * cur.b[0]; S1 = t1 - dot * cur.b[1]; S2 = t2 - dot * cur.b[2]; S3 = t3 - dot * cur.b[3];
                    { const sc_f2 Ya = {S0, S1}, Yb2 = {S2, S3}; const sc_f2 y2 = sc_fma2(Yb2, sc_f2{cur.r[2], cur.r[3]}, Ya * sc_f2{cur.r[0], cur.r[1]}); yprev = y2[0] + y2[1]; }
                    if (j % 3 == 0) scan_set_m0(ring + j * SCAN_SLOT);
                    scan_dma2(j % 3, rs, voff, voffb, so); so += ((j + 1) % 3) ? dstepA : dstepB;
                    cur = nxt;
                }
                {
                    const int sa = s0 + 14 - kq;
                    if (sa >= 0) scan_store(Yb + (size_t)scan_row(sa, d, b) * RW, ykA);
                }
            }
            scan_store(Yb + (size_t)scan_row(NS - 1, d, b) * RW, dpp_sum16(yprev));
            SCAN_WAIT(0);
#undef SCAN_SOFF
        }
#if PROBE_MASK & 0x4000000
        __syncthreads();
#endif
    } else {
#if PROBE_MASK & 0x4000000
        __syncthreads();
#endif
        conv_role(p, l, (int)blockIdx.x * 4 + (wave - 4), (int)gridDim.x * 4, lane);
#if PROBE_MASK & 0x100000
        conv_role(p, l, (int)blockIdx.x * 4 + (wave - 4), (int)gridDim.x * 4, lane);
#endif
    }
    __syncthreads();
}

PHASE_FN void ph_readout(const Params& p, int l) {
    static_assert(RW == 512 && RH == 8, "readout geometry");
    const int TX_ = ltid(p.sw);
    const int wave = TX_ >> 6, lane = TX_ & 63;
    for (int r = blockIdx.x * NW + wave; r < T; r += gridDim.x * NW) {
        pg8::f32x4 y[2], vv[2], gg[2];
#pragma unroll
        for (int j = 0; j < 2; ++j) { const size_t o = (size_t)r * RW + j * 256 + lane * 4;
            y[j] = *(const pg8::f32x4*)(WSF(O_Y) + o) + *(const pg8::f32x4*)(WSF(O_Y) + (size_t)T * RW + o); vv[j] = *(const pg8::f32x4*)(WSF(O_V) + o); gg[j] = *(const pg8::f32x4*)(WSF(O_G) + o); }
#pragma unroll
        for (int j = 0; j < 2; ++j) { const int ch = j * 256 + lane * 4;
            const float mean = dpp_sum16(y[j][0] + y[j][1] + y[j][2] + y[j][3]) * (1.0f / 64.0f);
            const pg8::f32x4 dv = y[j] - mean;
            const float var = dpp_sum16(dv[0] * dv[0] + dv[1] * dv[1] + dv[2] * dv[2] + dv[3] * dv[3]) * (1.0f / 64.0f);
            const float rs = rsqrtf(var + GN_EPS), bon = WSF(O_BON)[(size_t)r * RH + (ch >> 6)];
            const pg8::f32x4 lg = *(const pg8::f32x4*)(p.in[ILNG] + l * RW + ch), lb = *(const pg8::f32x4*)(p.in[ILNB] + l * RW + ch);
            const pg8::f32x4 o4 = (dv * rs * lg + lb + bon * vv[j]) * gg[j];
            pg8::u32x2 w2; w2[0] = pg8::pk_bf16(o4[0], o4[1]); w2[1] = pg8::pk_bf16(o4[2], o4[3]);
            *(pg8::u32x2*)(WSH(O_OCAT) + (size_t)r * KCAT + PW + ch) = w2; }
    }
}

constexpr int AT_KS = 272, AT_VS = 144, AT_PS = 144;
constexpr int AT_K = 0, AT_V = 64 * AT_KS, AT_P = AT_V + 128 * AT_VS, AT_ST = AT_P + NW * 32 * AT_PS;
typedef float f32x16 __attribute__((ext_vector_type(16)));
struct AttnRegs { pg8::u32x4 k[2], v[2]; };
template <bool WITHV> __device__ __forceinline__ void attn_load(const Params& p, AttnRegs& r, int krow0, int rlo, int rhi, int kvh, int tid) {
#pragma unroll
    for (int i = 0; i < 2; ++i) {
        const int chunk = tid + i * NT, key = chunk >> 4, part = chunk & 15;
        int row = krow0 + key; row = row < rlo ? rlo : (row > rhi ? rhi : row);
        r.k[i] = *(const pg8::u32x4*)(WSH(O_KB) + (size_t)row * KVW + kvh * 128 + part * 8);
        if (WITHV) {
            const int keyv = chunk & 63, partv = chunk >> 6;
            int rowv = krow0 + keyv; rowv = rowv < rlo ? rlo : (rowv > rhi ? rhi : rowv);
            r.v[i] = *(const pg8::u32x4*)(WSH(O_VB) + (size_t)rowv * KVW + kvh * 128 + partv * 8);
        }
    }
}
template <bool WITHV> __device__ __forceinline__ void attn_store(LAS unsigned char* lds, const AttnRegs& r, int tid) {
#pragma unroll
    for (int i = 0; i < 2; ++i) {
        const int chunk = tid + i * NT, key = chunk >> 4, part = chunk & 15;
        *(LAS pg8::u32x4*)(lds + AT_K + key * AT_KS + part * 16) = r.k[i];
        if (WITHV) {
            const int keyv = chunk & 63, partv = chunk >> 6;
            const unsigned w4[4] = {r.v[i][0], r.v[i][1], r.v[i][2], r.v[i][3]};
#pragma unroll
            for (int q = 0; q < 4; ++q) {
                *(LAS bf16_t*)(lds + AT_V + (partv * 8 + 2 * q) * AT_VS + keyv * 2) = (bf16_t)(w4[q] & 0xffffu);
                *(LAS bf16_t*)(lds + AT_V + (partv * 8 + 2 * q + 1) * AT_VS + keyv * 2) = (bf16_t)(w4[q] >> 16);
            }
        }
    }
}
PHASE_FN void ph_attn(const Params& p, int l, bool need_ctx, LAS unsigned char* lds) {
    const int TX_ = ltid(p.sw);
#ifdef EMU
    const int wave = TX_ >> 6;
#else
    const int wave = p.sw;
#endif
    const int g = wave & 3, th = wave >> 2;
    constexpr int NCT = C / 64, NQT = L / 64, n_lat = NB * KVH * NQT;
    const int n_ctx = need_ctx ? NB * KVH * NCT : 0;
    const float SC = 0.08838834764831845f;
    LAS unsigned char* Pw = lds + AT_P + wave * 32 * AT_PS;
    LAS float* st = (LAS float*)(lds + AT_ST + wave * 512);
    for (int u = blockIdx.x; u < n_lat + n_ctx; u += gridDim.x) {
        int txo = TX_; PG8_OPAQUE(txo);
        const int lane = txo & 63, c = lane & 31, h = lane >> 5;
        const bool lat = u < n_lat;
        const int uu = lat ? u : u - n_lat, nqt = lat ? NQT : NCT;
        const int tq = uu % nqt, kvh = (uu / nqt) % KVH, b = uu / (nqt * KVH);
        const int hq = kvh * 4 + g, ntile = lat ? NCT + 5 : NCT;
        const int tw = tq * 64 + th * 32 + c;
        const int qrow = lat ? TC + b * L + tw : b * C + tw;
        const float sink = p.in[ISINK][l * QH + hq];
        pg8::bf16x8 Qu[8], Qr[8];
#pragma unroll
        for (int ks = 0; ks < 8; ++ks) {
            Qu[ks] = *(const pg8::bf16x8*)(WSH(O_QB) + (size_t)qrow * AW + hq * 128 + ks * 16 + h * 8);
            Qr[ks] = lat ? *(const pg8::bf16x8*)(WSH(O_QRB) + (size_t)(qrow - TC) * AW + hq * 128 + ks * 16 + h * 8) : Qu[ks];
        }
#define AT_TILE(kt, krow0, rlo, rhi, jpos0) const bool ctxt = (kt) < NCT; \
        const int jpos0 = ctxt ? 0 : tq * 64 - 128 + ((kt) - NCT) * 64; \
        const int krow0 = ctxt ? b * C + (kt) * 64 : TC + b * L + jpos0, rlo = ctxt ? b * C : TC + b * L, rhi = ctxt ? b * C + C - 1 : TC + b * L + L - 1;
#define AT_SCORES(acc, kb, ctxt) { acc = (f32x16){0.f, 0.f, 0.f, 0.f, 0.f, 0.f, 0.f, 0.f, 0.f, 0.f, 0.f, 0.f, 0.f, 0.f, 0.f, 0.f}; \
        _Pragma("unroll") for (int ks = 0; ks < 8; ++ks) { const pg8::bf16x8 kf = *(const LAS pg8::bf16x8*)(lds + AT_K + ((kb) * 32 + c) * AT_KS + ks * 32 + h * 16); \
            acc = __builtin_amdgcn_mfma_f32_32x32x16_bf16(kf, (ctxt) ? Qu[ks] : Qr[ks], acc, 0, 0, 0); } }
        float mloc = -1e30f;
        AttnRegs ar;
        { AT_TILE(0, krow0, rlo, rhi, jpos0) (void)jpos0; attn_load<false>(p, ar, krow0, rlo, rhi, kvh, txo); }
        for (int kt = 0; kt < ntile; ++kt) {
            AT_TILE(kt, krow0, rlo, rhi, jpos0)
            __syncthreads();
            attn_store<false>(lds, ar, txo);
            __syncthreads();
            if (kt + 1 < ntile) { const int kn = kt + 1; const bool ctxt2 = kn < NCT; const int jp2 = ctxt2 ? 0 : tq * 64 - 128 + (kn - NCT) * 64;
              attn_load<false>(p, ar, ctxt2 ? b * C + kn * 64 : TC + b * L + jp2, ctxt2 ? b * C : TC + b * L, ctxt2 ? b * C + C - 1 : TC + b * L + L - 1, kvh, txo); }
#pragma unroll
            for (int kb = 0; kb < 2; ++kb) {
                f32x16 acc; AT_SCORES(acc, kb, ctxt)
#pragma unroll
                for (int i = 0; i < 16; ++i) {
                    const int j = jpos0 + kb * 32 + (i & 3) + 8 * (i >> 2) + 4 * h;
                    const bool valid = ctxt || (j >= 0 && j < L && j - tw <= 128 && tw - j <= 128);
                    mloc = fmaxf(mloc, valid ? acc[i] : -1e30f);
                }
            }
        }
        st[h * 32 + c] = mloc;
        WAVE_SYNC();
        const float m = fmaxf(fmaxf(st[c], st[32 + c]) * SC, sink);
        WAVE_SYNC();
        f32x16 O[4];
#pragma unroll
        for (int db = 0; db < 4; ++db) O[db] = (f32x16){0.f, 0.f, 0.f, 0.f, 0.f, 0.f, 0.f, 0.f, 0.f, 0.f, 0.f, 0.f, 0.f, 0.f, 0.f, 0.f};
        float lsum = 0.f;
        { AT_TILE(0, krow0, rlo, rhi, jpos0) (void)jpos0; attn_load<true>(p, ar, krow0, rlo, rhi, kvh, txo); }
        for (int kt = 0; kt < ntile; ++kt) {
            AT_TILE(kt, krow0, rlo, rhi, jpos0)
            __syncthreads();
            attn_store<true>(lds, ar, txo);
            __syncthreads();
            if (kt + 1 < ntile) { const int kn = kt + 1; const bool ctxt2 = kn < NCT; const int jp2 = ctxt2 ? 0 : tq * 64 - 128 + (kn - NCT) * 64;
              attn_load<true>(p, ar, ctxt2 ? b * C + kn * 64 : TC + b * L + jp2, ctxt2 ? b * C : TC + b * L, ctxt2 ? b * C + C - 1 : TC + b * L + L - 1, kvh, txo); }
#pragma unroll
            for (int kb = 0; kb < 2; ++kb) {
                f32x16 acc; AT_SCORES(acc, kb, ctxt)
#pragma unroll
                for (int grp = 0; grp < 4; ++grp) {
                    float pv[4];
#pragma unroll
                    for (int q = 0; q < 4; ++q) {
                        const int i = grp * 4 + q, j = jpos0 + kb * 32 + q + 8 * grp + 4 * h;
                        const bool valid = ctxt || (j >= 0 && j < L && j - tw <= 128 && tw - j <= 128);
                        const float e = valid ? __expf(acc[i] * SC - m) : 0.f;
                        lsum += e; pv[q] = e;
                    }
                    pg8::u32x2 w2; w2[0] = pg8::pk_bf16(pv[0], pv[1]); w2[1] = pg8::pk_bf16(pv[2], pv[3]);
                    *(LAS pg8::u32x2*)(Pw + c * AT_PS + (kb * 32 + 8 * grp + 4 * h) * 2) = w2;
                }
            }
            WAVE_SYNC();
#pragma unroll
            for (int ks = 0; ks < 4; ++ks) {
                const pg8::bf16x8 pf = *(const LAS pg8::bf16x8*)(Pw + c * AT_PS + ks * 32 + h * 16);
#pragma unroll
                for (int db = 0; db < 4; ++db) {
                    const pg8::bf16x8 vf = *(const LAS pg8::bf16x8*)(lds + AT_V + (db * 32 + c) * AT_VS + ks * 32 + h * 16);
                    O[db] = __builtin_amdgcn_mfma_f32_32x32x16_bf16(pf, vf, O[db], 0, 0, 0);
                }
            }
            WAVE_SYNC();
        }
        st[64 + h * 32 + c] = lsum;
        WAVE_SYNC();
        float rinv[16];
#pragma unroll
        for (int i = 0; i < 16; ++i) { const int q = (i & 3) + 8 * (i >> 2) + 4 * h; const float mm = fmaxf(fmaxf(st[q], st[32 + q]) * SC, sink); rinv[i] = pg8::frcp(st[64 + q] + st[96 + q] + __expf(sink - mm)); }
        WAVE_SYNC();
        const int orow0 = (lat ? TC + b * L : b * C) + tq * 64 + th * 32;
#pragma unroll
        for (int dh = 0; dh < 2; ++dh) {
#pragma unroll
            for (int d2 = 0; d2 < 2; ++d2)
#pragma unroll
                for (int i = 0; i < 16; ++i) { const int q = (i & 3) + 8 * (i >> 2) + 4 * h;
                    *(LAS bf16_t*)(Pw + q * AT_PS + (d2 * 32 + c) * 2) = f2bf(O[dh * 2 + d2][i] * rinv[i]); }
            WAVE_SYNC();
#pragma unroll
            for (int pz = 0; pz < 4; ++pz) { const int row = pz * 8 + (lane >> 3), ck = lane & 7;
                const pg8::u32x4 w4 = *(const LAS pg8::u32x4*)(Pw + row * AT_PS + ck * 16);
                *(pg8::u32x4*)(WSH(O_OCAT) + (size_t)(orow0 + row) * KCAT + PW + RW + hq * 128 + dh * 64 + ck * 8) = w4; }
            WAVE_SYNC();
        }
#undef AT_TILE
#undef AT_SCORES
    }
    __syncthreads();
}

PHASE_FN void ph_poolmm(const Params& p, int l, float* lds) {
    const int TX_ = ltid(p.sw);
    const int tx = TX_ & 15, ty = TX_ >> 4;
    const int nM = T / GT_M, nN = PW / 64;
    for (int it = blockIdx.x; it < nM * nN; it += gridDim.x) {
        const int m0 = (it / nN) * GT_M, n0 = (it % nN) * 64, g = n0 / PGD;
        float acc[4][4]; ZERO_ACC(acc);
        gemm_tile(WSF(O_POOLED) + g * PGD, PW, nullptr, 0, T, m0, p.in[IPOOLW] + ((size_t)l * 4 + g) * PGD * PGD, PGD, n0 - g * PGD, PGD, acc, lds, TX_);
#pragma unroll
        for (int i = 0; i < 4; ++i)
#pragma unroll
            for (int j = 0; j < 4; ++j) { const int n = n0 + 4 * tx + j; WSH(O_OCAT)[(size_t)(m0 + 4 * ty + i) * KCAT + n] = f2bf(acc[i][j] * p.in[IPOOLS][l * PW + n]); }
    }
}

PHASE_FN void ph_merge(const Params& p, int l, bool need_ctx, LAS unsigned char* lds) {
    const int pm0 = need_ctx ? 0 : TC / 256;
    pg8::DenseOrder S; S.init(WSH(O_OCAT), KCAT, WSH(O_WMT) + (size_t)l * D * KCAT, KCAT, pm0, T / 256 - pm0, D / 256, gridDim.x, blockIdx.x);
    pg8::EpiMerge E{WSH(O_SG), WSH(O_MBB)};
    pg8::gemm_phase<pg8::EpiMerge, pg8::DenseOrder>(lds, KCAT, KCAT, KCAT, S, E, ltid(p.sw));
}
PHASE_FN void ph_wout(const Params& p, int l, bool need_ctx, LAS unsigned char* lds) {
    const int pm0 = need_ctx ? 0 : TC / 256;
    pg8::DenseOrder S; S.init(WSH(O_MBB), D, WSH(O_WOT) + (size_t)l * D * D, D, pm0, T / 256 - pm0, D / 256, gridDim.x, blockIdx.x);
    pg8::EpiWout E{WSF(O_X), WSF(O_MOD) + (size_t)l * (NB + 1) * 6 * D, l == 0 ? p.in[ICTX] : nullptr, l == 0 ? p.in[IX] : nullptr};
    pg8::gemm_phase<pg8::EpiWout, pg8::DenseOrder>(lds, D, D, D, S, E, ltid(p.sw));
}

PHASE_FN void ph_norm2(const Params& p, int l, bool need_ctx, LAS unsigned char* lds, bool dry = false) {
    const int TX_ = ltid(p.sw);
#ifdef EMU
    const int wave = TX_ >> 6;
#else
    const int wave = p.sw;
#endif
    const int lane = TX_ & 63;
    LAS float* Wc = (LAS float*)lds;
    LAS float* lg = (LAS float*)lds + 6 * D + wave * 200;
    const int r_begin = need_ctx ? 0 : TC, nrows_all = T - r_begin;
    const int per = min((nrows_all + (int)gridDim.x - 1) / (int)gridDim.x, 40);
    const int nblk = (nrows_all + per - 1) / per;
    for (int blk = blockIdx.x; blk < nblk; blk += gridDim.x) {
    const int rb0 = r_begin + blk * per, rb1 = min(rb0 + per, T);
    const int q4 = per / 8, extra = per - 8 * q4;
    const int myn = q4 + (wave < extra ? 1 : 0), myr0 = rb0 + wave * q4 + min(wave, extra);
    const int nrow = max(0, min(myn, rb1 - myr0));
    const float* g2 = p.in[INORM2] + l * D;
    int ln = lane; PG8_OPAQUE(ln);
    float hv[5][D / 64];
#pragma unroll
    for (int rr = 0; rr < 5; ++rr) {
        const int r = min(myr0 + rr, T - 1); int t, len, mr; seq_info(r, t, len, mr);
        const float* xr = WSF(O_X) + (size_t)r * D;
        float ss = 0.f;
#pragma unroll
        for (int i = 0; i < D / 256; ++i) { const float4 x = *(const float4*)(xr + (i * 64 + ln) * 4); hv[rr][4 * i] = x.x; hv[rr][4 * i + 1] = x.y; hv[rr][4 * i + 2] = x.z; hv[rr][4 * i + 3] = x.w; ss += x.x * x.x + x.y * x.y + x.z * x.z + x.w * x.w; }
        ss = wave_bcast63(wave_total63(ss));
        const float rs = rsqrtf(ss / (float)D + NORM_EPS);
        const float* md = WSF(O_MOD) + ((size_t)l * (NB + 1) + mr) * 6 * D;
#pragma unroll
        for (int i = 0; i < D / 256; ++i) {
            const int c = (i * 64 + ln) * 4;
            const float4 g = *(const float4*)(g2 + c), sh = *(const float4*)(md + 3 * D + c), sc = *(const float4*)(md + 4 * D + c);
            const float h0 = (hv[rr][4 * i] * rs * g.x) * (1.0f + sc.x) + sh.x, h1 = (hv[rr][4 * i + 1] * rs * g.y) * (1.0f + sc.y) + sh.y;
            const float h2 = (hv[rr][4 * i + 2] * rs * g.z) * (1.0f + sc.z) + sh.z, h3 = (hv[rr][4 * i + 3] * rs * g.w) * (1.0f + sc.w) + sh.w;
            hv[rr][4 * i] = h0; hv[rr][4 * i + 1] = h1; hv[rr][4 * i + 2] = h2; hv[rr][4 * i + 3] = h3;
            if (rr < nrow) { uint2 o; o.x = pg8::pk_bf16(h0, h1); o.y = pg8::pk_bf16(h2, h3); *(uint2*)(WSH(O_H2B) + (size_t)r * D + c) = o; }
        }
        WAVE_FENCE();
    }
#pragma unroll 1
    for (int ch = 0; ch < 6; ++ch) {
        __syncthreads();
        {
            const float* wsrc = WSF(O_WRT) + ((size_t)l * (4 + NE) + ch * 6) * D;
            for (int i4 = TX_; i4 < 6 * D / 4; i4 += NT) *(LAS pg8::f32x4*)(Wc + i4 * 4) = *(const pg8::f32x4*)(wsrc + i4 * 4);
        }
        __syncthreads();
        float acc[5][6];
#pragma unroll
        for (int rr = 0; rr < 5; ++rr)
#pragma unroll
            for (int n = 0; n < 6; ++n) acc[rr][n] = 0.f;
#pragma unroll
        for (int i = 0; i < D / 256; ++i) {
#pragma unroll
            for (int n = 0; n < 6; ++n) {
                const pg8::f32x4 wq = *(const LAS pg8::f32x4*)(Wc + n * D + (i * 64 + lane) * 4);
#pragma unroll
                for (int rr = 0; rr < 5; ++rr) acc[rr][n] += hv[rr][4 * i] * wq[0] + hv[rr][4 * i + 1] * wq[1] + hv[rr][4 * i + 2] * wq[2] + hv[rr][4 * i + 3] * wq[3];
            }
#pragma unroll
            for (int rr = 0; rr < 5; ++rr) ACC_PIN6(acc[rr]);
            WAVE_FENCE();
        }
#pragma unroll
        for (int rr = 0; rr < 5; ++rr)
#pragma unroll
            for (int n = 0; n < 6; ++n) { const float tsum = wave_total63(acc[rr][n]); if (lane == 63) lg[rr * 40 + ch * 6 + n] = tsum; }
    }
    WAVE_SYNC();
    if (lane < nrow && !dry) {
        const int r = myr0 + lane; const LAS float* q = lg + lane * 40;
        float lgv[36];
#pragma unroll
        for (int i = 0; i < 36; ++i) lgv[i] = q[i] + (i < 4 ? p.in[IRGB][l * 4 + i] : p.in[IREB][l * NE + i - 4]);
        int gi = 0; float gm = lgv[0];
#pragma unroll
        for (int i = 1; i < 4; ++i) if (lgv[i] > gm) { gm = lgv[i]; gi = i; }
        float gs = 0.f;
#pragma unroll
        for (int i = 0; i < 4; ++i) gs += expf(lgv[i] - gm);
        const float g_top = 1.0f / gs;
        float el[8];
#pragma unroll
        for (int i = 0; i < 8; ++i) el[i] = (gi == 0) ? lgv[4 + i] : (gi == 1 ? lgv[12 + i] : (gi == 2 ? lgv[20 + i] : lgv[28 + i]));
        int e0 = 0; float m0 = el[0];
#pragma unroll
        for (int i = 1; i < 8; ++i) if (el[i] > m0) { m0 = el[i]; e0 = i; }
        int e1 = -1; float m1 = -3.0e38f;
#pragma unroll
        for (int i = 0; i < 8; ++i) if (i != e0 && el[i] > m1) { m1 = el[i]; e1 = i; }
        const float p1 = expf(m1 - m0);
        const float w0 = g_top / (1.0f + p1), w1 = g_top * p1 / (1.0f + p1);
        const int id0 = gi * 8 + e0, id1 = gi * 8 + e1;
        WSI(O_EID)[2 * r] = id0; WSI(O_EID)[2 * r + 1] = id1; WSF(O_EWT)[2 * r] = w0; WSF(O_EWT)[2 * r + 1] = w1;
        WSI(O_POS)[2 * r] = atomicAdd(&WSI(O_ECNT)[l * NE + id0], 1);
        WSI(O_POS)[2 * r + 1] = atomicAdd(&WSI(O_ECNT)[l * NE + id1], 1);
    }
    WAVE_SYNC();
    }
    __syncthreads();
}

constexpr int LDS_TOFF = pg8::STAGE_BYTES;
__device__ __forceinline__ void moe_offsets(const Params& p, int l, LAS int* toff) {
    const int TX_ = ltid(p.sw);
    __syncthreads();
    if (TX_ < NE) toff[64 + TX_] = WSI(O_ECNT)[l * NE + TX_];
    __syncthreads();
    if (TX_ <= NE) { int s = 0; for (int q = 0; q < TX_; ++q) s += (toff[64 + q] + 255) >> 8; toff[TX_] = s; }
    __syncthreads();
}
PHASE_FN void ph_gather(const Params& p, int l, bool need_ctx, LAS unsigned char* lds) {
    const int TX_ = ltid(p.sw);
    LAS int* toff = (LAS int*)(lds + LDS_TOFF);
    moe_offsets(p, l, toff);
    const int wave = TX_ >> 6, lane = TX_ & 63;
    const int s_begin = need_ctx ? 0 : 2 * TC;
    for (int sl = s_begin + blockIdx.x * NT + TX_; sl < 2 * T; sl += gridDim.x * NT) {
        const int e = WSI(O_EID)[sl], dst = toff[e] * 256 + WSI(O_POS)[sl];
        WSI(O_SLOTOF)[dst] = sl; WSF(O_WTP)[dst] = WSF(O_EWT)[sl];
    }
    for (int e = blockIdx.x; e < NE; e += gridDim.x) {
        const int r0 = toff[e] * 256 + toff[64 + e], r1 = toff[e + 1] * 256;
        for (int r = r0 + TX_; r < r1; r += NT) { WSI(O_SLOTOF)[r] = -1; WSF(O_WTP)[r] = 0.f; }
    }
    __syncthreads();
}
PHASE_FN void ph_moe1(const Params& p, int l, LAS unsigned char* lds) {
    LAS int* toff = (LAS int*)(lds + LDS_TOFF);
    moe_offsets(p, l, toff);
    pg8::MoeGatherOrder S{(const char*)WSH(O_H2B), (const char*)(WSH(O_EGU) + (size_t)l * NE * 2 * DE * D), (size_t)2 * DE * D * 2, (size_t)256 * D * 2, 2 * DE / 256, (int)gridDim.x, (int)blockIdx.x, toff, WSI(O_SLOTOF)};
    pg8::EpiSwiglu E{WSH(O_ACTB), WSF(O_WTP)};
    pg8::gemm_phase<pg8::EpiSwiglu, pg8::MoeGatherOrder>(lds, D, D, D, S, E, ltid(p.sw));
}
PHASE_FN void ph_moe2(const Params& p, int l, LAS unsigned char* lds) {
    LAS int* toff = (LAS int*)(lds + LDS_TOFF);
    moe_offsets(p, l, toff);
    pg8::MoeOrder S{(const char*)WSH(O_ACTB), (const char*)(WSH(O_ED) + (size_t)l * NE * D * DE), (size_t)256 * DE * 2, (size_t)D * DE * 2, (size_t)256 * DE * 2, D / 256, (int)gridDim.x, (int)blockIdx.x, toff};
    pg8::EpiDown E{WSH(O_YSB), WSI(O_SLOTOF)};
    pg8::gemm_phase<pg8::EpiDown, pg8::MoeOrder>(lds, DE, DE, DE, S, E, ltid(p.sw));
}

enum { PH_P0 = 0, PH_NORM1, PH_WIN, PH_PREP, PH_MIX, PH_READOUT, PH_MERGE, PH_WOUT, PH_NORM2, PH_GATHER, PH_MOE1, PH_MOE2, PH_FINAL };
template <int PH> __device__ __forceinline__ void run_phase(const Params& p_in, int l, unsigned char* smem, int sw) {
    const bool need_ctx = (l != DEPTH - 1);
    float* ldsf = (float*)smem;
    Params p;
#ifdef EMU
    p = p_in; p.sw = sw;
#else
    typedef const __attribute__((address_space(4))) Params* KP;
    KP kp = (KP)__builtin_amdgcn_kernarg_segment_ptr();
    asm volatile("" : "+s"(kp));
#pragma unroll
    for (int i = 0; i < N_IN; ++i) p.in[i] = kp->in[i];
    p.out = kp->out; p.ws = kp->ws; p.sw = sw; p.pad = 0;
    (void)p_in;
#endif
    LAS unsigned char* ldsl = (LAS unsigned char*)smem;
    if (PH == PH_P0) {
#if PROBE_MASK & 0x2000000
        {
            const int TX_ = ltid(p.sw); unsigned acc_ = 0;
            const size_t gt_ = (size_t)blockIdx.x * NT + TX_, gs_ = (size_t)gridDim.x * NT;
            for (size_t pg = gt_; pg < O_END / 4096; pg += gs_) acc_ += ((const volatile unsigned*)p.ws)[pg * 1024];
            for (size_t pg = gt_; pg < (size_t)DEPTH * D * 6 * D / 1024; pg += gs_) acc_ += ((const volatile unsigned*)p.in[IMODW])[pg * 1024];
            for (size_t pg = gt_; pg < (size_t)DEPTH * D * IN_DIM / 1024; pg += gs_) acc_ += ((const volatile unsigned*)p.in[IWIN])[pg * 1024];
            for (size_t pg = gt_; pg < (size_t)DEPTH * NE * D * DE / 1024; pg += gs_) { acc_ += ((const volatile unsigned*)p.in[IEWG])[pg * 1024]; acc_ += ((const volatile unsigned*)p.in[IEWU])[pg * 1024]; acc_ += ((const volatile unsigned*)p.in[IEWD])[pg * 1024]; }
            for (size_t pg = gt_; pg < (size_t)NB * L * D / 1024; pg += gs_) acc_ += ((const volatile unsigned*)p.in[IX])[pg * 1024];
            if (acc_ == 0x12345678u) WSI(O_EID)[0] = 1;
        }
#endif
        ph_pws(p); ph_rope_table(p); ph_lora_pack(p); ph_router_pack(p); ph_mod(p, ldsf); ph_conv_win0(p, ldsf); }
    if (PH == PH_NORM1) {
#if PROBE_MASK & 0x800000
        ph_norm1(p, l, 0, true);
#endif
        ph_norm1(p, l, 0); ph_fold(p, l, ldsf); }
    if (PH == PH_WIN) ph_win(p, l, ldsl);
    if (PH == PH_PREP) ph_prep(p, l, ldsf);
    if (PH == PH_MIX) {
        ph_scan(p, l, ldsl);
#if PROBE_MASK & 0x10000
        ph_scan(p, l, ldsl);
#endif
        ph_attn(p, l, need_ctx, ldsl);
#if PROBE_MASK & 0x20000
        ph_attn(p, l, need_ctx, ldsl);
#endif
    }
    if (PH == PH_READOUT) ph_readout(p, l);
    if (PH == PH_MERGE) ph_merge(p, l, need_ctx, ldsl);
    if (PH == PH_WOUT) ph_wout(p, l, need_ctx, ldsl);
    if (PH == PH_NORM2) {
#if PROBE_MASK & 0x400000
        ph_norm2(p, l, need_ctx, ldsl, true);
#endif
        ph_norm2(p, l, need_ctx, ldsl); }
    if (PH == PH_GATHER) ph_gather(p, l, need_ctx, ldsl);
    if (PH == PH_MOE1) ph_moe1(p, l, ldsl);
    if (PH == PH_MOE2) ph_moe2(p, l, ldsl);
    if (PH == PH_FINAL) {
#if PROBE_MASK & 0x800000
        ph_norm1(p, 0, 2, true);
#endif
        ph_norm1(p, 0, 2); }
}

#ifdef EMU
__shared__ unsigned char emu_smem[LDS_BYTES] __attribute__((aligned(16)));
template <int PH> __global__ void k_phase(Params p, int l) { run_phase<PH>(p, l, emu_smem, 0); }
#else
#define XB_TMO      128
#define XB_XCNT(j)  (256  + 64 * (j))
#define XB_XSUB(j)  (1280 + 64 * (j))
#define XB_XGEN(j)  (2304 + 64 * (j))
#define XB_TOP      3328
#define XB_TOPGEN   3392
#define XCD_BAR_WORDS 3456
#define XB_SPIN_CAP (1u << 18)
__device__ __forceinline__ unsigned xb_ld(unsigned* p)              { return __hip_atomic_load(p, __ATOMIC_RELAXED, __HIP_MEMORY_SCOPE_AGENT); }
__device__ __forceinline__ unsigned xb_add(unsigned* p, unsigned v) { return __hip_atomic_fetch_add(p, v, __ATOMIC_RELAXED, __HIP_MEMORY_SCOPE_AGENT); }
__device__ __forceinline__ unsigned xb_xcc_id() { return (unsigned)__builtin_amdgcn_s_getreg((3 << 11) | 20) & 0xFu; }
#define XB_SPIN(cond, bar) do { unsigned _sp = 0; while (cond) { __builtin_amdgcn_s_sleep(1); \
    if ((++_sp & 255u) == 0u) { if (xb_ld(&(bar)[XB_TMO])) break; if (_sp > XB_SPIN_CAP) { atomicAdd(&(bar)[XB_TMO], 1u); break; } } } } while (0)
struct XcdBarrier { unsigned* bar; unsigned x; volatile LAS unsigned* st; };
__device__ __forceinline__ XcdBarrier xcd_barrier_post(unsigned* bar, volatile LAS unsigned* st) {
    XcdBarrier b; b.bar = bar; b.x = xb_xcc_id(); b.st = st;
    if (threadIdx.x == 0) (void)xb_add(&bar[XB_XCNT(b.x)], 1u);
    return b;
}
__device__ __forceinline__ void xcd_barrier_complete(unsigned* bar, unsigned x, unsigned& nloc, unsigned& nx) {
    const unsigned G = gridDim.x * gridDim.y * gridDim.z;
    unsigned sum, cnt, mine, sp = 0u;
    for (;;) {
        sum = 0u; cnt = 0u; mine = 0u;
#pragma unroll
        for (unsigned j = 0; j < 16; ++j) { const unsigned c = xb_ld(&bar[XB_XCNT(j)]); sum += c; cnt += (c > 0u) ? 1u : 0u; mine = (j == x) ? c : mine; }
        if (sum == G) break;
        __builtin_amdgcn_s_sleep(1);
        if ((++sp & 255u) == 0u) { if (xb_ld(&bar[XB_TMO])) break; if (sp > XB_SPIN_CAP) { atomicAdd(&bar[XB_TMO], 1u); break; } }
    }
    nloc = mine > 0u ? mine : 1u; nx = cnt > 0u ? cnt : 1u;
}
__device__ __forceinline__ void xcd_barrier(const XcdBarrier& b_in, const int sw) {
    asm volatile("s_waitcnt vmcnt(0)" ::: "memory");
    __syncthreads();
    XcdBarrier b = b_in;
    asm volatile("" : "+s"(b.bar), "+s"(b.x));
    if (ltid(sw) == 0) {
        unsigned* bar = b.bar;
        __builtin_amdgcn_s_waitcnt(0);
        unsigned nloc = b.st[0], nx = b.st[1];
        if (nloc == 0u) { xcd_barrier_complete(bar, b.x, nloc, nx); b.st[0] = nloc; b.st[1] = nx; }
        const unsigned old = xb_add(&bar[XB_XSUB(b.x)], 1u);
        const unsigned gen = old / nloc;
        if (old + 1u == (gen + 1u) * nloc) {
            __builtin_amdgcn_fence(__ATOMIC_RELEASE, "agent");
            asm volatile("s_waitcnt vmcnt(0)" ::: "memory");
            const unsigned og = xb_add(&bar[XB_TOP], 1u);
            const unsigned tg = og / nx;
            if (og + 1u == (tg + 1u) * nx) xb_add(&bar[XB_TOPGEN], 1u);
            else XB_SPIN(xb_ld(&bar[XB_TOPGEN]) == tg, bar);
            __builtin_amdgcn_fence(__ATOMIC_ACQUIRE, "agent");
            xb_add(&bar[XB_XGEN(b.x)], 1u);
            asm volatile("s_waitcnt vmcnt(0)" ::: "memory");
        } else {
            XB_SPIN(xb_ld(&bar[XB_XGEN(b.x)]) == gen, bar);
            __builtin_amdgcn_fence(__ATOMIC_ACQUIRE, "agent");
            asm volatile("s_waitcnt vmcnt(0)" ::: "memory");
        }
    }
    __syncthreads();
}

#define RUNB(PH, l) { run_phase<PH>(p, l, smem, sw); if ((PROBE_MASK >> PH) & 1) run_phase<PH>(p, l, smem, sw); xcd_barrier(bar, sw); if (PROBE_MASK & 0x1000000) xcd_barrier(bar, sw); }
__global__ void __launch_bounds__(NT, 2) k_mega(Params p) {
    extern __shared__ __attribute__((aligned(16))) unsigned char smem[];
    const int sw = __builtin_amdgcn_readfirstlane((int)(threadIdx.x >> 6));
    volatile LAS unsigned* xbw = (volatile LAS unsigned*)((LAS unsigned char*)smem + LDS_BYTES - 16);
    if (threadIdx.x == 0) { xbw[0] = 0u; xbw[1] = 0u; xbw[2] = 0u; xbw[3] = 0u; }
    __syncthreads();
    XcdBarrier bar = xcd_barrier_post((unsigned*)(p.ws + O_BAR), xbw);
    RUNB(PH_P0, 0)
    for (int l = 0; l < DEPTH; ++l) {
        RUNB(PH_NORM1, l)
        RUNB(PH_WIN, l)
        RUNB(PH_PREP, l)
        RUNB(PH_MIX, l)
        RUNB(PH_READOUT, l)
        RUNB(PH_MERGE, l)
        RUNB(PH_WOUT, l)
        RUNB(PH_NORM2, l)
        RUNB(PH_GATHER, l)
        RUNB(PH_MOE1, l)
        RUNB(PH_MOE2, l)
    }
    run_phase<PH_FINAL>(p, 0, smem, sw);
}
#endif
}

extern "C" void kernel_launch(void* const* d_in, const int* in_sizes, int n_in, void* d_out, int out_size, void* d_ws, size_t ws_size, hipStream_t stream) {
    Params p{};
    for (int i = 0; i < N_IN; ++i) p.in[i] = (const float*)d_in[i];
    p.out = (float*)d_out;
    p.ws = (unsigned char*)d_ws;
    (void)in_sizes; (void)n_in; (void)out_size;
    if (ws_size < O_END) return;
#ifndef EMU
    static int grid = 0;
    if (!grid) {
        int dev = 0, cus = 0, per_cu = 0;
        (void)hipGetDevice(&dev);
        (void)hipDeviceGetAttribute(&cus, hipDeviceAttributeMultiprocessorCount, dev);
        (void)hipFuncSetAttribute((const void*)k_mega, hipFuncAttributeMaxDynamicSharedMemorySize, LDS_BYTES);
        (void)hipOccupancyMaxActiveBlocksPerMultiprocessor(&per_cu, (const void*)k_mega, NT, LDS_BYTES);
        (void)hipGetLastError();
        grid = cus;
    }
    (void)hipMemsetAsync(p.ws, 0, ZERO_BYTES, stream);
    hipLaunchKernelGGL(k_mega, dim3(grid), dim3(NT), LDS_BYTES, stream, p);
#else
    memset(p.ws, 0, ZERO_BYTES);
    const int G = 64;
#define LAUNCH(PH, l) emu::launch([=] { k_phase<PH>(p, l); }, dim3(G), dim3(NT))
    LAUNCH(PH_P0, 0);
    for (int l = 0; l < DEPTH; ++l) {
        LAUNCH(PH_NORM1, l); LAUNCH(PH_WIN, l); LAUNCH(PH_PREP, l); LAUNCH(PH_MIX, l); LAUNCH(PH_READOUT, l);
        LAUNCH(PH_MERGE, l); LAUNCH(PH_WOUT, l); LAUNCH(PH_NORM2, l); LAUNCH(PH_GATHER, l); LAUNCH(PH_MOE1, l); LAUNCH(PH_MOE2, l);
    }
    LAUNCH(PH_FINAL, 0);
#endif
}
```

```cpp
#ifndef EMU
#include <hip/hip_runtime.h>
#endif
#include <stdint.h>
#include <stddef.h>

#ifndef CFG_D
#define CFG_D 2048
#define CFG_B 4
#define CFG_L 2048
#define CFG_C 256
#endif
#ifndef PROBE_MASK
#define PROBE_MASK 0
#endif
#ifdef EMU
#define LAS
#else
#define LAS __attribute__((address_space(3)))
#endif
namespace {
constexpr int D = CFG_D, NB = CFG_B, L = CFG_L, C = CFG_C, DEPTH = 2;
constexpr int TC = NB * C, TL = NB * L, T = TC + TL;
constexpr int PGD = D / 16, PW = 4 * PGD;
constexpr int RH = D / 256, RW = RH * 64, DL = D / 32, IL = D / 32, GL = D / 16, RC = 3 * RW + DL + IL + GL;
constexpr int QH = D / 256, KVH = QH / 4, AW = QH * 128, KVW = KVH * 128;
constexpr int IN_DIM = PW + RC + AW + 2 * KVW + 3 * D;
constexpr int OFF_XA = 0, OFF_RW = PW, OFF_Q = PW + RC, OFF_K = OFF_Q + AW, OFF_V = OFF_K + KVW, OFF_GA = OFF_V + KVW, OFF_GB = OFF_GA + D, OFF_GC = OFF_GB + D;
constexpr int DE = D / 4, NE = 32;
constexpr float NORM_EPS = 1e-6f, GN_EPS = 64e-5f;
constexpr int NT = 512, NW = NT / 64;
constexpr int LDS_BYTES = 147456;
static_assert(T % 256 == 0 && TC % 256 == 0 && IN_DIM % 256 == 0 && D % 256 == 0, "tile shapes");

typedef unsigned short bf16_t;
enum { IX = 0, IC, ICTX, ICCTX, IMODW, IMODB, INORM1, IWIN, IPOOLW, IPOOLS, IMU, IDW0, IDUP, IA0, IAUP, IGUP, IKK, IKA, IRK, ILNG, ILNB, ISINK, IPP, IPR, IPA, IWOUT, INORM2, IRGW, IRGB, IREW, IREB, IEWG, IEWU, IEWD, IFG, N_IN };

struct Params { const float* in[N_IN]; float* out; unsigned char* ws; int sw, pad; };

constexpr size_t A256(size_t x) { return (x + 255) & ~(size_t)255; }
constexpr size_t O_BAR = 0;
constexpr size_t O_ECNT = 16384;
constexpr size_t ZERO_BYTES = O_ECNT + 1024;
constexpr int UW = OFF_GA;
constexpr int KCAT = PW + RW + AW;
constexpr int RPAD = 2 * T + NE * 256;
constexpr size_t MAXS(size_t a, size_t b) { return a > b ? a : b; }
constexpr size_t O_X = ZERO_BYTES;
constexpr size_t O_MOD = O_X + A256((size_t)T * D * 4);
constexpr size_t O_HB = O_MOD + A256((size_t)DEPTH * (NB + 1) * 6 * D * 4);
constexpr size_t O_MBB = O_HB, O_H2B = O_HB;
constexpr size_t O_U = O_HB + A256((size_t)T * D * 2);
constexpr size_t O_POOLED = O_U + A256((size_t)T * UW * 4);
constexpr size_t O_LP = O_POOLED;
constexpr size_t O_WRT = O_LP + A256((size_t)DEPTH * NW * 12 * 4 * 1024);
constexpr int LKS = 12;
constexpr size_t O_QB = O_POOLED + A256((size_t)T * PW * 4);
static_assert(O_WRT + (size_t)DEPTH * (4 + NE) * D * 4 <= O_QB, "LoRA fragments and router table must fit the former pooled buffer");
constexpr size_t O_QRB = O_QB + A256((size_t)T * AW * 2);
constexpr size_t O_KB = O_QRB + A256((size_t)TL * AW * 2);
constexpr size_t O_VB = O_KB + A256((size_t)T * KVW * 2);
constexpr size_t O_KR = O_VB + A256((size_t)T * KVW * 2);
constexpr size_t O_RA = O_KR;
constexpr size_t O_V = O_RA;
constexpr size_t O_G = O_V + A256((size_t)T * RW * 4);
constexpr size_t O_BON = O_G + A256((size_t)T * RW * 4);
constexpr size_t O_Y = O_BON + A256((size_t)T * RH * 4);
constexpr size_t O_PACK = O_Y + A256((size_t)2 * T * RW * 4);
constexpr int REC = 1280;
constexpr size_t PACK_BYTES = (size_t)2 * T * RH * REC;
constexpr size_t O_RA_END1 = O_PACK + A256(PACK_BYTES);
constexpr size_t O_H2G = O_RA;
constexpr size_t O_ACTB = O_H2G + A256((size_t)RPAD * D * 2);
constexpr size_t O_YSB = O_ACTB + A256((size_t)RPAD * DE * 2);
constexpr size_t O_RA_END2 = O_YSB + A256((size_t)2 * T * D * 2);
constexpr size_t O_SG = MAXS(O_RA_END1, O_RA_END2);
constexpr size_t O_OCAT = O_SG + A256((size_t)T * 3 * D * 2);
constexpr size_t O_WTP = O_OCAT + A256((size_t)T * KCAT * 2);
constexpr size_t O_SLOTOF = O_WTP + A256((size_t)RPAD * 4);
constexpr size_t O_POS = O_SLOTOF + A256((size_t)RPAD * 4);
constexpr size_t O_EWT = O_POS + A256((size_t)2 * T * 4);
constexpr size_t O_EID = O_EWT + A256((size_t)2 * T * 4);
constexpr size_t O_ROPE = O_EID + A256((size_t)2 * T * 4);
constexpr size_t O_PWS = O_ROPE + A256((size_t)L * 128 * 4);
constexpr size_t O_WINT = O_PWS + A256((size_t)DEPTH * 4 * PGD * PGD * 4);
constexpr size_t O_WMT = O_WINT + A256((size_t)DEPTH * IN_DIM * D * 2);
constexpr size_t O_WOT = O_WMT + A256((size_t)DEPTH * D * KCAT * 2);
constexpr size_t O_EGU = O_WOT + A256((size_t)DEPTH * D * D * 2);
constexpr size_t O_ED = O_EGU + A256((size_t)DEPTH * NE * 2 * DE * D * 2);
constexpr size_t O_END = O_ED + A256((size_t)DEPTH * NE * D * DE * 2);
#define WSF(off) ((float*)(p.ws + (off)))
#define WSI(off) ((int*)(p.ws + (off)))
#define WSH(off) ((bf16_t*)(p.ws + (off)))

__device__ __forceinline__ float sigmoidf_(float x) { return 1.0f / (1.0f + expf(-x)); }
__device__ __forceinline__ float siluf_(float x) { return x * sigmoidf_(x); }
__device__ __forceinline__ float softplusf_(float x) { return fmaxf(x, 0.0f) + log1pf(expf(-fabsf(x))); }
#ifdef EMU
__device__ __forceinline__ bf16_t f2bf(float f) { unsigned u; __builtin_memcpy(&u, &f, 4); u += 0x7FFFu + ((u >> 16) & 1u); return (bf16_t)(u >> 16); }
__device__ __forceinline__ unsigned cvt_pk_bf16(float lo, float hi) { return (unsigned)f2bf(lo) | ((unsigned)f2bf(hi) << 16); }
#else
typedef float cv_f32x2 __attribute__((ext_vector_type(2)));
typedef __bf16 cv_bf16x2 __attribute__((ext_vector_type(2)));
__device__ __forceinline__ unsigned cvt_pk_bf16(float lo, float hi) { const cv_f32x2 v = {lo, hi}; return __builtin_bit_cast(unsigned, __builtin_convertvector(v, cv_bf16x2)); }
__device__ __forceinline__ bf16_t f2bf(float f) { return (bf16_t)(cvt_pk_bf16(f, 0.f) & 0xffffu); }
#endif
__device__ __forceinline__ float bf2f(bf16_t h) { unsigned u = ((unsigned)h) << 16; float f; __builtin_memcpy(&f, &u, 4); return f; }

__device__ __forceinline__ int ltid(int sw) {
#ifdef EMU
    (void)sw; return threadIdx.x;
#else
    int t;
    asm volatile("v_mbcnt_lo_u32_b32 %0, -1, 0\n\tv_mbcnt_hi_u32_b32 %0, -1, %0" : "=v"(t));
    return t | (sw << 6);
#endif
}
__device__ __forceinline__ void seq_info(int r, int& t, int& len, int& modrow) {
    if (r < TC) { t = r % C; len = C; modrow = NB; }
    else { const int q = r - TC; t = q % L; len = L; modrow = q / L; }
}
__device__ __forceinline__ float lane_xor(float v, int lane, int m) {
#ifdef EMU
    (void)lane; return __shfl_xor(v, m);
#else
    return __builtin_bit_cast(float, __builtin_amdgcn_ds_bpermute((lane ^ m) << 2, __builtin_bit_cast(int, v)));
#endif
}
__device__ __forceinline__ float wave_sum(float v, int lane) {
#pragma unroll
    for (int m = 32; m >= 1; m >>= 1) v += lane_xor(v, lane, m);
    return v;
}
__device__ __forceinline__ float wave_max(float v, int lane) {
#pragma unroll
    for (int m = 32; m >= 1; m >>= 1) v = fmaxf(v, lane_xor(v, lane, m));
    return v;
}
__device__ __forceinline__ float block_sum(float v, float* red, const int TX_) {
    v = wave_sum(v, TX_ & 63);
    __syncthreads();
    if ((TX_ & 63) == 0) red[TX_ >> 6] = v;
    __syncthreads();
    float s = 0.f;
#pragma unroll
    for (int i = 0; i < NW; ++i) s += red[i];
    return s;
}
#define PHASE_FN __device__ __forceinline__
#ifdef EMU
#define WAVE_SYNC() emu::wave_sync()
#define WAVE_FENCE()
#else
#define WAVE_SYNC() asm volatile("" ::: "memory")
#define WAVE_FENCE() asm volatile("" ::: "memory")
#endif
#ifdef EMU
#define ACC_PIN12(a)
#define ACC_PIN6(a)
#else
#define ACC_PIN6(a) asm volatile("" : "+v"((a)[0]), "+v"((a)[1]), "+v"((a)[2]), "+v"((a)[3]), "+v"((a)[4]), "+v"((a)[5]))
#define ACC_PIN12(a) asm volatile("" : "+v"((a)[0]), "+v"((a)[1]), "+v"((a)[2]), "+v"((a)[3]), "+v"((a)[4]), "+v"((a)[5]), "+v"((a)[6]), "+v"((a)[7]), "+v"((a)[8]), "+v"((a)[9]), "+v"((a)[10]), "+v"((a)[11]))
#endif

namespace pg8 {
typedef short bf16x8 __attribute__((ext_vector_type(8)));
typedef float f32x4 __attribute__((ext_vector_type(4)));
typedef unsigned u32x4 __attribute__((ext_vector_type(4)));
typedef unsigned u32x2 __attribute__((ext_vector_type(2)));
constexpr int BM = 256, BK = 64, HALF = 128, HTB = HALF * BK * 2, STAGE_BYTES = 8 * HTB, NXCD = 8, WGM = 8;
__host__ __device__ __forceinline__ int lds_byte(int r, int c) { const int st = (r >> 4) * 2 + (c >> 5), rr = r & 15, cc = c & 31, ob = rr * 64 + cc * 2; return st * 1024 + (ob ^ (((ob >> 9) & 1) << 5)); }
__host__ __device__ __forceinline__ void stage_rc(int b, int& R, int& Cc) { const int st = b / 1024, sb = b % 1024, swz = sb ^ (((sb >> 9) & 1) << 5); R = (st >> 1) * 16 + swz / 64; Cc = (st & 1) * 32 + (swz % 64) / 2; }
__host__ __device__ __forceinline__ int perm32(int rho) { const int n = rho >> 4, i = rho & 15; return 8 * (i >> 2) + 4 * n + (i & 3); }
struct Unit { const char* a; const char* b; int pm, pn; };

#ifdef EMU
#define PG8_GLDS(gp, lp) __builtin_memcpy((unsigned char*)(lp) + (threadIdx.x & 63) * 16, (gp), 16)
#define PG8_WAIT_V(n)
#define PG8_WAIT_L(n)
#define PG8_BAR __syncthreads()
#define PG8_SCHED
#define PG8_PRIO(x)
#define PG8_RFL(x) (x)
#define PG8_MEMFENCE
#define PG8_OPAQUE(x)
#else
#define PG8_GLDS(gp, lp) __builtin_amdgcn_global_load_lds((const unsigned*)(gp), (LAS unsigned*)(lp), 16, 0, 0)
#define PG8_WAIT_V(n) asm volatile("s_waitcnt vmcnt(" #n ")" ::: "memory")
#define PG8_WAIT_L(n) asm volatile("s_waitcnt lgkmcnt(" #n ")" ::: "memory")
#define PG8_BAR __builtin_amdgcn_s_barrier()
#define PG8_SCHED __builtin_amdgcn_sched_barrier(0)
#define PG8_PRIO(x) __builtin_amdgcn_s_setprio(x)
#define PG8_RFL(x) __builtin_amdgcn_readfirstlane(x)
#define PG8_MEMFENCE asm volatile("" ::: "memory")
#define PG8_OPAQUE(x) asm volatile("" : "+v"(x))
#endif

struct DenseOrder {
    static constexpr bool GATHER = false;
    const char* A; const char* Bt; size_t tstepA, tstepB; int nM, nN, nwg, G, c, pm0;
    __device__ void init(const void* A_, int lda, const void* Bt_, int ldb, int pm0_, int nM_, int nN_, int G_, int c_) {
        A = (const char*)A_; Bt = (const char*)Bt_; tstepA = (size_t)BM * lda * 2; tstepB = (size_t)BM * ldb * 2; pm0 = pm0_; nM = nM_; nN = nN_; nwg = nM * nN; G = G_; c = c_; }
    __device__ bool next(int i, Unit& u) const {
        const long Lx = (long)i * G + c; if (Lx >= nwg) return false;
        int wgid = (int)Lx; { const int q = nwg / NXCD, r = nwg % NXCD, xcd = wgid % NXCD, off = wgid / NXCD; wgid = (xcd < r ? xcd * (q + 1) : r * (q + 1) + (xcd - r) * q) + off; }
        const int nig = WGM * nN, gid = wgid / nig, fm = gid * WGM, gsz = (nM - fm) < WGM ? (nM - fm) : WGM;
        u.pm = pm0 + fm + ((wgid % nig) % gsz); u.pn = (wgid % nig) / gsz;
        u.a = A + (size_t)u.pm * tstepA; u.b = Bt + (size_t)u.pn * tstepB; return true;
    }
};

struct WinOrder {
    static constexpr bool GATHER = false;
    DenseOrder lat; const char* A; const char* Bt; size_t tstepA, tstepB; int nlat, nctx, G, c; bool all_ctx;
    __device__ void init(const void* A_, const void* Bt_, int lda, int ldb, int G_, int c_, bool all_ctx_) {
        A = (const char*)A_; Bt = (const char*)Bt_; tstepA = (size_t)BM * lda * 2; tstepB = (size_t)BM * ldb * 2; G = G_; c = c_; all_ctx = all_ctx_;
        lat.init(A_, lda, Bt_, ldb, all_ctx_ ? 0 : TC / BM, all_ctx_ ? T / BM : TL / BM, IN_DIM / BM, G_, c_);
        nlat = lat.nwg; nctx = all_ctx_ ? 0 : (TC / BM) * 7; }
    __device__ bool next(int i, Unit& u) const {
        const long Lx = (long)i * G + c;
        if (Lx < nlat) return lat.next(i, u);
        const int j = (int)(Lx - nlat); if (j >= nctx) return false;
        const int q = j % 7; u.pm = j / 7;
        u.pn = (q < 5) ? (OFF_RW + RW) / BM + q : OFF_K / BM + (q - 5);
        u.a = A + (size_t)u.pm * tstepA; u.b = Bt + (size_t)u.pn * tstepB; return true;
    }
};
template <class Epi, class Sched>
__device__ __forceinline__ void gemm_phase(LAS unsigned char* lds, const int lda, const int ldb, const int K, const Sched& S, const Epi& E, const int TX_) {
    const int tid = TX_, wid = PG8_RFL(tid >> 6), lane = tid & 63, wr = wid >> 2, wc = wid & 3, fr = lane & 15, fq = lane >> 4;
    const int nt = K / BK;
    constexpr bool GA = Sched::GATHER;
    unsigned voffA[2], voffB[2];
    int gaR[2], gaC[2];
#pragma unroll
    for (int i = 0; i < 2; ++i) { int R, Cc; stage_rc(tid * 16 + i * 8192, R, Cc); const int Rb = Epi::PERM ? ((R & ~31) + perm32(R & 31)) : R;
        voffA[i] = (unsigned)(R * lda + Cc) * 2u; voffB[i] = (unsigned)(Rb * ldb + Cc) * 2u; gaR[i] = R; gaC[i] = Cc; }
    unsigned vgc[2][2], vgn[2][2];
#define PG8_GAOFF(dst, pm_) do { if constexpr (GA) { _Pragma("unroll") for (int h_ = 0; h_ < 2; ++h_) _Pragma("unroll") for (int i_ = 0; i_ < 2; ++i_) \
        dst[h_][i_] = (S.src_row((pm_), h_ * HALF + gaR[i_]) * (unsigned)lda + (unsigned)gaC[i_]) * 2u; } } while (0)
#define PG8_STAGE_A(bufoff, gptr, h, nextsel) do { if constexpr (GA) { unsigned vs_[2] = {(nextsel) ? vgn[h][0] : vgc[h][0], (nextsel) ? vgn[h][1] : vgc[h][1]}; PG8_STAGE(bufoff, gptr, vs_); } \
        else { PG8_STAGE(bufoff, (gptr) + (h) * hstepA, voffA); } } while (0)
    const size_t kstep = (size_t)(BK * 2);
    const size_t hstepA = (size_t)HALF * lda * 2, hstepB = (size_t)HALF * ldb * 2;
    const unsigned ldsw = (unsigned)wid * 1024u;
    const int aoff = lds_byte(wr * 64 + fr, fq * 8), boff = lds_byte(wc * 32 + fr, fq * 8);
#define PG8_SA(b, h) (((b) * 2 + (h)) * HTB)
#define PG8_SB(b, h) ((4 + (b) * 2 + (h)) * HTB)
#define PG8_STAGE(bufoff, gbase, voff) do { _Pragma("unroll") for (int _i = 0; _i < 2; ++_i) PG8_GLDS((const char*)(gbase) + (voff)[_i], lds + (bufoff) + ldsw + _i * 8192); } while (0)
#define PG8_LDA(dst, b, h) do { _Pragma("unroll") for (int m = 0; m < 4; ++m) _Pragma("unroll") for (int k = 0; k < 2; ++k) dst[m][k] = *(const LAS bf16x8*)(lds + PG8_SA(b, h) + aoff + m * 2048 + k * 1024); } while (0)
#define PG8_LDB(dst, b, h) do { _Pragma("unroll") for (int n = 0; n < 2; ++n) _Pragma("unroll") for (int k = 0; k < 2; ++k) dst[n][k] = *(const LAS bf16x8*)(lds + PG8_SB(b, h) + boff + n * 2048 + k * 1024); } while (0)
#define PG8_MMA(ai, bj, At, Bt) do { PG8_PRIO(1); _Pragma("unroll") for (int m = 0; m < 4; ++m) _Pragma("unroll") for (int n = 0; n < 2; ++n) _Pragma("unroll") for (int k = 0; k < 2; ++k) \
        acc[ai][bj][m][n] = __builtin_amdgcn_mfma_f32_16x16x32_bf16(Bt[n][k], At[m][k], acc[ai][bj][m][n], 0, 0, 0); PG8_PRIO(0); } while (0)
    Unit cur, nxt; int ui = 0;
    if (!S.next(0, cur)) return;
    f32x4 acc[2][2][4][2];
#pragma unroll
    for (int a = 0; a < 2; ++a)
#pragma unroll
        for (int b = 0; b < 2; ++b)
#pragma unroll
            for (int m = 0; m < 4; ++m)
#pragma unroll
                for (int n = 0; n < 2; ++n) acc[a][b][m][n] = (f32x4){0.f, 0.f, 0.f, 0.f};
    bf16x8 At[4][2], B0[2][2], B1[2][2];
    const char* cA = cur.a; const char* cB = cur.b;
    PG8_GAOFF(vgc, cur.pm);
    PG8_STAGE(PG8_SB(0, 0), cB, voffB); PG8_STAGE_A(PG8_SA(0, 0), cA, 0, false); PG8_STAGE(PG8_SB(0, 1), cB + hstepB, voffB); PG8_STAGE_A(PG8_SA(0, 1), cA, 1, false);
    if (wr == 1) PG8_BAR;
    PG8_WAIT_V(4); PG8_BAR;
    PG8_STAGE(PG8_SB(1, 0), cB + kstep, voffB); PG8_STAGE_A(PG8_SA(1, 0), cA + kstep, 0, false); PG8_STAGE(PG8_SB(1, 1), cB + hstepB + kstep, voffB);
    PG8_WAIT_V(6); PG8_BAR;
    for (;;) {
        const bool has_next = S.next(ui + 1, nxt);
        const char* nA = has_next ? nxt.a : cA; const char* nB = has_next ? nxt.b : cB;
        if (has_next) PG8_GAOFF(vgn, nxt.pm); else { if constexpr (GA) { vgn[0][0] = vgc[0][0]; vgn[0][1] = vgc[0][1]; vgn[1][0] = vgc[1][0]; vgn[1][1] = vgc[1][1]; } }
        int t = 0;
#pragma unroll 1
        for (int seg = 0; seg < Epi::NSEG; ++seg) {
        const int tend = Epi::seg_end(seg, nt);
#pragma unroll 1
        for (; t < tend; t += 2) {
            const bool last = (t == nt - 2);
            const char* a1 = cA + (size_t)(t + 1) * kstep;
            const char* a2 = last ? nA : cA + (size_t)(t + 2) * kstep; const char* b2 = last ? nB : cB + (size_t)(t + 2) * kstep;
            const char* a3 = a2 + kstep; const char* b3 = b2 + kstep;
            PG8_LDB(B0, 0, 0); PG8_SCHED; PG8_LDA(At, 0, 0); PG8_STAGE_A(PG8_SA(1, 1), a1, 1, false);
            PG8_WAIT_L(8); PG8_BAR; PG8_WAIT_L(0); PG8_MMA(0, 0, At, B0); PG8_BAR; PG8_SCHED;
            PG8_LDB(B1, 0, 1); PG8_STAGE(PG8_SB(0, 0), b2, voffB);
            PG8_BAR; PG8_WAIT_L(0); PG8_MMA(0, 1, At, B1); PG8_BAR;
            PG8_LDA(At, 0, 1); PG8_STAGE_A(PG8_SA(0, 0), a2, 0, last);
            PG8_BAR; PG8_WAIT_L(0); PG8_MMA(1, 0, At, B0); PG8_BAR; PG8_SCHED;
            PG8_STAGE(PG8_SB(0, 1), b2 + hstepB, voffB);
            PG8_WAIT_V(6); PG8_BAR; PG8_MMA(1, 1, At, B1); PG8_BAR;
            PG8_LDB(B0, 1, 0); PG8_SCHED; PG8_LDA(At, 1, 0); PG8_STAGE_A(PG8_SA(0, 1), a2, 1, last);
            PG8_WAIT_L(8); PG8_BAR; PG8_WAIT_L(0); PG8_MMA(0, 0, At, B0); PG8_BAR; PG8_SCHED;
            PG8_LDB(B1, 1, 1); PG8_STAGE(PG8_SB(1, 0), b3, voffB);
            PG8_BAR; PG8_WAIT_L(0); PG8_MMA(0, 1, At, B1); PG8_BAR;
            PG8_LDA(At, 1, 1); PG8_STAGE_A(PG8_SA(1, 0), a3, 0, last);
            PG8_BAR; PG8_WAIT_L(0); PG8_MMA(1, 0, At, B0); PG8_BAR; PG8_SCHED;
            PG8_STAGE(PG8_SB(1, 1), b3 + hstepB, voffB);
            PG8_WAIT_V(6); PG8_BAR; PG8_MMA(1, 1, At, B1); PG8_BAR;
        }
        if constexpr (Epi::NSEG > 1) { if (seg + 1 < Epi::NSEG) E.mid(acc, cur, seg, wr, wc, fr, fq); }
        }
        E(acc, cur, wr, wc, fr, fq);
        if (!has_next) break;
#pragma unroll
        for (int a = 0; a < 2; ++a)
#pragma unroll
            for (int b = 0; b < 2; ++b)
#pragma unroll
                for (int m = 0; m < 4; ++m)
#pragma unroll
                    for (int n = 0; n < 2; ++n) acc[a][b][m][n] = (f32x4){0.f, 0.f, 0.f, 0.f};
        cur = nxt; cA = nA; cB = nB; ++ui;
        if constexpr (GA) { vgc[0][0] = vgn[0][0]; vgc[0][1] = vgn[0][1]; vgc[1][0] = vgn[1][0]; vgc[1][1] = vgn[1][1]; }
    }
    PG8_WAIT_V(0);
    if (wr == 0) PG8_BAR;
    PG8_BAR;
#undef PG8_SA
#undef PG8_SB
#undef PG8_STAGE
#undef PG8_STAGE_A
#undef PG8_GAOFF
#undef PG8_LDA
#undef PG8_LDB
#undef PG8_MMA
}

__device__ __forceinline__ unsigned pk_bf16(float lo, float hi) { return cvt_pk_bf16(lo, hi); }
__device__ __forceinline__ float frcp(float x) {
#ifdef EMU
    return 1.0f / x;
#else
    return __builtin_amdgcn_rcpf(x);
#endif
}
__device__ __forceinline__ float fsig(float x) { return frcp(1.0f + __expf(-x)); }

__device__ __forceinline__ float lane_swap1(float v) {
#ifdef EMU
    return __shfl_xor(v, 1);
#else
    return __builtin_bit_cast(float, __builtin_amdgcn_update_dpp(0, __builtin_bit_cast(int, v), 0xB1, 0xf, 0xf, false));
#endif
}
__device__ __forceinline__ f32x4 lane_swap1(f32x4 v) { const float a = v[0], b = v[1], c = v[2], d = v[3]; f32x4 r; r[0] = lane_swap1(a); r[1] = lane_swap1(b); r[2] = lane_swap1(c); r[3] = lane_swap1(d); return r; }
__device__ __forceinline__ void pair_rows(const f32x4& A, const f32x4& B, bool odd, f32x4& S1, f32x4& S2) {
    const f32x4 X = lane_swap1(A), Y = lane_swap1(B);
    S1 = odd ? Y : A; S2 = odd ? B : X;
}
struct EpiWin {
    static constexpr bool PERM = true; static constexpr int NSEG = 1;
    static __device__ __forceinline__ int seg_end(int, int nt) { return nt; }
    float* U; bf16_t* SG;
    __device__ __forceinline__ void operator()(const f32x4 (&acc)[2][2][4][2], const Unit& u, int wr, int wc, int fr_in, int fq_in) const {
        int fr = fr_in, fq = fq_in; PG8_OPAQUE(fr); PG8_OPAQUE(fq);
        const int row0 = u.pm * BM + wr * 64 + fr, col0 = u.pn * BM + wc * 32 + 8 * fq;
        if (u.pn * BM >= OFF_GA) {
#pragma unroll
            for (int ai = 0; ai < 2; ++ai)
#pragma unroll
                for (int m = 0; m < 4; ++m) { bf16_t* rowp = SG + (size_t)(row0 + ai * HALF + m * 16) * (3 * D) + (col0 - OFF_GA);
#pragma unroll
                    for (int bj = 0; bj < 2; ++bj) { const f32x4 v0 = acc[ai][bj][m][0], v1 = acc[ai][bj][m][1]; u32x4 o;
                        o[0] = pk_bf16(fsig(v0[0]), fsig(v0[1])); o[1] = pk_bf16(fsig(v0[2]), fsig(v0[3])); o[2] = pk_bf16(fsig(v1[0]), fsig(v1[1])); o[3] = pk_bf16(fsig(v1[2]), fsig(v1[3]));
                        *(u32x4*)(rowp + bj * HALF) = o; } }
        } else {
            const bool odd = fr & 1;
#pragma unroll
            for (int ai = 0; ai < 2; ++ai)
#pragma unroll
                for (int m = 0; m < 4; ++m) { float* pe = U + (size_t)((row0 + ai * HALF + m * 16) & ~1) * UW + col0 + (odd ? 4 : 0);
#pragma unroll
                    for (int bj = 0; bj < 2; ++bj) { f32x4 S1, S2; pair_rows(acc[ai][bj][m][0], acc[ai][bj][m][1], odd, S1, S2);
                        *(f32x4*)(pe + bj * HALF) = S1; *(f32x4*)(pe + UW + bj * HALF) = S2; } }
        }
    }
};
struct EpiMerge {
    static constexpr bool PERM = true; static constexpr int NSEG = 3;
    static __device__ __forceinline__ int seg_end(int seg, int nt) { return seg == 0 ? PW / BK : (seg == 1 ? (PW + RW) / BK : nt); }
    const bf16_t* SG; bf16_t* O;
    __device__ __forceinline__ void mid(f32x4 (&acc)[2][2][4][2], const Unit& u, int which, int wr, int wc, int fr_in, int fq_in) const {
        int fr = fr_in, fq = fq_in; PG8_OPAQUE(fr); PG8_OPAQUE(fq);
        const int row0 = u.pm * BM + wr * 64 + fr, col0 = u.pn * BM + wc * 32 + 8 * fq;
#pragma unroll
        for (int ai = 0; ai < 2; ++ai)
#pragma unroll
            for (int m = 0; m < 4; ++m) { const bf16_t* rowp = SG + (size_t)(row0 + ai * HALF + m * 16) * (3 * D) + which * D + col0;
#pragma unroll
                for (int bj = 0; bj < 2; ++bj) {
                    const uint4 nu = *(const uint4*)(rowp + bj * HALF), de = *(const uint4*)(rowp + D + bj * HALF);
                    const unsigned nw[4] = {nu.x, nu.y, nu.z, nu.w}, dw[4] = {de.x, de.y, de.z, de.w};
#pragma unroll
                    for (int q = 0; q < 4; ++q) {
                        const float n0 = bf2f((bf16_t)(nw[q] & 0xffffu)), n1 = bf2f((bf16_t)(nw[q] >> 16)), d0 = bf2f((bf16_t)(dw[q] & 0xffffu)), d1 = bf2f((bf16_t)(dw[q] >> 16));
                        acc[ai][bj][m][q >> 1][2 * (q & 1)] *= n0 * frcp(d0); acc[ai][bj][m][q >> 1][2 * (q & 1) + 1] *= n1 * frcp(d1); } }
                PG8_MEMFENCE; }
    }
    __device__ __forceinline__ void operator()(const f32x4 (&acc)[2][2][4][2], const Unit& u, int wr, int wc, int fr_in, int fq_in) const {
        int fr = fr_in, fq = fq_in; PG8_OPAQUE(fr); PG8_OPAQUE(fq);
        const int row0 = u.pm * BM + wr * 64 + fr, col0 = u.pn * BM + wc * 32 + 8 * fq;
#pragma unroll
        for (int ai = 0; ai < 2; ++ai)
#pragma unroll
            for (int m = 0; m < 4; ++m) { const size_t ro = (size_t)(row0 + ai * HALF + m * 16);
#pragma unroll
                for (int bj = 0; bj < 2; ++bj) {
                    const uint4 sc = *(const uint4*)(SG + ro * (3 * D) + 2 * D + col0 + bj * HALF);
                    const unsigned sw[4] = {sc.x, sc.y, sc.z, sc.w}; unsigned ow[4];
#pragma unroll
                    for (int q = 0; q < 4; ++q) { const float s0 = bf2f((bf16_t)(sw[q] & 0xffffu)), s1 = bf2f((bf16_t)(sw[q] >> 16));
                        ow[q] = pk_bf16(acc[ai][bj][m][q >> 1][2 * (q & 1)] * s0, acc[ai][bj][m][q >> 1][2 * (q & 1) + 1] * s1); }
                    *(uint4*)(O + ro * D + col0 + bj * HALF) = make_uint4(ow[0], ow[1], ow[2], ow[3]); }
                PG8_MEMFENCE; }
    }
};
struct EpiWout {
    static constexpr bool PERM = false; static constexpr int NSEG = 1;
    static __device__ __forceinline__ int seg_end(int, int nt) { return nt; }
    float* X; const float* MODL; const float* inC; const float* inX;
    __device__ __forceinline__ void operator()(const f32x4 (&acc)[2][2][4][2], const Unit& u, int wr, int wc, int fr_in, int fq_in) const {
        int fr = fr_in, fq = fq_in; PG8_OPAQUE(fr); PG8_OPAQUE(fq);
        const int row0 = u.pm * BM + wr * 64 + fr, col0 = u.pn * BM + wc * 32 + 4 * fq;
        const int mr = (u.pm < TC / BM) ? NB : (u.pm - TC / BM) / (L / BM);
        const float* g1 = MODL + (size_t)mr * 6 * D + 2 * D + col0;
        f32x4 gv[2][2];
#pragma unroll
        for (int bj = 0; bj < 2; ++bj)
#pragma unroll
            for (int n = 0; n < 2; ++n) gv[bj][n] = *(const f32x4*)(g1 + bj * HALF + n * 16);
#pragma unroll
        for (int ai = 0; ai < 2; ++ai)
#pragma unroll
            for (int m = 0; m < 4; ++m) { const int row = row0 + ai * HALF + m * 16; float* rowp = X + (size_t)row * D + col0;
                const float* srcp = inX ? ((u.pm < TC / BM) ? inC + (size_t)row * D + col0 : inX + (size_t)(row - TC) * D + col0) : rowp;
#pragma unroll
                for (int bj = 0; bj < 2; ++bj)
#pragma unroll
                    for (int n = 0; n < 2; ++n) { *(f32x4*)(rowp + bj * HALF + n * 16) = *(const f32x4*)(srcp + bj * HALF + n * 16) + gv[bj][n] * acc[ai][bj][m][n]; } }
    }
};
struct EpiSwiglu {
    static constexpr bool PERM = true; static constexpr int NSEG = 1;
    static __device__ __forceinline__ int seg_end(int, int nt) { return nt; }
    bf16_t* ACT; const float* WTP;
    __device__ __forceinline__ void operator()(const f32x4 (&acc)[2][2][4][2], const Unit& u, int wr, int wc, int fr_in, int fq_in) const {
        int fr = fr_in, fq = fq_in; PG8_OPAQUE(fr); PG8_OPAQUE(fq);
        const int row0 = u.pm * BM + wr * 64 + fr, col0 = u.pn * HALF + wc * 32 + 8 * fq;
#pragma unroll
        for (int ai = 0; ai < 2; ++ai)
#pragma unroll
            for (int m = 0; m < 4; ++m) { const size_t ro = (size_t)(row0 + ai * HALF + m * 16); const float wt = WTP[ro]; unsigned ow[4];
#pragma unroll
                for (int q = 0; q < 4; ++q) { const int n = q >> 1, j = 2 * (q & 1);
                    const float g0 = acc[ai][0][m][n][j], g1 = acc[ai][0][m][n][j + 1], u0 = acc[ai][1][m][n][j], u1 = acc[ai][1][m][n][j + 1];
                    ow[q] = pk_bf16(g0 * fsig(g0) * u0 * wt, g1 * fsig(g1) * u1 * wt); }
                *(uint4*)(ACT + ro * DE + col0) = make_uint4(ow[0], ow[1], ow[2], ow[3]); PG8_MEMFENCE; }
    }
};
struct EpiDown {
    static constexpr bool PERM = true; static constexpr int NSEG = 1;
    static __device__ __forceinline__ int seg_end(int, int nt) { return nt; }
    bf16_t* YSB; const int* SLOTOF;
    __device__ __forceinline__ void operator()(const f32x4 (&acc)[2][2][4][2], const Unit& u, int wr, int wc, int fr_in, int fq_in) const {
        int fr = fr_in, fq = fq_in; PG8_OPAQUE(fr); PG8_OPAQUE(fq);
        const int row0 = u.pm * BM + wr * 64 + fr, col0 = u.pn * BM + wc * 32 + 8 * fq;
#pragma unroll
        for (int ai = 0; ai < 2; ++ai)
#pragma unroll
            for (int m = 0; m < 4; ++m) { const int slot = SLOTOF[row0 + ai * HALF + m * 16];
                if (slot >= 0) {
#pragma unroll
                    for (int bj = 0; bj < 2; ++bj) { unsigned ow[4];
#pragma unroll
                        for (int q = 0; q < 4; ++q) ow[q] = pk_bf16(acc[ai][bj][m][q >> 1][2 * (q & 1)], acc[ai][bj][m][q >> 1][2 * (q & 1) + 1]);
                        *(uint4*)(YSB + (size_t)slot * D + col0 + bj * HALF) = make_uint4(ow[0], ow[1], ow[2], ow[3]); } }
                PG8_MEMFENCE; }
    }
};
struct MoeOrder {
    static constexpr bool GATHER = false;
    const char* A; const char* Bt; size_t tstepA, estepB, tstepB; int nN, G, c; const LAS int* toff;
    __device__ bool next(int i, Unit& u) const {
        const int Lx = i * G + c; const int total = toff[NE] * nN; if (Lx >= total) return false;
        const int rt = Lx / nN, pn = Lx % nN; int e = 0;
        for (int q = 1; q < NE; ++q) e = (rt >= toff[q]) ? q : e;
        u.pm = rt; u.pn = pn; u.a = A + (size_t)rt * tstepA; u.b = Bt + (size_t)e * estepB + (size_t)pn * tstepB; return true;
    }
};
struct MoeGatherOrder {
    static constexpr bool GATHER = true;
    const char* A; const char* Bt; size_t estepB, tstepB; int nN, G, c; const LAS int* toff; const int* slotof;
    __device__ bool next(int i, Unit& u) const {
        const int Lx = i * G + c; const int total = toff[NE] * nN; if (Lx >= total) return false;
        const int rt = Lx / nN, pn = Lx % nN; int e = 0;
        for (int q = 1; q < NE; ++q) e = (rt >= toff[q]) ? q : e;
        u.pm = rt; u.pn = pn; u.a = A; u.b = Bt + (size_t)e * estepB + (size_t)pn * tstepB; return true;
    }
    __device__ __forceinline__ unsigned src_row(int pm, int r) const { const int sl = slotof[pm * BM + r]; return (unsigned)(sl < 0 ? 0 : (sl >> 1)); }
};
}

__device__ __forceinline__ void conv_tile(const float* src, int ld_src, bf16_t* dst, int ld_dst, int kt, float* lds, const int TX_) {
    const int tid = TX_;
    float* tb = lds;
    __syncthreads();
#pragma unroll
    for (int i = 0; i < 4; ++i) {
        const int idx = tid + i * NT, kr = idx >> 4, c4 = (idx & 15) * 4;
        const float4 v = *(const float4*)(src + (size_t)(kt * 128 + kr) * ld_src + c4);
        tb[kr * 65 + c4] = v.x; tb[kr * 65 + c4 + 1] = v.y; tb[kr * 65 + c4 + 2] = v.z; tb[kr * 65 + c4 + 3] = v.w;
    }
    __syncthreads();
    const int n = tid >> 3, kq = (tid & 7) * 16;
    unsigned w[8];
#pragma unroll
    for (int j = 0; j < 8; ++j) { const unsigned lo = f2bf(tb[(kq + 2 * j) * 65 + n]), hi = f2bf(tb[(kq + 2 * j + 1) * 65 + n]); w[j] = lo | (hi << 16); }
    uint4* dp = (uint4*)(dst + (size_t)n * ld_dst + kt * 128 + kq);
    dp[0] = make_uint4(w[0], w[1], w[2], w[3]); dp[1] = make_uint4(w[4], w[5], w[6], w[7]);
}
PHASE_FN void ph_conv_win0(const Params& p, float* lds) {
    const int TX_ = ltid(p.sw);
    const float* src = p.in[IWIN]; bf16_t* dst = WSH(O_WINT);
    for (int it = blockIdx.x; it < (D / 128) * (IN_DIM / 64); it += gridDim.x) { const int kt = it % (D / 128), nt = it / (D / 128); conv_tile(src + nt * 64, IN_DIM, dst + (size_t)nt * 64 * D, D, kt, lds, TX_); }
    __syncthreads();
}
PHASE_FN void ph_conv_layer(const Params& p, int l, float* lds, bool with_win) {
    const int TX_ = ltid(p.sw);
    const int G = gridDim.x; int base = 0;
#define CONV_JOB(NTILES, ...) { const int start_ = ((int)blockIdx.x - base % G + G) % G; for (int it = start_; it < (NTILES); it += G) { __VA_ARGS__ } base += (NTILES); }
    if (with_win) {
        const float* src = p.in[IWIN] + (size_t)l * D * IN_DIM; bf16_t* dst = WSH(O_WINT) + (size_t)l * IN_DIM * D;
        CONV_JOB((D / 128) * (IN_DIM / 64), { const int kt = it % (D / 128), nt = it / (D / 128); conv_tile(src + nt * 64, IN_DIM, dst + (size_t)nt * 64 * D, D, kt, lds, TX_); })
    }
    {
        bf16_t* dst = WSH(O_WMT) + (size_t)l * D * KCAT;
        const float* s0 = p.in[IPP] + (size_t)l * PW * D; const float* s1 = p.in[IPR] + (size_t)l * RW * D; const float* s2 = p.in[IPA] + (size_t)l * AW * D;
        CONV_JOB((PW / 128) * (D / 64), { const int kt = it % (PW / 128), nt = it / (PW / 128); conv_tile(s0 + nt * 64, D, dst + (size_t)nt * 64 * KCAT, KCAT, kt, lds, TX_); })
        CONV_JOB((RW / 128) * (D / 64), { const int kt = it % (RW / 128), nt = it / (RW / 128); conv_tile(s1 + nt * 64, D, dst + (size_t)nt * 64 * KCAT + PW, KCAT, kt, lds, TX_); })
        CONV_JOB((AW / 128) * (D / 64), { const int kt = it % (AW / 128), nt = it / (AW / 128); conv_tile(s2 + nt * 64, D, dst + (size_t)nt * 64 * KCAT + PW + RW, KCAT, kt, lds, TX_); })
    }
    {
        const float* src = p.in[IWOUT] + (size_t)l * D * D; bf16_t* dst = WSH(O_WOT) + (size_t)l * D * D;
        CONV_JOB((D / 128) * (D / 64), { const int kt = it % (D / 128), nt = it / (D / 128); conv_tile(src + nt * 64, D, dst + (size_t)nt * 64 * D, D, kt, lds, TX_); })
    }
    {
        constexpr int TPE = (D / 128) * (DE / 64);
        CONV_JOB(NE * 2 * TPE, { const int e = it / (2 * TPE), rem = it % (2 * TPE), which = rem / TPE, r2 = rem % TPE, kt = r2 % (D / 128), nt = r2 / (D / 128);
            const float* src = p.in[which ? IEWU : IEWG] + ((size_t)l * NE + e) * D * DE + nt * 64;
            const int drow = (nt >> 1) * 256 + which * 128 + (nt & 1) * 64;
            conv_tile(src, DE, WSH(O_EGU) + (((size_t)l * NE + e) * 2 * DE + drow) * D, D, kt, lds, TX_); })
    }
    {
        constexpr int TPE = (DE / 128) * (D / 64);
        CONV_JOB(NE * TPE, { const int e = it / TPE, r2 = it % TPE, kt = r2 % (DE / 128), nt = r2 / (DE / 128);
            conv_tile(p.in[IEWD] + ((size_t)l * NE + e) * DE * D + nt * 64, D, WSH(O_ED) + (((size_t)l * NE + e) * D + nt * 64) * DE, DE, kt, lds, TX_); })
    }
#undef CONV_JOB
    __syncthreads();
}

PHASE_FN void ph_copy(const Params& p) {
    const int TX_ = ltid(p.sw);
    const int gt = blockIdx.x * NT + TX_, gs = gridDim.x * NT;
    float4* X4 = (float4*)WSF(O_X);
    const float4* c4 = (const float4*)p.in[ICTX]; const float4* x4 = (const float4*)p.in[IX];
    for (long i = gt; i < (long)T * D / 4; i += gs) X4[i] = (i < (long)TC * D / 4) ? c4[i] : x4[i - (long)TC * D / 4];
}
PHASE_FN void ph_rope_table(const Params& p) {
    const int TX_ = ltid(p.sw);
    const int gt = blockIdx.x * NT + TX_, gs = gridDim.x * NT;
    for (int i = gt; i < L * 64; i += gs) {
        const int t = i >> 6, j = i & 63, ax = j >> 5, f = j & 31;
        const float inv = powf(10000.0f, -(float)(2 * f) / 64.0f);
        const float ang = (ax == 0 ? (float)(t / 64) : (float)(t % 64)) * inv;
        WSF(O_ROPE)[(size_t)t * 128 + j] = cosf(ang); WSF(O_ROPE)[(size_t)t * 128 + 64 + j] = sinf(ang);
    }
}
PHASE_FN void ph_pws(const Params& p) {
    const int TX_ = ltid(p.sw);
    for (int i = blockIdx.x * NT + TX_; i < DEPTH * 4 * PGD * PGD; i += gridDim.x * NT) {
        const int d = i % PGD, g = (i / (PGD * PGD)) % 4, l = i / (4 * PGD * PGD);
        WSF(O_PWS)[i] = p.in[IPOOLW][i] * p.in[IPOOLS][l * PW + g * PGD + d];
    }
}
PHASE_FN void ph_lora_pack(const Params& p) {
    const int TX_ = ltid(p.sw);
    const float* pgu = p.in[IGUP]; const float* pdu = p.in[IDUP]; const float* pau = p.in[IAUP];
#ifndef EMU
    asm volatile("" : "+s"(pgu), "+s"(pdu), "+s"(pau));
#endif
    for (int i = blockIdx.x * NT + TX_; i < DEPTH * NW * LKS * 4 * 64; i += gridDim.x * NT) {
        const int lane = i & 63, nt = (i >> 6) & 3, ks = (i >> 8) % LKS, w = (i / (256 * LKS)) % NW, l = i / (256 * LKS * NW);
        const int ch = w * 64 + (lane & 15) * 4 + nt;
        const float* src; int k0;
        if (ks < 4) { src = pgu + (size_t)l * GL * RW; k0 = ks * 32; }
        else if (ks < 8) { src = pdu + (size_t)(l * 2 + ((ks - 4) >> 1)) * DL * RW; k0 = ((ks - 4) & 1) * 32; }
        else { src = pau + (size_t)(l * 2 + ((ks - 8) >> 1)) * IL * RW; k0 = ((ks - 8) & 1) * 32; }
        k0 += (lane >> 4) * 8;
        const float* q = src + (size_t)k0 * RW + ch;
        const float x0 = q[0], x1 = q[RW], x2 = q[2 * RW], x3 = q[3 * RW], x4 = q[4 * RW], x5 = q[5 * RW], x6 = q[6 * RW], x7 = q[7 * RW];
        const bf16_t h0 = f2bf(x0), h1 = f2bf(x1), h2 = f2bf(x2), h3 = f2bf(x3), h4 = f2bf(x4), h5 = f2bf(x5), h6 = f2bf(x6), h7 = f2bf(x7);
        uint4 hi;
        hi.x = (unsigned)h0 | ((unsigned)h1 << 16); hi.y = (unsigned)h2 | ((unsigned)h3 << 16); hi.z = (unsigned)h4 | ((unsigned)h5 << 16); hi.w = (unsigned)h6 | ((unsigned)h7 << 16);
        ((uint4*)(p.ws + O_LP + (size_t)(i >> 6) * 1024))[lane] = hi;
    }
}
PHASE_FN void ph_router_pack(const Params& p) {
    const int TX_ = ltid(p.sw);
    for (int i = blockIdx.x * NT + TX_; i < DEPTH * (4 + NE) * D; i += gridDim.x * NT) {
        const int k = i % D, q = (i / D) % (4 + NE), l = i / (D * (4 + NE));
        WSF(O_WRT)[i] = (q < 4) ? p.in[IRGW][((size_t)l * D + k) * 4 + q] : p.in[IREW][((size_t)l * D + k) * NE + (q - 4)];
    }
}
PHASE_FN void ph_mod(const Params& p, float* lds) {
    const int TX_ = ltid(p.sw);
    float* sl = lds;
    float* red = lds + (NB + 1) * D;
    const int tid = TX_, kg = tid >> 3, cq = tid & 7;
    const int nitems = DEPTH * 6 * D / 32;
    if ((int)blockIdx.x < nitems) {
        for (int i = tid; i < (NB + 1) * D; i += NT) sl[i] = siluf_(i < NB * D ? p.in[IC][i] : p.in[ICCTX][i - NB * D]);
        __syncthreads();
        for (int it = blockIdx.x; it < nitems; it += gridDim.x) {
            const int l = it / (6 * D / 32), n0 = (it % (6 * D / 32)) * 32;
            float acc[NB + 1][4];
#pragma unroll
            for (int j = 0; j <= NB; ++j)
#pragma unroll
                for (int q = 0; q < 4; ++q) acc[j][q] = 0.f;
            const float* w = p.in[IMODW] + (size_t)l * D * 6 * D + n0 + cq * 4;
#pragma unroll 1
            for (int k0 = kg; k0 < D; k0 += 64 * 8) {
                float4 wv[8];
#pragma unroll
                for (int u = 0; u < 8; ++u) wv[u] = *(const float4*)(w + (size_t)(k0 + 64 * u) * 6 * D);
#pragma unroll
                for (int u = 0; u < 8; ++u)
#pragma unroll
                    for (int j = 0; j <= NB; ++j) { const float sv = sl[j * D + k0 + 64 * u]; acc[j][0] += sv * wv[u].x; acc[j][1] += sv * wv[u].y; acc[j][2] += sv * wv[u].z; acc[j][3] += sv * wv[u].w; }
            }
            __syncthreads();
#pragma unroll
            for (int j = 0; j <= NB; ++j)
#pragma unroll
                for (int q = 0; q < 4; ++q) red[(kg * (NB + 1) + j) * 32 + cq * 4 + q] = acc[j][q];
            __syncthreads();
            if (tid < (NB + 1) * 32) {
                const int j = tid / 32, cc = tid % 32;
                float sum = 0.f;
                for (int g = 0; g < 64; ++g) sum += red[(g * (NB + 1) + j) * 32 + cc];
                WSF(O_MOD)[((size_t)l * (NB + 1) + j) * 6 * D + n0 + cc] = sum + p.in[IMODB][l * 6 * D + n0 + cc];
            }
        }
    }
    __syncthreads();
}
PHASE_FN void ph_norm1(const Params& p, int l, int mode, bool dry = false) {
    const int TX_ = ltid(p.sw);
    const int wave = TX_ >> 6, lane = TX_ & 63;
    const int r_begin = (mode == 2) ? TC : 0;
    const int lp = (mode == 2) ? DEPTH - 1 : l - 1;
    for (int r = r_begin + blockIdx.x * NW + wave; r < T; r += gridDim.x * NW) {
        int t, len, mr; seq_info(r, t, len, mr);
        float* xr = WSF(O_X) + (size_t)r * D;
        const float* xsrc = (mode == 0 && l == 0) ? ((r < TC) ? p.in[ICTX] + (size_t)r * D : p.in[IX] + (size_t)(r - TC) * D) : xr;
        const bool comb = (lp >= 0) && (lp != DEPTH - 1 || r >= TC);
        float4 v[D / 256];
        float ss = 0.f;
#pragma unroll
        for (int i = 0; i < D / 256; ++i) {
            const int c = (i * 64 + lane) * 4;
            float4 x = *(const float4*)(xsrc + c);
            if (comb) {
                const float4 g2 = *(const float4*)(WSF(O_MOD) + ((size_t)lp * (NB + 1) + mr) * 6 * D + 5 * D + c);
                const uint2 y0 = *(const uint2*)(WSH(O_YSB) + (size_t)(2 * r) * D + c), y1 = *(const uint2*)(WSH(O_YSB) + (size_t)(2 * r + 1) * D + c);
                x.x += g2.x * (bf2f((bf16_t)(y0.x & 0xffffu)) + bf2f((bf16_t)(y1.x & 0xffffu))); x.y += g2.y * (bf2f((bf16_t)(y0.x >> 16)) + bf2f((bf16_t)(y1.x >> 16)));
                x.z += g2.z * (bf2f((bf16_t)(y0.y & 0xffffu)) + bf2f((bf16_t)(y1.y & 0xffffu))); x.w += g2.w * (bf2f((bf16_t)(y0.y >> 16)) + bf2f((bf16_t)(y1.y >> 16)));
                if (!dry) *(float4*)(xr + c) = x;
            }
            v[i] = x; ss += x.x * x.x + x.y * x.y + x.z * x.z + x.w * x.w;
        }
        ss = wave_sum(ss, lane);
        const float rs = rsqrtf(ss / (float)D + NORM_EPS);
#pragma unroll
        for (int i = 0; i < D / 256; ++i) {
            const int c = (i * 64 + lane) * 4;
            if (mode == 2) {
                const float4 g = *(const float4*)(p.in[IFG] + c);
                *(float4*)(p.out + (size_t)(r - TC) * D + c) = make_float4(v[i].x * rs * g.x, v[i].y * rs * g.y, v[i].z * rs * g.z, v[i].w * rs * g.w);
            } else {
                const float* md = WSF(O_MOD) + ((size_t)l * (NB + 1) + mr) * 6 * D;
                const float4 g = *(const float4*)(p.in[INORM1] + l * D + c), sh = *(const float4*)(md + c), sc = *(const float4*)(md + D + c);
                const float h0 = (v[i].x * rs * g.x) * (1.0f + sc.x) + sh.x, h1 = (v[i].y * rs * g.y) * (1.0f + sc.y) + sh.y;
                const float h2 = (v[i].z * rs * g.z) * (1.0f + sc.z) + sh.z, h3 = (v[i].w * rs * g.w) * (1.0f + sc.w) + sh.w;
                uint2 o; o.x = (unsigned)f2bf(h0) | ((unsigned)f2bf(h1) << 16); o.y = (unsigned)f2bf(h2) | ((unsigned)f2bf(h3) << 16);
                *(uint2*)(WSH(O_HB) + (size_t)r * D + c) = o;
            }
        }
    }
}

constexpr int GT_M = NT / 4;
__device__ __forceinline__ void gemm_tile(const float* A, int lda, const int* aidx, int ashift, int mvalid, int m0, const float* B, int ldb, int n0, int K, float (&acc)[4][4], float* lds, const int TX_) {
    float* As = lds;
    float* Bs = lds + 16 * (GT_M + 4);
    const int tid = TX_, tx = tid & 15, ty = tid >> 4;
    const int ar = tid >> 2, ak = (tid & 3) * 4;
    const int bk = (tid & 255) >> 4, bn = (tid & 15) * 4;
    const bool avalid = (m0 + ar) < mvalid;
    long arow = 0;
    if (avalid) arow = aidx ? (long)(aidx[m0 + ar] >> ashift) : (long)(m0 + ar);
    const float* ap = A + arow * lda + ak;
    const float* bp = B + (size_t)bk * ldb + n0 + bn;
    for (int k0 = 0; k0 < K; k0 += 16) {
        float a0 = 0.f, a1 = 0.f, a2 = 0.f, a3 = 0.f;
        if (avalid) { a0 = ap[k0]; a1 = ap[k0 + 1]; a2 = ap[k0 + 2]; a3 = ap[k0 + 3]; }
        float b0 = 0.f, b1 = 0.f, b2 = 0.f, b3 = 0.f;
        if (tid < 256) { const float* bq = bp + (size_t)k0 * ldb; b0 = bq[0]; b1 = bq[1]; b2 = bq[2]; b3 = bq[3]; }
        __syncthreads();
        As[ak * (GT_M + 4) + ar] = a0; As[(ak + 1) * (GT_M + 4) + ar] = a1; As[(ak + 2) * (GT_M + 4) + ar] = a2; As[(ak + 3) * (GT_M + 4) + ar] = a3;
        if (tid < 256) { Bs[bk * 68 + bn] = b0; Bs[bk * 68 + bn + 1] = b1; Bs[bk * 68 + bn + 2] = b2; Bs[bk * 68 + bn + 3] = b3; }
        __syncthreads();
#pragma unroll
        for (int k = 0; k < 16; ++k) {
            float a[4], b[4];
#pragma unroll
            for (int i = 0; i < 4; ++i) { a[i] = As[k * (GT_M + 4) + 4 * ty + i]; b[i] = Bs[k * 68 + 4 * tx + i]; }
#pragma unroll
            for (int i = 0; i < 4; ++i)
#pragma unroll
                for (int j = 0; j < 4; ++j) acc[i][j] += a[i] * b[j];
        }
    }
    __syncthreads();
}
#define ZERO_ACC(a) { _Pragma("unroll") for (int i_ = 0; i_ < 4; ++i_) _Pragma("unroll") for (int j_ = 0; j_ < 4; ++j_) a[i_][j_] = 0.f; }

PHASE_FN void ph_fold(const Params& p, int l, float* lds) {
    const int TX_ = ltid(p.sw);
    const int tx = TX_ & 15, ty = TX_ >> 4;
    static_assert(PGD == GT_M, "fold tile");
    for (int it = blockIdx.x; it < 4 * (D / 64); it += gridDim.x) {
        const int g = it / (D / 64), n0 = (it % (D / 64)) * 64;
        float acc[4][4]; ZERO_ACC(acc);
        gemm_tile(WSF(O_PWS) + ((size_t)l * 4 + g) * PGD * PGD, PGD, nullptr, 0, PGD, 0, p.in[IPP] + ((size_t)l * PW + g * PGD) * D, D, n0, PGD, acc, lds, TX_);
#pragma unroll
        for (int i = 0; i < 4; ++i)
#pragma unroll
            for (int j = 0; j < 4; ++j) WSH(O_WMT)[(size_t)l * D * KCAT + (size_t)(n0 + 4 * tx + j) * KCAT + g * PGD + 4 * ty + i] = f2bf(acc[i][j]);
    }
}
PHASE_FN void ph_win(const Params& p, int l, LAS unsigned char* lds) {
    static_assert((OFF_RW + RW) % 256 == 0 && (OFF_RW + RC) % 256 == 0 && OFF_K % 256 == 0 && KVW == 256, "column tiles of the context-only subset");
    pg8::WinOrder S; S.init(WSH(O_HB), WSH(O_WINT) + (size_t)l * IN_DIM * D, D, D, gridDim.x, blockIdx.x, l != DEPTH - 1);
    pg8::EpiWin E{WSF(O_U), WSH(O_SG)};
    pg8::gemm_phase<pg8::EpiWin, pg8::WinOrder>(lds, D, D, D, S, E, ltid(p.sw));
}

__device__ __forceinline__ float dpp_sum16(float v);
#ifdef EMU
__device__ __forceinline__ float wave_total63(float v) { for (int m = 32; m >= 1; m >>= 1) v += __shfl_xor(v, m); return v; }
__device__ __forceinline__ float wave_bcast63(float v) { return __shfl(v, 63); }
#else
template <int CTRL, int RMASK> __device__ __forceinline__ float dpp_mov_rm(float v) { return __builtin_bit_cast(float, __builtin_amdgcn_update_dpp(0, __builtin_bit_cast(int, v), CTRL, RMASK, 0xf, false)); }
__device__ __forceinline__ float wave_total63(float v) {
    v = dpp_sum16(v); v += dpp_mov_rm<0x142, 0xa>(v); v += dpp_mov_rm<0x143, 0xc>(v); return v;
}
__device__ __forceinline__ float wave_bcast63(float v) { return __builtin_bit_cast(float, __builtin_amdgcn_readlane(__builtin_bit_cast(int, v), 63)); }
#endif
#ifdef EMU
struct BufRsrc { const char* p; };
__device__ __forceinline__ BufRsrc make_rsrc(const void* p, size_t) { return BufRsrc{(const char*)p}; }
__device__ __forceinline__ float buf_load4(BufRsrc r, int voff, int soff) { return *(const float*)(r.p + voff + soff); }
__device__ __forceinline__ pg8::bf16x8 buf_load16(BufRsrc r, int voff, int soff) { return *(const pg8::bf16x8*)(r.p + voff + soff); }
#else
typedef __amdgpu_buffer_rsrc_t BufRsrc;
__device__ __forceinline__ BufRsrc make_rsrc(const void* p, size_t bytes) { return __builtin_amdgcn_make_buffer_rsrc((void*)p, 0, (int)bytes, 0x00020000); }
__device__ __forceinline__ float buf_load4(BufRsrc r, int voff, int soff) { return __builtin_bit_cast(float, __builtin_amdgcn_raw_buffer_load_b32(r, voff, soff, 0)); }
__device__ __forceinline__ pg8::bf16x8 buf_load16(BufRsrc r, int voff, int soff) { return __builtin_bit_cast(pg8::bf16x8, __builtin_amdgcn_raw_buffer_load_b128(r, voff, soff, 0)); }
#endif
constexpr int PR = 9;
constexpr int LAS_A = 264;
static_assert(DL == 64 && IL == 64 && GL == 128 && RC == 3 * RW + 256, "LoRA geometry");
static_assert(RW == NT, "prep geometry");
PHASE_FN void ph_prep(const Params& p, int l, float* lds) {
    const int TX_ = ltid(p.sw);
    float* us = lds;
    bf16_t* Ahi = (bf16_t*)(us + PR * RC);
    bf16_t* Alo = Ahi + 16 * LAS_A;
    const int tid0 = TX_;
    for (int i = tid0; i < 16 * LAS_A; i += NT) { Ahi[i] = 0; Alo[i] = 0; }
    const float* U = WSF(O_U);
    const float* mu = p.in[IMU] + l * RC;
    for (int grp = blockIdx.x; grp < (T + PR - 1) / PR; grp += gridDim.x) {
        const int r0 = grp * PR, nr = min(PR, T - r0);
        int tid = tid0; PG8_OPAQUE(tid);
        const int lane = tid & 63;
        __syncthreads();
#if PROBE_MASK & 0x10000000
        for (int rep1_ = 0; rep1_ < 2; ++rep1_) {
        PG8_OPAQUE(rep1_);
#endif
        {
            const int ch = tid, gi = ch / PGD, hw = 1 << gi;
            float xv[PR + 16];
#pragma unroll
            for (int q = 0; q < PR + 16; ++q) { const int row = r0 - 8 + q; xv[q] = (row >= 0 && row < T) ? U[(size_t)row * UW + OFF_XA + ch] : 0.f; }
#pragma unroll
            for (int rr = 0; rr < PR; ++rr) if (rr < nr) {
                const int r = r0 + rr; int t, len, mr; seq_info(r, t, len, mr);
                float sacc = 0.f;
#pragma unroll
                for (int dq = -8; dq < 8; ++dq) { const int tt = t + dq; const bool ok = dq >= -hw && dq < hw && tt >= 0 && tt < len; sacc += ok ? xv[8 + rr + dq] : 0.f; }
                const int lo = max(t - hw, 0), hi = min(t + hw, len);
                WSH(O_OCAT)[(size_t)r * KCAT + ch] = f2bf(sacc * pg8::frcp((float)(hi - lo)) - xv[8 + rr]);
            }
        }
        WAVE_FENCE();
        for (int q = tid; q < PR * (QH + KVH) * 8; q += NT) {
            const int fo = q & 3, ax = (q >> 2) & 1, hh = (q >> 3) % (QH + KVH), rr = q / (8 * (QH + KVH)), e1 = ax * 64 + fo * 8;
            const int soff = (hh < QH) ? (OFF_Q + hh * 128) : (OFF_K + (hh - QH) * 128);
            if (rr < nr) {
                const int r = r0 + rr; int t, len, mr; seq_info(r, t, len, mr); const bool lat = r >= TC;
                const float* src = U + (size_t)r * UW + soff + e1;
                const pg8::f32x4 xa0 = *(const pg8::f32x4*)src, xa1 = *(const pg8::f32x4*)(src + 4), xb0 = *(const pg8::f32x4*)(src + 32), xb1 = *(const pg8::f32x4*)(src + 36);
                const float* rt = WSF(O_ROPE) + (size_t)(lat ? t : 0) * 128 + ax * 32 + fo * 8;
                const pg8::f32x4 c0 = *(const pg8::f32x4*)rt, c1 = *(const pg8::f32x4*)(rt + 4), s0 = *(const pg8::f32x4*)(rt + 64), s1 = *(const pg8::f32x4*)(rt + 68);
                pg8::f32x4 ya0 = xa0, ya1 = xa1, yb0 = xb0, yb1 = xb1;
                if (lat) { ya0 = xa0 * c0 - xb0 * s0; ya1 = xa1 * c1 - xb1 * s1; yb0 = xa0 * s0 + xb0 * c0; yb1 = xa1 * s1 + xb1 * c1; }
#define PK8(lo_, hi_) pg8::u32x4{pg8::pk_bf16((lo_)[0], (lo_)[1]), pg8::pk_bf16((lo_)[2], (lo_)[3]), pg8::pk_bf16((hi_)[0], (hi_)[1]), pg8::pk_bf16((hi_)[2], (hi_)[3])}
                if (hh < QH) {
                    bf16_t* qu = WSH(O_QB) + (size_t)r * AW + hh * 128 + e1; *(pg8::u32x4*)qu = PK8(xa0, xa1); *(pg8::u32x4*)(qu + 32) = PK8(xb0, xb1);
                    if (lat) { bf16_t* qr = WSH(O_QRB) + (size_t)(r - TC) * AW + hh * 128 + e1; *(pg8::u32x4*)qr = PK8(ya0, ya1); *(pg8::u32x4*)(qr + 32) = PK8(yb0, yb1); }
                } else {
                    bf16_t* kd = WSH(O_KB) + (size_t)r * KVW + (hh - QH) * 128 + e1; *(pg8::u32x4*)kd = PK8(ya0, ya1); *(pg8::u32x4*)(kd + 32) = PK8(yb0, yb1);
                }
#undef PK8
            }
        }
        WAVE_FENCE();
#pragma unroll 2
        for (int i = tid; i < nr * (KVW / 4); i += NT) {
            const int rr = i / (KVW / 4), c4 = (i % (KVW / 4)) * 4, r = r0 + rr;
            const float4 v = *(const float4*)(U + (size_t)r * UW + OFF_V + c4);
            uint2 o; o.x = pg8::pk_bf16(v.x, v.y); o.y = pg8::pk_bf16(v.z, v.w);
            *(uint2*)(WSH(O_VB) + (size_t)r * KVW + c4) = o;
        }
        WAVE_FENCE();
        if (tid < RC / 4) {
            const int c4 = tid * 4;
            float4 uv[PR + 2];
#pragma unroll
            for (int q = 0; q < PR + 2; ++q) { const int row = r0 - 1 + q; uv[q] = (row >= 0 && row < T) ? *(const float4*)(U + (size_t)row * UW + OFF_RW + c4) : make_float4(0.f, 0.f, 0.f, 0.f); }
            const float4 m4 = *(const float4*)(mu + c4);
#pragma unroll
            for (int rr = 0; rr < PR; ++rr) if (rr < nr) {
                const int r = r0 + rr; int t, len, mr; seq_info(r, t, len, mr);
                const float4 u0 = uv[rr + 1];
                const float4 up = (t > 0) ? uv[rr] : make_float4(0.f, 0.f, 0.f, 0.f), un = (t < len - 1) ? uv[rr + 2] : make_float4(0.f, 0.f, 0.f, 0.f);
                float* d = us + rr * RC + c4;
                d[0] = u0.x + m4.x * (0.5f * (up.x + un.x) - u0.x); d[1] = u0.y + m4.y * (0.5f * (up.y + un.y) - u0.y);
                d[2] = u0.z + m4.z * (0.5f * (up.z + un.z) - u0.z); d[3] = u0.w + m4.w * (0.5f * (up.w + un.w) - u0.w);
            }
        }
#if PROBE_MASK & 0x10000000
        }
#endif
        __syncthreads();
        for (int i = tid; i < PR * 256; i += NT) {
            const int rr = i >> 8, j = i & 255;
            const float v = (rr < nr) ? us[rr * RC + 3 * RW + j] : 0.f;
            const float tv = (j < DL) ? 1.0f - 2.0f * pg8::frcp(1.0f + __expf(2.0f * v)) : ((j < DL + IL) ? v : pg8::fsig(v));
            const bf16_t h = f2bf(tv);
            const int ar = 4 * (rr / 3) + rr % 3;
            Ahi[ar * LAS_A + j] = h; Alo[ar * LAS_A + j] = f2bf(tv - bf2f(h));
        }
        __syncthreads();
#ifdef EMU
        const int hd = tid >> 6;
#else
        const int hd = p.sw;
#endif
        const int mrow = lane & 15, kg = lane >> 4;
        pg8::f32x4 aG[4], aW0[4], aW1[4], aA0[4], aA1[4];
#pragma unroll
        for (int nt = 0; nt < 4; ++nt) {
            const int chn = hd * 64 + 4 * mrow + nt;
            const float w00 = p.in[IDW0][(l * 2 + 0) * RW + chn], w01 = p.in[IDW0][(l * 2 + 1) * RW + chn], a00 = p.in[IA0][(l * 2 + 0) * RW + chn], a01 = p.in[IA0][(l * 2 + 1) * RW + chn];
            aG[nt] = pg8::f32x4{0.f, 0.f, 0.f, 0.f}; aW0[nt] = pg8::f32x4{w00, w00, w00, w00}; aW1[nt] = pg8::f32x4{w01, w01, w01, w01};
            aA0[nt] = pg8::f32x4{a00, a00, a00, a00}; aA1[nt] = pg8::f32x4{a01, a01, a01, a01};
        }
        {
            const BufRsrc rlp = make_rsrc(p.ws + O_LP + (size_t)(l * NW + hd) * LKS * 4 * 1024, (size_t)LKS * 4 * 1024);
            const int vo = lane * 16;
            const bf16_t* arow_h = Ahi + mrow * LAS_A + kg * 8; const bf16_t* arow_l = Alo + mrow * LAS_A + kg * 8;
            pg8::bf16x8 bh[2][4];
#pragma unroll
            for (int nt = 0; nt < 4; ++nt) bh[0][nt] = buf_load16(rlp, vo, nt * 1024);
#pragma unroll
            for (int ks = 0; ks < LKS; ++ks) {
                const int cur = ks & 1, nxt = cur ^ 1;
                if (ks + 1 < LKS) {
#pragma unroll
                    for (int nt = 0; nt < 4; ++nt) bh[nxt][nt] = buf_load16(rlp, vo, ((ks + 1) * 4 + nt) * 1024);
                }
                const int kb = (ks < 4) ? 128 + 32 * ks : ((ks < 8) ? 32 * ((ks - 4) & 1) : 64 + 32 * ((ks - 8) & 1));
                const pg8::bf16x8 ah = *(const pg8::bf16x8*)(arow_h + kb), al = *(const pg8::bf16x8*)(arow_l + kb);
#pragma unroll
                for (int nt = 0; nt < 4; ++nt) {
                    pg8::f32x4& acc = (ks < 4) ? aG[nt] : ((ks < 6) ? aW0[nt] : ((ks < 8) ? aW1[nt] : ((ks < 10) ? aA0[nt] : aA1[nt])));
                    acc = __builtin_amdgcn_mfma_f32_16x16x32_bf16(ah, bh[cur][nt], acc, 0, 0, 0);
                    acc = __builtin_amdgcn_mfma_f32_16x16x32_bf16(al, bh[cur][nt], acc, 0, 0, 0);
                }
                WAVE_FENCE();
            }
        }
        float ssq[3] = {0.f, 0.f, 0.f}, bsm[3] = {0.f, 0.f, 0.f};
#pragma unroll
        for (int nt = 0; nt < 4; ++nt) {
            const int chn = hd * 64 + 4 * mrow + nt;
            const float kkc = p.in[IKK][l * RW + chn], kac = p.in[IKA][l * RW + chn], rkc = p.in[IRK][l * RW + chn];
#pragma unroll
            for (int i = 0; i < 3; ++i) {
                const int rr = kg * 3 + i;
                const float rv = us[rr * RC + chn], kv = us[rr * RC + RW + chn];
                aW0[nt][i] = __expf(-0.6065306597f * pg8::frcp(1.0f + __expf(-aW0[nt][i]))); aW1[nt][i] = __expf(-0.6065306597f * pg8::frcp(1.0f + __expf(-aW1[nt][i])));
                const float a0 = pg8::fsig(aA0[nt][i]), a1 = pg8::fsig(aA1[nt][i]);
                aA0[nt][i] = a0; aA1[nt][i] = a1;
                const float key0 = kv * (1.0f + (a0 - 1.0f) * kac), key1 = kv * (1.0f + (a1 - 1.0f) * kac);
                const float kkr = kv * kkc;
                ssq[i] += kkr * kkr; bsm[i] += rv * (key0 + key1) * rkc;
            }
        }
#pragma unroll
        for (int i = 0; i < 3; ++i) { ssq[i] = dpp_sum16(ssq[i]); bsm[i] = dpp_sum16(bsm[i]); }
        const int ch4 = hd * 64 + 4 * mrow;
        const pg8::f32x4 kkc4 = *(const pg8::f32x4*)(p.in[IKK] + l * RW + ch4), kac4 = *(const pg8::f32x4*)(p.in[IKA] + l * RW + ch4);
#pragma unroll
        for (int i = 0; i < 3; ++i) {
            const int rr = kg * 3 + i;
            if (kg < 3 && rr < nr) {
                const int r = r0 + rr;
                const float inv = pg8::frcp(fmaxf(sqrtf(ssq[i]), 1e-12f));
                const pg8::f32x4 rv = *(const pg8::f32x4*)(us + rr * RC + ch4), kv = *(const pg8::f32x4*)(us + rr * RC + RW + ch4), vv = *(const pg8::f32x4*)(us + rr * RC + 2 * RW + ch4);
                pg8::f32x4 w0, w1, a0, a1, gg;
#pragma unroll
                for (int nt = 0; nt < 4; ++nt) { w0[nt] = aW0[nt][i]; w1[nt] = aW1[nt][i]; a0[nt] = aA0[nt][i]; a1[nt] = aA1[nt][i]; gg[nt] = aG[nt][i]; }
                const pg8::f32x4 key0 = kv * (1.0f + (a0 - 1.0f) * kac4), key1 = kv * (1.0f + (a1 - 1.0f) * kac4), kn = kv * kkc4 * inv;
                pg8::u32x2 rb, vb; rb[0] = pg8::pk_bf16(rv[0], rv[1]); rb[1] = pg8::pk_bf16(rv[2], rv[3]); vb[0] = pg8::pk_bf16(vv[0], vv[1]); vb[1] = pg8::pk_bf16(vv[2], vv[3]);
                unsigned char* pk0 = p.ws + O_PACK + (((size_t)0 * T + r) * RH + hd) * REC + 16 * mrow;
                unsigned char* pk1 = p.ws + O_PACK + (((size_t)1 * T + r) * RH + hd) * REC + 16 * mrow;
                *(pg8::f32x4*)pk0 = w0; *(pg8::f32x4*)(pk0 + 256) = key0; *(pg8::f32x4*)(pk0 + 512) = kn * a0; *(pg8::f32x4*)(pk0 + 768) = kn;
                *(pg8::u32x2*)(pk0 + 1024 - 8 * mrow) = rb; *(pg8::u32x2*)(pk0 + 1152 - 8 * mrow) = vb;
                *(pg8::f32x4*)pk1 = w1; *(pg8::f32x4*)(pk1 + 256) = key1; *(pg8::f32x4*)(pk1 + 512) = kn * a1; *(pg8::f32x4*)(pk1 + 768) = kn;
                *(pg8::u32x2*)(pk1 + 1024 - 8 * mrow) = rb; *(pg8::u32x2*)(pk1 + 1152 - 8 * mrow) = vb;
                *(pg8::f32x4*)(WSF(O_V) + (size_t)r * RW + ch4) = vv;
                *(pg8::f32x4*)(WSF(O_G) + (size_t)r * RW + ch4) = gg;
                if (mrow == 0) WSF(O_BON)[(size_t)r * RH + hd] = 0.5f * bsm[i];
            }
            WAVE_FENCE();
        }
    }
    __syncthreads();
}

constexpr int SCAN_RING = 16, SCAN_SLOT = REC;
constexpr int SH_ROUNDS = 5;
static_assert(SH_ROUNDS * 16 * SCAN_SLOT + 64 <= LDS_BYTES - 16 && (C % 16) == 0 && ((C + L) % 16) == 0, "shared scan ring");
static_assert((C + L) % SCAN_RING == 0 && C % SCAN_RING == 0 && SCAN_RING == 16, "scan ring depth");
#ifdef EMU
__device__ __forceinline__ float dpp_sum16(float v) { v += __shfl_xor(v, 1); v += __shfl_xor(v, 2); v += __shfl_xor(v, 4); v += __shfl_xor(v, 8); return v; }
static thread_local unsigned char* emu_m0[16];
__device__ __forceinline__ void scan_set_m0(unsigned char* slot) { emu_m0[threadIdx.x >> 6] = slot; }
__device__ __forceinline__ void scan_dma2(int q, BufRsrc rs, int voff, int voffb, int soff_adj) {
    __builtin_memcpy(emu_m0[threadIdx.x >> 6] + q * 1280 + voff, rs.p + soff_adj + q * 1280 + voff, 16);
    __builtin_memcpy(emu_m0[threadIdx.x >> 6] + q * 1280 + 1024 + voffb, rs.p + soff_adj + q * 1280 + 1024 + voffb, 4);
}
__device__ __forceinline__ void scan_dma2_settled(BufRsrc rs, int voff, int voffb, int soff_adj) { scan_dma2(0, rs, voff, voffb, soff_adj); }
#define SCAN_WAIT(n) emu::wave_sync()
#define SH_RELAX() emu::yield()
#define SH_FENCE() ((void)0)
#define SCAN_SGPR_SETTLE(rs_, so_) ((void)0)
__device__ __forceinline__ float row_push(float keep, float v, int kq) { const float up = __shfl(keep, (int)(threadIdx.x & 63) - 1); return kq ? up : v; }
__device__ __forceinline__ void scan_store(float* q, float v) { *q = v; }
#else
template <int CTRL> __device__ __forceinline__ float dpp_mov(float v) { return __builtin_bit_cast(float, __builtin_amdgcn_update_dpp(0, __builtin_bit_cast(int, v), CTRL, 0xf, 0xf, false)); }
__device__ __forceinline__ float dpp_sum16(float v) {
    v += dpp_mov<0xB1>(v); v += dpp_mov<0x4E>(v); v += dpp_mov<0x141>(v); v += dpp_mov<0x140>(v); return v;
}
__device__ __forceinline__ void scan_set_m0(LAS unsigned char* slot) { const unsigned dst = (unsigned)(uintptr_t)slot; asm volatile("s_mov_b32 m0, %0\n\ts_nop 0" :: "s"(dst) : "memory", "m0"); }
__device__ __forceinline__ void scan_dma2_settled(BufRsrc rs, int voff, int voffb, int soff_adj) {
    asm volatile("s_nop 4\n\tbuffer_load_dwordx4 %0, %2, %3 offen lds\n\tbuffer_load_dword %1, %2, %3 offen offset:1024 lds" :: "v"(voff), "v"(voffb), "s"(rs), "s"(soff_adj) : "memory");
}
__device__ __forceinline__ void scan_dma2(int q, BufRsrc rs, int voff, int voffb, int soff_adj) {
    if (q == 0) asm volatile("buffer_load_dwordx4 %0, %2, %3 offen lds\n\tbuffer_load_dword %1, %2, %3 offen offset:1024 lds" :: "v"(voff), "v"(voffb), "s"(rs), "s"(soff_adj) : "memory");
    else if (q == 1) asm volatile("buffer_load_dwordx4 %0, %2, %3 offen offset:1280 lds\n\tbuffer_load_dword %1, %2, %3 offen offset:2304 lds" :: "v"(voff), "v"(voffb), "s"(rs), "s"(soff_adj) : "memory");
    else asm volatile("buffer_load_dwordx4 %0, %2, %3 offen offset:2560 lds\n\tbuffer_load_dword %1, %2, %3 offen offset:3584 lds" :: "v"(voff), "v"(voffb), "s"(rs), "s"(soff_adj) : "memory");
}
#define SCAN_WAIT(n) asm volatile("s_waitcnt vmcnt(" #n ")" ::: "memory")
#define SH_RELAX() __builtin_amdgcn_s_sleep(1)
#define SH_FENCE() asm volatile("" ::: "memory")
#define SCAN_SGPR_SETTLE(rs_, so_) asm volatile("s_nop 4" :: "s"(rs_), "s"(so_) : "memory")
__device__ __forceinline__ float row_push(float keep, float v, int) {
    return __builtin_bit_cast(float, __builtin_amdgcn_update_dpp(__builtin_bit_cast(int, v), __builtin_bit_cast(int, keep), 0x111, 0xf, 0xf, false));
}
__device__ __forceinline__ void scan_store(float* q, float v) { asm volatile("global_store_dword %0, %1, off" :: "v"(q), "v"(v) : "memory"); }
#endif
__device__ __forceinline__ int scan_row(int s, int d, int b) {
    const int in_ctx = s < C;
    const int len = in_ctx ? C : L, base = in_ctx ? b * C : TC + b * L, t = in_ctx ? s : s - C;
    return base + (d == 0 ? t : len - 1 - t);
}
struct ScanOps { pg8::f32x4 w, k, b, kk, r; float v; };
__device__ __forceinline__ pg8::f32x4 bf4_to_f32(pg8::u32x2 q) {
    pg8::f32x4 o; o[0] = __builtin_bit_cast(float, q[0] << 16); o[1] = __builtin_bit_cast(float, q[0] & 0xffff0000u); o[2] = __builtin_bit_cast(float, q[1] << 16); o[3] = __builtin_bit_cast(float, q[1] & 0xffff0000u); return o;
}
__device__ __forceinline__ ScanOps scan_read(const LAS unsigned char* slot, int kq, int vrow) {
    ScanOps o;
    o.w = *(const LAS pg8::f32x4*)(slot + kq * 16); o.k = *(const LAS pg8::f32x4*)(slot + 256 + kq * 16); o.b = *(const LAS pg8::f32x4*)(slot + 512 + kq * 16); o.kk = *(const LAS pg8::f32x4*)(slot + 768 + kq * 16);
    o.r = bf4_to_f32(*(const LAS pg8::u32x2*)(slot + 1024 + kq * 8));
    o.v = bf2f(*(const LAS bf16_t*)(slot + 1152 + vrow * 2)); return o;
}
struct ConvTile { const float* src; bf16_t* dst; int ld_src, ld_dst; };
__device__ __forceinline__ int conv_total(int l) {
    return (KCAT / 64) * (D / 64) + (D / 64) * (D / 64) + NE * 2 * (D / 64) * (DE / 64) + NE * (DE / 64) * (D / 64) + ((l + 1 < DEPTH) ? (D / 64) * (IN_DIM / 64) : 0);
}
__device__ __forceinline__ ConvTile conv_tile_of(const Params& p, int l, int it) {
    ConvTile c;
    const float* ppp = p.in[IPP]; const float* ppr = p.in[IPR]; const float* ppa = p.in[IPA]; const float* pwg = p.in[IEWG]; const float* pwu = p.in[IEWU];
#ifndef EMU
    asm volatile("" : "+s"(ppp), "+s"(ppr), "+s"(ppa), "+s"(pwg), "+s"(pwu));
#endif
    constexpr int N0 = (PW / 64) * (D / 64), N1 = N0 + (RW / 64) * (D / 64), N2 = N1 + (AW / 64) * (D / 64), N3 = N2 + (D / 64) * (D / 64);
    constexpr int TPE1 = (D / 64) * (DE / 64), N4 = N3 + NE * 2 * TPE1, TPE2 = (DE / 64) * (D / 64), N5 = N4 + NE * TPE2;
    if (it < N2) {
        const int j = it < N0 ? it : (it < N1 ? it - N0 : it - N1);
        const int nk = it < N0 ? PW / 64 : (it < N1 ? RW / 64 : AW / 64), koff = it < N0 ? 0 : (it < N1 ? PW : PW + RW);
        const float* sb = it < N0 ? ppp + (size_t)l * PW * D : (it < N1 ? ppr + (size_t)l * RW * D : ppa + (size_t)l * AW * D);
        const int kt = j % nk, nt = j / nk;
        c.src = sb + (size_t)kt * 64 * D + nt * 64; c.ld_src = D; c.dst = WSH(O_WMT) + (size_t)l * D * KCAT + (size_t)nt * 64 * KCAT + koff + kt * 64; c.ld_dst = KCAT;
    } else if (it < N3) {
        const int j = it - N2, kt = j % (D / 64), nt = j / (D / 64);
        c.src = p.in[IWOUT] + (size_t)l * D * D + (size_t)kt * 64 * D + nt * 64; c.ld_src = D; c.dst = WSH(O_WOT) + (size_t)l * D * D + (size_t)nt * 64 * D + kt * 64; c.ld_dst = D;
    } else if (it < N4) {
        const int j = it - N3, e = j / (2 * TPE1), rem = j % (2 * TPE1), which = rem / TPE1, r2 = rem % TPE1, kt = r2 % (D / 64), nt = r2 / (D / 64);
        c.src = (which ? pwu : pwg) + ((size_t)l * NE + e) * D * DE + (size_t)kt * 64 * DE + nt * 64; c.ld_src = DE;
        const int drow = (nt >> 1) * 256 + which * 128 + (nt & 1) * 64;
        c.dst = WSH(O_EGU) + (((size_t)l * NE + e) * 2 * DE + drow) * D + kt * 64; c.ld_dst = D;
    } else if (it < N5) {
        const int j = it - N4, e = j / TPE2, r2 = j % TPE2, kt = r2 % (DE / 64), nt = r2 / (DE / 64);
        c.src = p.in[IEWD] + ((size_t)l * NE + e) * DE * D + (size_t)kt * 64 * D + nt * 64; c.ld_src = D; c.dst = WSH(O_ED) + (((size_t)l * NE + e) * D + nt * 64) * DE + kt * 64; c.ld_dst = DE;
    } else {
        const int j = it - N5, kt = j % (D / 64), nt = j / (D / 64);
        c.src = p.in[IWIN] + (size_t)(l + 1) * D * IN_DIM + (size_t)kt * 64 * IN_DIM + nt * 64; c.ld_src = IN_DIM; c.dst = WSH(O_WINT) + (size_t)(l + 1) * IN_DIM * D + (size_t)nt * 64 * D + kt * 64; c.ld_dst = D;
    }
    return c;
}
__device__ __forceinline__ void conv_load(const ConvTile& c, int lane, float (&v)[64]) {
    const BufRsrc rs = make_rsrc(c.src, (size_t)64 * c.ld_src * 4);
#pragma unroll
    for (int k = 0; k < 64; ++k) v[k] = buf_load4(rs, lane * 4, k * c.ld_src * 4);
}
__device__ __forceinline__ void conv_emit(const ConvTile& c, int lane, const float (&v)[64]) {
#ifdef EMU
    bf16_t* q = c.dst + (size_t)lane * c.ld_dst;
#pragma unroll
    for (int j = 0; j < 8; ++j)
        *(uint4*)(q + 8 * j) = make_uint4(pg8::pk_bf16(v[8 * j], v[8 * j + 1]), pg8::pk_bf16(v[8 * j + 2], v[8 * j + 3]), pg8::pk_bf16(v[8 * j + 4], v[8 * j + 5]), pg8::pk_bf16(v[8 * j + 6], v[8 * j + 7]));
#else
    const BufRsrc rd = make_rsrc(c.dst, (size_t)64 * c.ld_dst * 2);
    const int vo = lane * c.ld_dst * 2;
#pragma unroll
    for (int j = 0; j < 8; ++j) {
        pg8::u32x4 w; w[0] = pg8::pk_bf16(v[8 * j], v[8 * j + 1]); w[1] = pg8::pk_bf16(v[8 * j + 2], v[8 * j + 3]); w[2] = pg8::pk_bf16(v[8 * j + 4], v[8 * j + 5]); w[3] = pg8::pk_bf16(v[8 * j + 6], v[8 * j + 7]);
        __builtin_amdgcn_raw_buffer_store_b128(w, rd, vo + 16 * j, 0, 0);
    }
#endif
}
__device__ __forceinline__ void conv_role(const Params& p, int l, int cw, int ncw, int lane) {
    constexpr int NFOLD = (PW / 64) * (D / 64);
    const int total = conv_total(l);
    cw += NFOLD;
    while (cw >= NFOLD + ncw) cw -= ncw;
    if (cw >= total) return;
    float va[64], vb[64];
    ConvTile ca = conv_tile_of(p, l, cw);
    conv_load(ca, lane, va);
#pragma unroll 1
    for (int it = cw; it < total; it += ncw) {
        const int nx = it + ncw;
        const ConvTile cb = conv_tile_of(p, l, nx < total ? nx : it);
        conv_load(cb, lane, vb);
        conv_emit(ca, lane, va);
        ca = cb;
#pragma unroll
        for (int i = 0; i < 64; ++i) va[i] = vb[i];
    }
}
PHASE_FN void ph_scan(const Params& p, int l, LAS unsigned char* lds) {
    (void)l;
    const int TX_ = ltid(p.sw);
#ifdef EMU
    const int wave = TX_ >> 6;
#else
    const int wave = p.sw;
#endif
    const int lane = TX_ & 63, g = lane >> 4, kq = lane & 15;
    constexpr int NS = C + L, nitems = 2 * NB * RH * 16;
    const BufRsrc rs = make_rsrc((const unsigned char*)WSF(O_PACK) - 4096, PACK_BYTES + 4096);
    volatile LAS int* flg = (volatile LAS int*)(lds + SH_ROUNDS * 16 * SCAN_SLOT);
    if (TX_ < 8) flg[TX_] = 0;
    __syncthreads();
    if (wave < 4) {
        LAS unsigned char* ring = lds + wave * (SCAN_RING * SCAN_SLOT);
        const bool xcd_deal = (gridDim.x % 8 == 0) && (nitems % (8 * 16) == 0) && (gridDim.x * 4 == nitems);
        if (xcd_deal) {
            constexpr int NR = NS / 16;
            const int x = blockIdx.x % 8, slot = (blockIdx.x / 8) * 4 + wave;
            const int item = (x + 8 * (slot >> 4)) * 16 + (slot & 15);
            const int chain = item >> 4, rg = item & 15;
            const int d = chain / (NB * RH), b = (chain / RH) % NB, h = chain % RH;
            const int vrow = rg * 4 + g;
            const int dstep = (d == 0 ? 1 : -1) * RH * REC;
#define SCAN_SOFF(s) ((int)((((size_t)d * T + scan_row((s), d, b)) * RH + h) * REC))
            const int voff = lane * 16, voffb = lane * 4;
#define SH_ISSUE(q_, phq_) { int so_ = SCAN_SOFF(16 * (q_) + wave) + 4096; SCAN_SGPR_SETTLE(rs, so_); LAS unsigned char* sb_ = lds + (((phq_) * 16 + wave) * SCAN_SLOT); \
                _Pragma("unroll") for (int k_ = 0; k_ < 4; ++k_) { scan_set_m0(sb_ + k_ * 4 * SCAN_SLOT); scan_dma2_settled(rs, voff, voffb, so_); so_ += 4 * dstep; } }
#define SH_SPIN(needl_, needc_) { unsigned sp_ = 0; for (;;) { const int l0_ = flg[0], l1_ = flg[1], l2_ = flg[2], l3_ = flg[3], c0_ = flg[4], c1_ = flg[5], c2_ = flg[6], c3_ = flg[7]; \
                if ((min(min(l0_, l1_), min(l2_, l3_)) >= (needl_) && min(min(c0_, c1_), min(c2_, c3_)) >= (needc_)) || ++sp_ > (1u << 20)) break; SH_RELAX(); } SH_FENCE(); }
            SH_ISSUE(0, 0) SH_ISSUE(1, 1) SH_ISSUE(2, 2)
            SCAN_WAIT(0);
            SH_FENCE();
            if (lane == 0) flg[wave] = 3;
            float S0 = 0.f, S1 = 0.f, S2 = 0.f, S3 = 0.f;
            float* Yb = WSF(O_Y) + (size_t)d * T * RW + h * 64 + vrow;
            SH_SPIN(1, -1)
            ScanOps cur = scan_read(lds, kq, vrow);
            float yprev = 0.f, ykA = 0.f;
            int ph = 0;
#pragma unroll 1
            for (int r = 0; r < NR; ++r) {
                SH_FENCE();
                if (lane == 0) flg[4 + wave] = r;
                SH_SPIN(min(r + 2, NR), r - 1)
                const int ph3 = (ph + 3 >= SH_ROUNDS) ? ph + 3 - SH_ROUNDS : ph + 3;
                if (r + 3 < NR) { SH_ISSUE(r + 3, ph3) SCAN_WAIT(8); } else { SCAN_WAIT(0); }
                SH_FENCE();
                if (lane == 0) flg[wave] = min(r + 3, NR);
                const int phn = (ph + 1 >= SH_ROUNDS) ? 0 : ph + 1;
                const LAS unsigned char* rb = lds + ph * 16 * SCAN_SLOT;
                const LAS unsigned char* rbn = lds + phn * 16 * SCAN_SLOT;
                const int s0 = r * 16;
#pragma unroll
                for (int j = 0; j < 16; ++j) {
                    const ScanOps nxt = scan_read(j < 15 ? rb + (j + 1) * SCAN_SLOT : rbn, kq, vrow);
                    float dot = S0 * cur.kk[0] + S1 * cur.kk[1] + S2 * cur.kk[2] + S3 * cur.kk[3];
                    const float t0 = S0 * cur.w[0] + cur.v * cur.k[0], t1 = S1 * cur.w[1] + cur.v * cur.k[1], t2 = S2 * cur.w[2] + cur.v * cur.k[2], t3 = S3 * cur.w[3] + cur.v * cur.k[3];
                    dot = dpp_sum16(dot);
                    const float yred = dpp_sum16(yprev);
                    ykA = row_push(ykA, yred, kq);
                    S0 = t0 - dot * cur.b[0]; S1 = t1 - dot * cur.b[1]; S2 = t2 - dot * cur.b[2]; S3 = t3 - dot * cur.b[3];
                    yprev = S0 * cur.r[0] + S1 * cur.r[1] + S2 * cur.r[2] + S3 * cur.r[3];
                    cur = nxt;
                }
                {
                    const int sa = s0 + 14 - kq;
                    if (sa >= 0) scan_store(Yb + (size_t)scan_row(sa, d, b) * RW, ykA);
                }
                ph = phn;
            }
            scan_store(Yb + (size_t)scan_row(NS - 1, d, b) * RW, dpp_sum16(yprev));
            SCAN_WAIT(0);
#undef SCAN_SOFF
#undef SH_ISSUE
#undef SH_SPIN
        }
#if PROBE_MASK & 0x200000
        for (int rep_ = 0; rep_ < 2; ++rep_)
#endif
        for (int it0 = xcd_deal ? nitems : wave * gridDim.x + blockIdx.x; it0 < nitems; it0 += 4 * gridDim.x) {
            int item = it0;
            if (xcd_deal) { const int x = blockIdx.x % 8, slot = (blockIdx.x / 8) * 4 + wave;
                item = (x + 8 * (slot >> 4)) * 16 + (slot & 15); }
            const int chain = item >> 4, rg = item & 15;
            const int d = chain / (NB * RH), b = (chain / RH) % NB, h = chain % RH;
            const int vrow = rg * 4 + g;
            const int dstep = (d == 0 ? 1 : -1) * RH * REC;
#define SCAN_SOFF(s) ((int)((((size_t)d * T + scan_row((s), d, b)) * RH + h) * REC))
            const int voff = lane * 16;
            const int dstepA = dstep - SCAN_SLOT, dstepB = dstep + 2 * SCAN_SLOT;
            const int voffb = lane * 4;
            {
                int so = SCAN_SOFF(0) + 4096;
                SCAN_SGPR_SETTLE(rs, so);
#pragma unroll
                for (int j = 0; j < SCAN_RING; ++j) { if (j % 3 == 0) scan_set_m0(ring + j * SCAN_SLOT); scan_dma2(j % 3, rs, voff, voffb, so); so += ((j + 1) % 3) ? dstepA : dstepB; }
            }
            float S0 = 0.f, S1 = 0.f, S2 = 0.f, S3 = 0.f;
            float* Yb = WSF(O_Y) + (size_t)d * T * RW + h * 64 + vrow;
            SCAN_WAIT(30);
            ScanOps cur = scan_read(ring, kq, vrow);
            float yprev = 0.f, ykA = 0.f;
#pragma unroll 1
            for (int s0 = 0; s0 < NS; s0 += SCAN_RING) {
                const int sn0 = (s0 + SCAN_RING < NS) ? s0 + SCAN_RING : s0;
                int so = SCAN_SOFF(sn0) + 4096;
                SCAN_SGPR_SETTLE(rs, so);
#pragma unroll
                for (int j = 0; j < SCAN_RING; ++j) {
                    SCAN_WAIT(28);
                    const ScanOps nxt = scan_read(ring + ((j + 1) % SCAN_RING) * SCAN_SLOT, kq, vrow);
                    float dot = S0 * cur.kk[0] + S1 * cur.kk[1] + S2 * cur.kk[2] + S3 * cur.kk[3];
                    const float t0 = S0 * cur.w[0] + cur.v * cur.k[0], t1 = S1 * cur.w[1] + cur.v * cur.k[1], t2 = S2 * cur.w[2] + cur.v * cur.k[2], t3 = S3 * cur.w[3] + cur.v * cur.k[3];
                    dot = dpp_sum16(dot);
                    const float yred = dpp_sum16(yprev);
                    ykA = row_push(ykA, yred, kq);
                    S0 = t0 - dot * cur.b[0]; S1 = t1 - dot * cur.b[1]; S2 = t2 - dot * cur.b[2]; S3 = t3 - dot * cur.b[3];
                    yprev = S0 * cur.r[0] + S1 * cur.r[1] + S2 * cur.r[2] + S3 * cur.r[3];
                    if (j % 3 == 0) scan_set_m0(ring + j * SCAN_SLOT);
                    scan_dma2(j % 3, rs, voff, voffb, so); so += ((j + 1) % 3) ? dstepA : dstepB;
                    cur = nxt;
                }
                {
                    const int sa = s0 + 14 - kq;
                    if (sa >= 0) scan_store(Yb + (size_t)scan_row(sa, d, b) * RW, ykA);
                }
            }
            scan_store(Yb + (size_t)scan_row(NS - 1, d, b) * RW, dpp_sum16(yprev));
            SCAN_WAIT(0);
#undef SCAN_SOFF
        }
#if PROBE_MASK & 0x4000000
        __syncthreads();
#endif
    } else {
#if PROBE_MASK & 0x4000000
        __syncthreads();
#endif
        conv_role(p, l, (int)blockIdx.x * 4 + (wave - 4), (int)gridDim.x * 4, lane);
#if PROBE_MASK & 0x100000
        conv_role(p, l, (int)blockIdx.x * 4 + (wave - 4), (int)gridDim.x * 4, lane);
#endif
    }
    __syncthreads();
}

PHASE_FN void ph_readout(const Params& p, int l) {
    static_assert(RW == 512 && RH == 8, "readout geometry");
    const int TX_ = ltid(p.sw);
    const int wave = TX_ >> 6, lane = TX_ & 63;
    for (int r = blockIdx.x * NW + wave; r < T; r += gridDim.x * NW) {
        pg8::f32x4 y[2], vv[2], gg[2];
#pragma unroll
        for (int j = 0; j < 2; ++j) { const size_t o = (size_t)r * RW + j * 256 + lane * 4;
            y[j] = *(const pg8::f32x4*)(WSF(O_Y) + o) + *(const pg8::f32x4*)(WSF(O_Y) + (size_t)T * RW + o); vv[j] = *(const pg8::f32x4*)(WSF(O_V) + o); gg[j] = *(const pg8::f32x4*)(WSF(O_G) + o); }
#pragma unroll
        for (int j = 0; j < 2; ++j) { const int ch = j * 256 + lane * 4;
            const float mean = dpp_sum16(y[j][0] + y[j][1] + y[j][2] + y[j][3]) * (1.0f / 64.0f);
            const pg8::f32x4 dv = y[j] - mean;
            const float var = dpp_sum16(dv[0] * dv[0] + dv[1] * dv[1] + dv[2] * dv[2] + dv[3] * dv[3]) * (1.0f / 64.0f);
            const float rs = rsqrtf(var + GN_EPS), bon = WSF(O_BON)[(size_t)r * RH + (ch >> 6)];
            const pg8::f32x4 lg = *(const pg8::f32x4*)(p.in[ILNG] + l * RW + ch), lb = *(const pg8::f32x4*)(p.in[ILNB] + l * RW + ch);
            const pg8::f32x4 o4 = (dv * rs * lg + lb + bon * vv[j]) * gg[j];
            pg8::u32x2 w2; w2[0] = pg8::pk_bf16(o4[0], o4[1]); w2[1] = pg8::pk_bf16(o4[2], o4[3]);
            *(pg8::u32x2*)(WSH(O_OCAT) + (size_t)r * KCAT + PW + ch) = w2; }
    }
}

constexpr int AT_KS = 272, AT_VS = 144, AT_PS = 144;
constexpr int AT_K = 0, AT_V = 64 * AT_KS, AT_P = AT_V + 128 * AT_VS, AT_ST = AT_P + NW * 32 * AT_PS;
typedef float f32x16 __attribute__((ext_vector_type(16)));
struct AttnRegs { pg8::u32x4 k[2], v[2]; };
template <bool WITHV> __device__ __forceinline__ void attn_load(const Params& p, AttnRegs& r, int krow0, int rlo, int rhi, int kvh, int tid) {
#pragma unroll
    for (int i = 0; i < 2; ++i) {
        const int chunk = tid + i * NT, key = chunk >> 4, part = chunk & 15;
        int row = krow0 + key; row = row < rlo ? rlo : (row > rhi ? rhi : row);
        r.k[i] = *(const pg8::u32x4*)(WSH(O_KB) + (size_t)row * KVW + kvh * 128 + part * 8);
        if (WITHV) {
            const int keyv = chunk & 63, partv = chunk >> 6;
            int rowv = krow0 + keyv; rowv = rowv < rlo ? rlo : (rowv > rhi ? rhi : rowv);
            r.v[i] = *(const pg8::u32x4*)(WSH(O_VB) + (size_t)rowv * KVW + kvh * 128 + partv * 8);
        }
    }
}
template <bool WITHV> __device__ __forceinline__ void attn_store(LAS unsigned char* lds, const AttnRegs& r, int tid) {
#pragma unroll
    for (int i = 0; i < 2; ++i) {
        const int chunk = tid + i * NT, key = chunk >> 4, part = chunk & 15;
        *(LAS pg8::u32x4*)(lds + AT_K + key * AT_KS + part * 16) = r.k[i];
        if (WITHV) {
            const int keyv = chunk & 63, partv = chunk >> 6;
            const unsigned w4[4] = {r.v[i][0], r.v[i][1], r.v[i][2], r.v[i][3]};
#pragma unroll
            for (int q = 0; q < 4; ++q) {
                *(LAS bf16_t*)(lds + AT_V + (partv * 8 + 2 * q) * AT_VS + keyv * 2) = (bf16_t)(w4[q] & 0xffffu);
                *(LAS bf16_t*)(lds + AT_V + (partv * 8 + 2 * q + 1) * AT_VS + keyv * 2) = (bf16_t)(w4[q] >> 16);
            }
        }
    }
}
PHASE_FN void ph_attn(const Params& p, int l, bool need_ctx, LAS unsigned char* lds) {
    const int TX_ = ltid(p.sw);
#ifdef EMU
    const int wave = TX_ >> 6;
#else
    const int wave = p.sw;
#endif
    const int g = wave & 3, th = wave >> 2;
    constexpr int NCT = C / 64, NQT = L / 64, n_lat = NB * KVH * NQT;
    const int n_ctx = need_ctx ? NB * KVH * NCT : 0;
    const float SC = 0.08838834764831845f;
    LAS unsigned char* Pw = lds + AT_P + wave * 32 * AT_PS;
    LAS float* st = (LAS float*)(lds + AT_ST + wave * 512);
    for (int u = blockIdx.x; u < n_lat + n_ctx; u += gridDim.x) {
        int txo = TX_; PG8_OPAQUE(txo);
        const int lane = txo & 63, c = lane & 31, h = lane >> 5;
        const bool lat = u < n_lat;
        const int uu = lat ? u : u - n_lat, nqt = lat ? NQT : NCT;
        const int tq = uu % nqt, kvh = (uu / nqt) % KVH, b = uu / (nqt * KVH);
        const int hq = kvh * 4 + g, ntile = lat ? NCT + 5 : NCT;
        const int tw = tq * 64 + th * 32 + c;
        const int qrow = lat ? TC + b * L + tw : b * C + tw;
        const float sink = p.in[ISINK][l * QH + hq];
        pg8::bf16x8 Qu[8], Qr[8];
#pragma unroll
        for (int ks = 0; ks < 8; ++ks) {
            Qu[ks] = *(const pg8::bf16x8*)(WSH(O_QB) + (size_t)qrow * AW + hq * 128 + ks * 16 + h * 8);
            Qr[ks] = lat ? *(const pg8::bf16x8*)(WSH(O_QRB) + (size_t)(qrow - TC) * AW + hq * 128 + ks * 16 + h * 8) : Qu[ks];
        }
#define AT_TILE(kt, krow0, rlo, rhi, jpos0) const bool ctxt = (kt) < NCT; \
        const int jpos0 = ctxt ? 0 : tq * 64 - 128 + ((kt) - NCT) * 64; \
        const int krow0 = ctxt ? b * C + (kt) * 64 : TC + b * L + jpos0, rlo = ctxt ? b * C : TC + b * L, rhi = ctxt ? b * C + C - 1 : TC + b * L + L - 1;
#define AT_SCORES(acc, kb, ctxt) { acc = (f32x16){0.f, 0.f, 0.f, 0.f, 0.f, 0.f, 0.f, 0.f, 0.f, 0.f, 0.f, 0.f, 0.f, 0.f, 0.f, 0.f}; \
        _Pragma("unroll") for (int ks = 0; ks < 8; ++ks) { const pg8::bf16x8 kf = *(const LAS pg8::bf16x8*)(lds + AT_K + ((kb) * 32 + c) * AT_KS + ks * 32 + h * 16); \
            acc = __builtin_amdgcn_mfma_f32_32x32x16_bf16(kf, (ctxt) ? Qu[ks] : Qr[ks], acc, 0, 0, 0); } }
        float mloc = -1e30f;
        AttnRegs ar;
        { AT_TILE(0, krow0, rlo, rhi, jpos0) (void)jpos0; attn_load<false>(p, ar, krow0, rlo, rhi, kvh, txo); }
        for (int kt = 0; kt < ntile; ++kt) {
            AT_TILE(kt, krow0, rlo, rhi, jpos0)
            __syncthreads();
            attn_store<false>(lds, ar, txo);
            __syncthreads();
            if (kt + 1 < ntile) { const int kn = kt + 1; const bool ctxt2 = kn < NCT; const int jp2 = ctxt2 ? 0 : tq * 64 - 128 + (kn - NCT) * 64;
              attn_load<false>(p, ar, ctxt2 ? b * C + kn * 64 : TC + b * L + jp2, ctxt2 ? b * C : TC + b * L, ctxt2 ? b * C + C - 1 : TC + b * L + L - 1, kvh, txo); }
#pragma unroll
            for (int kb = 0; kb < 2; ++kb) {
                f32x16 acc; AT_SCORES(acc, kb, ctxt)
#pragma unroll
                for (int i = 0; i < 16; ++i) {
                    const int j = jpos0 + kb * 32 + (i & 3) + 8 * (i >> 2) + 4 * h;
                    const bool valid = ctxt || (j >= 0 && j < L && j - tw <= 128 && tw - j <= 128);
                    mloc = fmaxf(mloc, valid ? acc[i] : -1e30f);
                }
            }
        }
        st[h * 32 + c] = mloc;
        WAVE_SYNC();
        const float m = fmaxf(fmaxf(st[c], st[32 + c]) * SC, sink);
        WAVE_SYNC();
        f32x16 O[4];
#pragma unroll
        for (int db = 0; db < 4; ++db) O[db] = (f32x16){0.f, 0.f, 0.f, 0.f, 0.f, 0.f, 0.f, 0.f, 0.f, 0.f, 0.f, 0.f, 0.f, 0.f, 0.f, 0.f};
        float lsum = 0.f;
        { AT_TILE(0, krow0, rlo, rhi, jpos0) (void)jpos0; attn_load<true>(p, ar, krow0, rlo, rhi, kvh, txo); }
        for (int kt = 0; kt < ntile; ++kt) {
            AT_TILE(kt, krow0, rlo, rhi, jpos0)
            __syncthreads();
            attn_store<true>(lds, ar, txo);
            __syncthreads();
            if (kt + 1 < ntile) { const int kn = kt + 1; const bool ctxt2 = kn < NCT; const int jp2 = ctxt2 ? 0 : tq * 64 - 128 + (kn - NCT) * 64;
              attn_load<true>(p, ar, ctxt2 ? b * C + kn * 64 : TC + b * L + jp2, ctxt2 ? b * C : TC + b * L, ctxt2 ? b * C + C - 1 : TC + b * L + L - 1, kvh, txo); }
#pragma unroll
            for (int kb = 0; kb < 2; ++kb) {
                f32x16 acc; AT_SCORES(acc, kb, ctxt)
#pragma unroll
                for (int grp = 0; grp < 4; ++grp) {
                    float pv[4];
#pragma unroll
                    for (int q = 0; q < 4; ++q) {
                        const int i = grp * 4 + q, j = jpos0 + kb * 32 + q + 8 * grp + 4 * h;
                        const bool valid = ctxt || (j >= 0 && j < L && j - tw <= 128 && tw - j <= 128);
                        const float e = valid ? __expf(acc[i] * SC - m) : 0.f;
                        lsum += e; pv[q] = e;
                    }
                    pg8::u32x2 w2; w2[0] = pg8::pk_bf16(pv[0], pv[1]); w2[1] = pg8::pk_bf16(pv[2], pv[3]);
                    *(LAS pg8::u32x2*)(Pw + c * AT_PS + (kb * 32 + 8 * grp + 4 * h) * 2) = w2;
                }
            }
            WAVE_SYNC();
#pragma unroll
            for (int ks = 0; ks < 4; ++ks) {
                const pg8::bf16x8 pf = *(const LAS pg8::bf16x8*)(Pw + c * AT_PS + ks * 32 + h * 16);
#pragma unroll
                for (int db = 0; db < 4; ++db) {
                    const pg8::bf16x8 vf = *(const LAS pg8::bf16x8*)(lds + AT_V + (db * 32 + c) * AT_VS + ks * 32 + h * 16);
                    O[db] = __builtin_amdgcn_mfma_f32_32x32x16_bf16(pf, vf, O[db], 0, 0, 0);
                }
            }
            WAVE_SYNC();
        }
        st[64 + h * 32 + c] = lsum;
        WAVE_SYNC();
        float rinv[16];
#pragma unroll
        for (int i = 0; i < 16; ++i) { const int q = (i & 3) + 8 * (i >> 2) + 4 * h; const float mm = fmaxf(fmaxf(st[q], st[32 + q]) * SC, sink); rinv[i] = pg8::frcp(st[64 + q] + st[96 + q] + __expf(sink - mm)); }
        WAVE_SYNC();
        const int orow0 = (lat ? TC + b * L : b * C) + tq * 64 + th * 32;
#pragma unroll
        for (int dh = 0; dh < 2; ++dh) {
#pragma unroll
            for (int d2 = 0; d2 < 2; ++d2)
#pragma unroll
                for (int i = 0; i < 16; ++i) { const int q = (i & 3) + 8 * (i >> 2) + 4 * h;
                    *(LAS bf16_t*)(Pw + q * AT_PS + (d2 * 32 + c) * 2) = f2bf(O[dh * 2 + d2][i] * rinv[i]); }
            WAVE_SYNC();
#pragma unroll
            for (int pz = 0; pz < 4; ++pz) { const int row = pz * 8 + (lane >> 3), ck = lane & 7;
                const pg8::u32x4 w4 = *(const LAS pg8::u32x4*)(Pw + row * AT_PS + ck * 16);
                *(pg8::u32x4*)(WSH(O_OCAT) + (size_t)(orow0 + row) * KCAT + PW + RW + hq * 128 + dh * 64 + ck * 8) = w4; }
            WAVE_SYNC();
        }
#undef AT_TILE
#undef AT_SCORES
    }
    __syncthreads();
}

PHASE_FN void ph_poolmm(const Params& p, int l, float* lds) {
    const int TX_ = ltid(p.sw);
    const int tx = TX_ & 15, ty = TX_ >> 4;
    const int nM = T / GT_M, nN = PW / 64;
    for (int it = blockIdx.x; it < nM * nN; it += gridDim.x) {
        const int m0 = (it / nN) * GT_M, n0 = (it % nN) * 64, g = n0 / PGD;
        float acc[4][4]; ZERO_ACC(acc);
        gemm_tile(WSF(O_POOLED) + g * PGD, PW, nullptr, 0, T, m0, p.in[IPOOLW] + ((size_t)l * 4 + g) * PGD * PGD, PGD, n0 - g * PGD, PGD, acc, lds, TX_);
#pragma unroll
        for (int i = 0; i < 4; ++i)
#pragma unroll
            for (int j = 0; j < 4; ++j) { const int n = n0 + 4 * tx + j; WSH(O_OCAT)[(size_t)(m0 + 4 * ty + i) * KCAT + n] = f2bf(acc[i][j] * p.in[IPOOLS][l * PW + n]); }
    }
}

PHASE_FN void ph_merge(const Params& p, int l, bool need_ctx, LAS unsigned char* lds) {
    const int pm0 = need_ctx ? 0 : TC / 256;
    pg8::DenseOrder S; S.init(WSH(O_OCAT), KCAT, WSH(O_WMT) + (size_t)l * D * KCAT, KCAT, pm0, T / 256 - pm0, D / 256, gridDim.x, blockIdx.x);
    pg8::EpiMerge E{WSH(O_SG), WSH(O_MBB)};
    pg8::gemm_phase<pg8::EpiMerge, pg8::DenseOrder>(lds, KCAT, KCAT, KCAT, S, E, ltid(p.sw));
}
PHASE_FN void ph_wout(const Params& p, int l, bool need_ctx, LAS unsigned char* lds) {
    const int pm0 = need_ctx ? 0 : TC / 256;
    pg8::DenseOrder S; S.init(WSH(O_MBB), D, WSH(O_WOT) + (size_t)l * D * D, D, pm0, T / 256 - pm0, D / 256, gridDim.x, blockIdx.x);
    pg8::EpiWout E{WSF(O_X), WSF(O_MOD) + (size_t)l * (NB + 1) * 6 * D, l == 0 ? p.in[ICTX] : nullptr, l == 0 ? p.in[IX] : nullptr};
    pg8::gemm_phase<pg8::EpiWout, pg8::DenseOrder>(lds, D, D, D, S, E, ltid(p.sw));
}

PHASE_FN void ph_norm2(const Params& p, int l, bool need_ctx, LAS unsigned char* lds, bool dry = false) {
    const int TX_ = ltid(p.sw);
#ifdef EMU
    const int wave = TX_ >> 6;
#else
    const int wave = p.sw;
#endif
    const int lane = TX_ & 63;
    LAS float* Wc = (LAS float*)lds;
    LAS float* lg = (LAS float*)lds + 6 * D + wave * 200;
    const int r_begin = need_ctx ? 0 : TC, nrows_all = T - r_begin;
    const int per = min((nrows_all + (int)gridDim.x - 1) / (int)gridDim.x, 40);
    const int nblk = (nrows_all + per - 1) / per;
    for (int blk = blockIdx.x; blk < nblk; blk += gridDim.x) {
    const int rb0 = r_begin + blk * per, rb1 = min(rb0 + per, T);
    const int q4 = per / 8, extra = per - 8 * q4;
    const int myn = q4 + (wave < extra ? 1 : 0), myr0 = rb0 + wave * q4 + min(wave, extra);
    const int nrow = max(0, min(myn, rb1 - myr0));
    const float* g2 = p.in[INORM2] + l * D;
    int ln = lane; PG8_OPAQUE(ln);
    float hv[5][D / 64];
#pragma unroll
    for (int rr = 0; rr < 5; ++rr) {
        const int r = min(myr0 + rr, T - 1); int t, len, mr; seq_info(r, t, len, mr);
        const float* xr = WSF(O_X) + (size_t)r * D;
        float ss = 0.f;
#pragma unroll
        for (int i = 0; i < D / 256; ++i) { const float4 x = *(const float4*)(xr + (i * 64 + ln) * 4); hv[rr][4 * i] = x.x; hv[rr][4 * i + 1] = x.y; hv[rr][4 * i + 2] = x.z; hv[rr][4 * i + 3] = x.w; ss += x.x * x.x + x.y * x.y + x.z * x.z + x.w * x.w; }
        ss = wave_bcast63(wave_total63(ss));
        const float rs = rsqrtf(ss / (float)D + NORM_EPS);
        const float* md = WSF(O_MOD) + ((size_t)l * (NB + 1) + mr) * 6 * D;
#pragma unroll
        for (int i = 0; i < D / 256; ++i) {
            const int c = (i * 64 + ln) * 4;
            const float4 g = *(const float4*)(g2 + c), sh = *(const float4*)(md + 3 * D + c), sc = *(const float4*)(md + 4 * D + c);
            const float h0 = (hv[rr][4 * i] * rs * g.x) * (1.0f + sc.x) + sh.x, h1 = (hv[rr][4 * i + 1] * rs * g.y) * (1.0f + sc.y) + sh.y;
            const float h2 = (hv[rr][4 * i + 2] * rs * g.z) * (1.0f + sc.z) + sh.z, h3 = (hv[rr][4 * i + 3] * rs * g.w) * (1.0f + sc.w) + sh.w;
            hv[rr][4 * i] = h0; hv[rr][4 * i + 1] = h1; hv[rr][4 * i + 2] = h2; hv[rr][4 * i + 3] = h3;
            if (rr < nrow) { uint2 o; o.x = pg8::pk_bf16(h0, h1); o.y = pg8::pk_bf16(h2, h3); *(uint2*)(WSH(O_H2B) + (size_t)r * D + c) = o; }
        }
        WAVE_FENCE();
    }
#pragma unroll 1
    for (int ch = 0; ch < 6; ++ch) {
        __syncthreads();
        {
            const float* wsrc = WSF(O_WRT) + ((size_t)l * (4 + NE) + ch * 6) * D;
            for (int i4 = TX_; i4 < 6 * D / 4; i4 += NT) *(LAS pg8::f32x4*)(Wc + i4 * 4) = *(const pg8::f32x4*)(wsrc + i4 * 4);
        }
        __syncthreads();
        float acc[5][6];
#pragma unroll
        for (int rr = 0; rr < 5; ++rr)
#pragma unroll
            for (int n = 0; n < 6; ++n) acc[rr][n] = 0.f;
#pragma unroll
        for (int i = 0; i < D / 256; ++i) {
#pragma unroll
            for (int n = 0; n < 6; ++n) {
                const pg8::f32x4 wq = *(const LAS pg8::f32x4*)(Wc + n * D + (i * 64 + lane) * 4);
#pragma unroll
                for (int rr = 0; rr < 5; ++rr) acc[rr][n] += hv[rr][4 * i] * wq[0] + hv[rr][4 * i + 1] * wq[1] + hv[rr][4 * i + 2] * wq[2] + hv[rr][4 * i + 3] * wq[3];
            }
#pragma unroll
            for (int rr = 0; rr < 5; ++rr) ACC_PIN6(acc[rr]);
            WAVE_FENCE();
        }
#pragma unroll
        for (int rr = 0; rr < 5; ++rr)
#pragma unroll
            for (int n = 0; n < 6; ++n) { const float tsum = wave_total63(acc[rr][n]); if (lane == 63) lg[rr * 40 + ch * 6 + n] = tsum; }
    }
    WAVE_SYNC();
    if (lane < nrow && !dry) {
        const int r = myr0 + lane; const LAS float* q = lg + lane * 40;
        float lgv[36];
#pragma unroll
        for (int i = 0; i < 36; ++i) lgv[i] = q[i] + (i < 4 ? p.in[IRGB][l * 4 + i] : p.in[IREB][l * NE + i - 4]);
        int gi = 0; float gm = lgv[0];
#pragma unroll
        for (int i = 1; i < 4; ++i) if (lgv[i] > gm) { gm = lgv[i]; gi = i; }
        float gs = 0.f;
#pragma unroll
        for (int i = 0; i < 4; ++i) gs += expf(lgv[i] - gm);
        const float g_top = 1.0f / gs;
        float el[8];
#pragma unroll
        for (int i = 0; i < 8; ++i) el[i] = (gi == 0) ? lgv[4 + i] : (gi == 1 ? lgv[12 + i] : (gi == 2 ? lgv[20 + i] : lgv[28 + i]));
        int e0 = 0; float m0 = el[0];
#pragma unroll
        for (int i = 1; i < 8; ++i) if (el[i] > m0) { m0 = el[i]; e0 = i; }
        int e1 = -1; float m1 = -3.0e38f;
#pragma unroll
        for (int i = 0; i < 8; ++i) if (i != e0 && el[i] > m1) { m1 = el[i]; e1 = i; }
        const float p1 = expf(m1 - m0);
        const float w0 = g_top / (1.0f + p1), w1 = g_top * p1 / (1.0f + p1);
        const int id0 = gi * 8 + e0, id1 = gi * 8 + e1;
        WSI(O_EID)[2 * r] = id0; WSI(O_EID)[2 * r + 1] = id1; WSF(O_EWT)[2 * r] = w0; WSF(O_EWT)[2 * r + 1] = w1;
        WSI(O_POS)[2 * r] = atomicAdd(&WSI(O_ECNT)[l * NE + id0], 1);
        WSI(O_POS)[2 * r + 1] = atomicAdd(&WSI(O_ECNT)[l * NE + id1], 1);
    }
    WAVE_SYNC();
    }
    __syncthreads();
}

constexpr int LDS_TOFF = pg8::STAGE_BYTES;
__device__ __forceinline__ void moe_offsets(const Params& p, int l, LAS int* toff) {
    const int TX_ = ltid(p.sw);
    __syncthreads();
    if (TX_ < NE) toff[64 + TX_] = WSI(O_ECNT)[l * NE + TX_];
    __syncthreads();
    if (TX_ <= NE) { int s = 0; for (int q = 0; q < TX_; ++q) s += (toff[64 + q] + 255) >> 8; toff[TX_] = s; }
    __syncthreads();
}
PHASE_FN void ph_gather(const Params& p, int l, bool need_ctx, LAS unsigned char* lds) {
    const int TX_ = ltid(p.sw);
    LAS int* toff = (LAS int*)(lds + LDS_TOFF);
    moe_offsets(p, l, toff);
    const int wave = TX_ >> 6, lane = TX_ & 63;
    const int s_begin = need_ctx ? 0 : 2 * TC;
    for (int sl = s_begin + blockIdx.x * NT + TX_; sl < 2 * T; sl += gridDim.x * NT) {
        const int e = WSI(O_EID)[sl], dst = toff[e] * 256 + WSI(O_POS)[sl];
        WSI(O_SLOTOF)[dst] = sl; WSF(O_WTP)[dst] = WSF(O_EWT)[sl];
    }
    for (int e = blockIdx.x; e < NE; e += gridDim.x) {
        const int r0 = toff[e] * 256 + toff[64 + e], r1 = toff[e + 1] * 256;
        for (int r = r0 + TX_; r < r1; r += NT) { WSI(O_SLOTOF)[r] = -1; WSF(O_WTP)[r] = 0.f; }
    }
    __syncthreads();
}
PHASE_FN void ph_moe1(const Params& p, int l, LAS unsigned char* lds) {
    LAS int* toff = (LAS int*)(lds + LDS_TOFF);
    moe_offsets(p, l, toff);
    pg8::MoeGatherOrder S{(const char*)WSH(O_H2B), (const char*)(WSH(O_EGU) + (size_t)l * NE * 2 * DE * D), (size_t)2 * DE * D * 2, (size_t)256 * D * 2, 2 * DE / 256, (int)gridDim.x, (int)blockIdx.x, toff, WSI(O_SLOTOF)};
    pg8::EpiSwiglu E{WSH(O_ACTB), WSF(O_WTP)};
    pg8::gemm_phase<pg8::EpiSwiglu, pg8::MoeGatherOrder>(lds, D, D, D, S, E, ltid(p.sw));
}
PHASE_FN void ph_moe2(const Params& p, int l, LAS unsigned char* lds) {
    LAS int* toff = (LAS int*)(lds + LDS_TOFF);
    moe_offsets(p, l, toff);
    pg8::MoeOrder S{(const char*)WSH(O_ACTB), (const char*)(WSH(O_ED) + (size_t)l * NE * D * DE), (size_t)256 * DE * 2, (size_t)D * DE * 2, (size_t)256 * DE * 2, D / 256, (int)gridDim.x, (int)blockIdx.x, toff};
    pg8::EpiDown E{WSH(O_YSB), WSI(O_SLOTOF)};
    pg8::gemm_phase<pg8::EpiDown, pg8::MoeOrder>(lds, DE, DE, DE, S, E, ltid(p.sw));
}

enum { PH_P0 = 0, PH_NORM1, PH_WIN, PH_PREP, PH_MIX, PH_READOUT, PH_MERGE, PH_WOUT, PH_NORM2, PH_GATHER, PH_MOE1, PH_MOE2, PH_FINAL };
template <int PH> __device__ __forceinline__ void run_phase(const Params& p_in, int l, unsigned char* smem, int sw) {
    const bool need_ctx = (l != DEPTH - 1);
    float* ldsf = (float*)smem;
    Params p;
#ifdef EMU
    p = p_in; p.sw = sw;
#else
    typedef const __attribute__((address_space(4))) Params* KP;
    KP kp = (KP)__builtin_amdgcn_kernarg_segment_ptr();
    asm volatile("" : "+s"(kp));
#pragma unroll
    for (int i = 0; i < N_IN; ++i) p.in[i] = kp->in[i];
    p.out = kp->out; p.ws = kp->ws; p.sw = sw; p.pad = 0;
    (void)p_in;
#endif
    LAS unsigned char* ldsl = (LAS unsigned char*)smem;
    if (PH == PH_P0) {
#if PROBE_MASK & 0x2000000
        {
            const int TX_ = ltid(p.sw); unsigned acc_ = 0;
            const size_t gt_ = (size_t)blockIdx.x * NT + TX_, gs_ = (size_t)gridDim.x * NT;
            for (size_t pg = gt_; pg < O_END / 4096; pg += gs_) acc_ += ((const volatile unsigned*)p.ws)[pg * 1024];
            for (size_t pg = gt_; pg < (size_t)DEPTH * D * 6 * D / 1024; pg += gs_) acc_ += ((const volatile unsigned*)p.in[IMODW])[pg * 1024];
            for (size_t pg = gt_; pg < (size_t)DEPTH * D * IN_DIM / 1024; pg += gs_) acc_ += ((const volatile unsigned*)p.in[IWIN])[pg * 1024];
            for (size_t pg = gt_; pg < (size_t)DEPTH * NE * D * DE / 1024; pg += gs_) { acc_ += ((const volatile unsigned*)p.in[IEWG])[pg * 1024]; acc_ += ((const volatile unsigned*)p.in[IEWU])[pg * 1024]; acc_ += ((const volatile unsigned*)p.in[IEWD])[pg * 1024]; }
            for (size_t pg = gt_; pg < (size_t)NB * L * D / 1024; pg += gs_) acc_ += ((const volatile unsigned*)p.in[IX])[pg * 1024];
            if (acc_ == 0x12345678u) WSI(O_EID)[0] = 1;
        }
#endif
        ph_pws(p); ph_rope_table(p); ph_lora_pack(p); ph_router_pack(p); ph_mod(p, ldsf); ph_conv_win0(p, ldsf); }
    if (PH == PH_NORM1) {
#if PROBE_MASK & 0x800000
        ph_norm1(p, l, 0, true);
#endif
        ph_norm1(p, l, 0); ph_fold(p, l, ldsf); }
    if (PH == PH_WIN) ph_win(p, l, ldsl);
    if (PH == PH_PREP) ph_prep(p, l, ldsf);
    if (PH == PH_MIX) {
        ph_scan(p, l, ldsl);
#if PROBE_MASK & 0x10000
        ph_scan(p, l, ldsl);
#endif
        ph_attn(p, l, need_ctx, ldsl);
#if PROBE_MASK & 0x20000
        ph_attn(p, l, need_ctx, ldsl);
#endif
    }
    if (PH == PH_READOUT) ph_readout(p, l);
    if (PH == PH_MERGE) ph_merge(p, l, need_ctx, ldsl);
    if (PH == PH_WOUT) ph_wout(p, l, need_ctx, ldsl);
    if (PH == PH_NORM2) {
#if PROBE_MASK & 0x400000
        ph_norm2(p, l, need_ctx, ldsl, true);
#endif
        ph_norm2(p, l, need_ctx, ldsl); }
    if (PH == PH_GATHER) ph_gather(p, l, need_ctx, ldsl);
    if (PH == PH_MOE1) ph_moe1(p, l, ldsl);
    if (PH == PH_MOE2) ph_moe2(p, l, ldsl);
    if (PH == PH_FINAL) {
#if PROBE_MASK & 0x800000
        ph_norm1(p, 0, 2, true);
#endif
        ph_norm1(p, 0, 2); }
}

#ifdef EMU
__shared__ unsigned char emu_smem[LDS_BYTES] __attribute__((aligned(16)));
template <int PH> __global__ void k_phase(Params p, int l) { run_phase<PH>(p, l, emu_smem, 0); }
#else
#define XB_TMO      128
#define XB_XCNT(j)  (256  + 64 * (j))
#define XB_XSUB(j)  (1280 + 64 * (j))
#define XB_XGEN(j)  (2304 + 64 * (j))
#define XB_TOP      3328
#define XB_TOPGEN   3392
#define XCD_BAR_WORDS 3456
#define XB_SPIN_CAP (1u << 18)
__device__ __forceinline__ unsigned xb_ld(unsigned* p)              { return __hip_atomic_load(p, __ATOMIC_RELAXED, __HIP_MEMORY_SCOPE_AGENT); }
__device__ __forceinline__ unsigned xb_add(unsigned* p, unsigned v) { return __hip_atomic_fetch_add(p, v, __ATOMIC_RELAXED, __HIP_MEMORY_SCOPE_AGENT); }
__device__ __forceinline__ unsigned xb_xcc_id() { return (unsigned)__builtin_amdgcn_s_getreg((3 << 11) | 20) & 0xFu; }
#define XB_SPIN(cond, bar) do { unsigned _sp = 0; while (cond) { __builtin_amdgcn_s_sleep(1); \
    if ((++_sp & 255u) == 0u) { if (xb_ld(&(bar)[XB_TMO])) break; if (_sp > XB_SPIN_CAP) { atomicAdd(&(bar)[XB_TMO], 1u); break; } } } } while (0)
struct XcdBarrier { unsigned* bar; unsigned x; volatile LAS unsigned* st; };
__device__ __forceinline__ XcdBarrier xcd_barrier_post(unsigned* bar, volatile LAS unsigned* st) {
    XcdBarrier b; b.bar = bar; b.x = xb_xcc_id(); b.st = st;
    if (threadIdx.x == 0) (void)xb_add(&bar[XB_XCNT(b.x)], 1u);
    return b;
}
__device__ __forceinline__ void xcd_barrier_complete(unsigned* bar, unsigned x, unsigned& nloc, unsigned& nx) {
    const unsigned G = gridDim.x * gridDim.y * gridDim.z;
    unsigned sum, cnt, mine, sp = 0u;
    for (;;) {
        sum = 0u; cnt = 0u; mine = 0u;
#pragma unroll
        for (unsigned j = 0; j < 16; ++j) { const unsigned c = xb_ld(&bar[XB_XCNT(j)]); sum += c; cnt += (c > 0u) ? 1u : 0u; mine = (j == x) ? c : mine; }
        if (sum == G) break;
        __builtin_amdgcn_s_sleep(1);
        if ((++sp & 255u) == 0u) { if (xb_ld(&bar[XB_TMO])) break; if (sp > XB_SPIN_CAP) { atomicAdd(&bar[XB_TMO], 1u); break; } }
    }
    nloc = mine > 0u ? mine : 1u; nx = cnt > 0u ? cnt : 1u;
}
__device__ __forceinline__ void xcd_barrier(const XcdBarrier& b_in, const int sw) {
    asm volatile("s_waitcnt vmcnt(0)" ::: "memory");
    __syncthreads();
    XcdBarrier b = b_in;
    asm volatile("" : "+s"(b.bar), "+s"(b.x));
    if (ltid(sw) == 0) {
        unsigned* bar = b.bar;
        __builtin_amdgcn_s_waitcnt(0);
        unsigned nloc = b.st[0], nx = b.st[1];
        if (nloc == 0u) { xcd_barrier_complete(bar, b.x, nloc, nx); b.st[0] = nloc; b.st[1] = nx; }
        const unsigned old = xb_add(&bar[XB_XSUB(b.x)], 1u);
        const unsigned gen = old / nloc;
        if (old + 1u == (gen + 1u) * nloc) {
            __builtin_amdgcn_fence(__ATOMIC_RELEASE, "agent");
            asm volatile("s_waitcnt vmcnt(0)" ::: "memory");
            const unsigned og = xb_add(&bar[XB_TOP], 1u);
            const unsigned tg = og / nx;
            if (og + 1u == (tg + 1u) * nx) xb_add(&bar[XB_TOPGEN], 1u);
            else XB_SPIN(xb_ld(&bar[XB_TOPGEN]) == tg, bar);
            __builtin_amdgcn_fence(__ATOMIC_ACQUIRE, "agent");
            xb_add(&bar[XB_XGEN(b.x)], 1u);
            asm volatile("s_waitcnt vmcnt(0)" ::: "memory");
        } else {
            XB_SPIN(xb_ld(&bar[XB_XGEN(b.x)]) == gen, bar);
            __builtin_amdgcn_fence(__ATOMIC_ACQUIRE, "agent");
            asm volatile("s_waitcnt vmcnt(0)" ::: "memory");
        }
    }
    __syncthreads();
}

#define RUNB(PH, l) { run_phase<PH>(p, l, smem, sw); if ((PROBE_MASK >> PH) & 1) run_phase<PH>(p, l, smem, sw); xcd_barrier(bar, sw); if (PROBE_MASK & 0x1000000) xcd_barrier(bar, sw); }
__global__ void __launch_bounds__(NT, 2) k_mega(Params p) {
    extern __shared__ __attribute__((aligned(16))) unsigned char smem[];
    const int sw = __builtin_amdgcn_readfirstlane((int)(threadIdx.x >> 6));
    volatile LAS unsigned* xbw = (volatile LAS unsigned*)((LAS unsigned char*)smem + LDS_BYTES - 16);
    if (threadIdx.x == 0) { xbw[0] = 0u; xbw[1] = 0u; xbw[2] = 0u; xbw[3] = 0u; }
    __syncthreads();
    XcdBarrier bar = xcd_barrier_post((unsigned*)(p.ws + O_BAR), xbw);
    RUNB(PH_P0, 0)
    for (int l = 0; l < DEPTH; ++l) {
        RUNB(PH_NORM1, l)
        RUNB(PH_WIN, l)
        RUNB(PH_PREP, l)
        RUNB(PH_MIX, l)
        RUNB(PH_READOUT, l)
        RUNB(PH_MERGE, l)
        RUNB(PH_WOUT, l)
        RUNB(PH_NORM2, l)
        RUNB(PH_GATHER, l)
        RUNB(PH_MOE1, l)
        RUNB(PH_MOE2, l)
    }
    run_phase<PH_FINAL>(p, 0, smem, sw);
}
#endif
}

extern "C" void kernel_launch(void* const* d_in, const int* in_sizes, int n_in, void* d_out, int out_size, void* d_ws, size_t ws_size, hipStream_t stream) {
    Params p{};
    for (int i = 0; i < N_IN; ++i) p.in[i] = (const float*)d_in[i];
    p.out = (float*)d_out;
    p.ws = (unsigned char*)d_ws;
    (void)in_sizes; (void)n_in; (void)out_size;
    if (ws_size < O_END) return;
#ifndef EMU
    static int grid = 0;
    if (!grid) {
        int dev = 0, cus = 0, per_cu = 0;
        (void)hipGetDevice(&dev);
        (void)hipDeviceGetAttribute(&cus, hipDeviceAttributeMultiprocessorCount, dev);
        (void)hipFuncSetAttribute((const void*)k_mega, hipFuncAttributeMaxDynamicSharedMemorySize, LDS_BYTES);
        (void)hipOccupancyMaxActiveBlocksPerMultiprocessor(&per_cu, (const void*)k_mega, NT, LDS_BYTES);
        (void)hipGetLastError();
        grid = cus;
    }
    (void)hipMemsetAsync(p.ws, 0, ZERO_BYTES, stream);
    hipLaunchKernelGGL(k_mega, dim3(grid), dim3(NT), LDS_BYTES, stream, p);
#else
    memset(p.ws, 0, ZERO_BYTES);
    const int G = 64;
#define LAUNCH(PH, l) emu::launch([=] { k_phase<PH>(p, l); }, dim3(G), dim3(NT))
    LAUNCH(PH_P0, 0);
    for (int l = 0; l < DEPTH; ++l) {
        LAUNCH(PH_NORM1, l); LAUNCH(PH_WIN, l); LAUNCH(PH_PREP, l); LAUNCH(PH_MIX, l); LAUNCH(PH_READOUT, l);
        LAUNCH(PH_MERGE, l); LAUNCH(PH_WOUT, l); LAUNCH(PH_NORM2, l); LAUNCH(PH_GATHER, l); LAUNCH(PH_MOE1, l); LAUNCH(PH_MOE2, l);
    }
    LAUNCH(PH_FINAL, 0);
#endif
}
```

```cpp
#ifndef EMU
#include <hip/hip_runtime.h>
#endif
#include <stdint.h>
#include <stddef.h>

#ifndef CFG_D
#define CFG_D 2048
#define CFG_B 4
#define CFG_L 2048
#define CFG_C 256
#endif
#ifndef PROBE_MASK
#define PROBE_MASK 0
#endif
#ifdef EMU
#define LAS
#else
#define LAS __attribute__((address_space(3)))
#endif
namespace {
constexpr int D = CFG_D, NB = CFG_B, L = CFG_L, C = CFG_C, DEPTH = 2;
constexpr int TC = NB * C, TL = NB * L, T = TC + TL;
constexpr int PGD = D / 16, PW = 4 * PGD;
constexpr int RH = D / 256, RW = RH * 64, DL = D / 32, IL = D / 32, GL = D / 16, RC = 3 * RW + DL + IL + GL;
constexpr int QH = D / 256, KVH = QH / 4, AW = QH * 128, KVW = KVH * 128;
constexpr int IN_DIM = PW + RC + AW + 2 * KVW + 3 * D;
constexpr int OFF_XA = 0, OFF_RW = PW, OFF_Q = PW + RC, OFF_K = OFF_Q + AW, OFF_V = OFF_K + KVW, OFF_GA = OFF_V + KVW, OFF_GB = OFF_GA + D, OFF_GC = OFF_GB + D;
constexpr int DE = D / 4, NE = 32;
constexpr float NORM_EPS = 1e-6f, GN_EPS = 64e-5f;
constexpr int NT = 512, NW = NT / 64;
constexpr int LDS_BYTES = 147456;
static_assert(T % 256 == 0 && TC % 256 == 0 && IN_DIM % 256 == 0 && D % 256 == 0, "tile shapes");

typedef unsigned short bf16_t;
enum { IX = 0, IC, ICTX, ICCTX, IMODW, IMODB, INORM1, IWIN, IPOOLW, IPOOLS, IMU, IDW0, IDUP, IA0, IAUP, IGUP, IKK, IKA, IRK, ILNG, ILNB, ISINK, IPP, IPR, IPA, IWOUT, INORM2, IRGW, IRGB, IREW, IREB, IEWG, IEWU, IEWD, IFG, N_IN };

struct Params { const float* in[N_IN]; float* out; unsigned char* ws; int sw, pad; };

constexpr size_t A256(size_t x) { return (x + 255) & ~(size_t)255; }
constexpr size_t O_BAR = 0;
constexpr size_t O_ECNT = 16384;
constexpr size_t ZERO_BYTES = O_ECNT + 1024;
constexpr int UW = OFF_GA;
constexpr int KCAT = PW + RW + AW;
constexpr int RPAD = 2 * T + NE * 256;
constexpr size_t MAXS(size_t a, size_t b) { return a > b ? a : b; }
constexpr size_t O_X = ZERO_BYTES;
constexpr size_t O_MOD = O_X + A256((size_t)T * D * 4);
constexpr size_t O_HB = O_MOD + A256((size_t)DEPTH * (NB + 1) * 6 * D * 4);
constexpr size_t O_MBB = O_HB, O_H2B = O_HB;
constexpr size_t O_U = O_HB + A256((size_t)T * D * 2);
constexpr size_t O_POOLED = O_U + A256((size_t)T * UW * 4);
constexpr size_t O_LP = O_POOLED;
constexpr size_t O_WRT = O_LP + A256((size_t)DEPTH * NW * 12 * 4 * 1024);
constexpr int LKS = 12;
constexpr size_t O_QB = O_POOLED + A256((size_t)T * PW * 4);
static_assert(O_WRT + (size_t)DEPTH * (4 + NE) * D * 4 <= O_QB, "LoRA fragments and router table must fit the former pooled buffer");
constexpr size_t O_QRB = O_QB + A256((size_t)T * AW * 2);
constexpr size_t O_KB = O_QRB + A256((size_t)TL * AW * 2);
constexpr size_t O_VB = O_KB + A256((size_t)T * KVW * 2);
constexpr size_t O_KR = O_VB + A256((size_t)T * KVW * 2);
constexpr size_t O_RA = O_KR;
constexpr size_t O_V = O_RA;
constexpr size_t O_G = O_V + A256((size_t)T * RW * 4);
constexpr size_t O_BON = O_G + A256((size_t)T * RW * 4);
constexpr size_t O_Y = O_BON + A256((size_t)T * RH * 4);
constexpr size_t O_PACK = O_Y + A256((size_t)2 * T * RW * 4);
constexpr int REC = 1280;
constexpr size_t PACK_BYTES = (size_t)2 * T * RH * REC;
constexpr size_t O_RA_END1 = O_PACK + A256(PACK_BYTES);
constexpr size_t O_H2G = O_RA;
constexpr size_t O_ACTB = O_H2G + A256((size_t)RPAD * D * 2);
constexpr size_t O_YSB = O_ACTB + A256((size_t)RPAD * DE * 2);
constexpr size_t O_RA_END2 = O_YSB + A256((size_t)2 * T * D * 2);
constexpr size_t O_SG = MAXS(O_RA_END1, O_RA_END2);
constexpr size_t O_OCAT = O_SG + A256((size_t)T * 3 * D * 2);
constexpr size_t O_WTP = O_OCAT + A256((size_t)T * KCAT * 2);
constexpr size_t O_SLOTOF = O_WTP + A256((size_t)RPAD * 4);
constexpr size_t O_POS = O_SLOTOF + A256((size_t)RPAD * 4);
constexpr size_t O_EWT = O_POS + A256((size_t)2 * T * 4);
constexpr size_t O_EID = O_EWT + A256((size_t)2 * T * 4);
constexpr size_t O_ROPE = O_EID + A256((size_t)2 * T * 4);
constexpr size_t O_PWS = O_ROPE + A256((size_t)L * 128 * 4);
constexpr size_t O_WINT = O_PWS + A256((size_t)DEPTH * 4 * PGD * PGD * 4);
constexpr size_t O_WMT = O_WINT + A256((size_t)DEPTH * IN_DIM * D * 2);
constexpr size_t O_WOT = O_WMT + A256((size_t)DEPTH * D * KCAT * 2);
constexpr size_t O_EGU = O_WOT + A256((size_t)DEPTH * D * D * 2);
constexpr size_t O_ED = O_EGU + A256((size_t)DEPTH * NE * 2 * DE * D * 2);
constexpr size_t O_END = O_ED + A256((size_t)DEPTH * NE * D * DE * 2);
#define WSF(off) ((float*)(p.ws + (off)))
#define WSI(off) ((int*)(p.ws + (off)))
#define WSH(off) ((bf16_t*)(p.ws + (off)))

__device__ __forceinline__ float sigmoidf_(float x) { return 1.0f / (1.0f + expf(-x)); }
__device__ __forceinline__ float siluf_(float x) { return x * sigmoidf_(x); }
__device__ __forceinline__ float softplusf_(float x) { return fmaxf(x, 0.0f) + log1pf(expf(-fabsf(x))); }
#ifdef EMU
__device__ __forceinline__ bf16_t f2bf(float f) { unsigned u; __builtin_memcpy(&u, &f, 4); u += 0x7FFFu + ((u >> 16) & 1u); return (bf16_t)(u >> 16); }
__device__ __forceinline__ unsigned cvt_pk_bf16(float lo, float hi) { return (unsigned)f2bf(lo) | ((unsigned)f2bf(hi) << 16); }
#else
typedef float cv_f32x2 __attribute__((ext_vector_type(2)));
typedef __bf16 cv_bf16x2 __attribute__((ext_vector_type(2)));
__device__ __forceinline__ unsigned cvt_pk_bf16(float lo, float hi) { const cv_f32x2 v = {lo, hi}; return __builtin_bit_cast(unsigned, __builtin_convertvector(v, cv_bf16x2)); }
__device__ __forceinline__ bf16_t f2bf(float f) { return (bf16_t)(cvt_pk_bf16(f, 0.f) & 0xffffu); }
#endif
__device__ __forceinline__ float bf2f(bf16_t h) { unsigned u = ((unsigned)h) << 16; float f; __builtin_memcpy(&f, &u, 4); return f; }

__device__ __forceinline__ int ltid(int sw) {
#ifdef EMU
    (void)sw; return threadIdx.x;
#else
    int t;
    asm volatile("v_mbcnt_lo_u32_b32 %0, -1, 0\n\tv_mbcnt_hi_u32_b32 %0, -1, %0" : "=v"(t));
    return t | (sw << 6);
#endif
}
__device__ __forceinline__ void seq_info(int r, int& t, int& len, int& modrow) {
    if (r < TC) { t = r % C; len = C; modrow = NB; }
    else { const int q = r - TC; t = q % L; len = L; modrow = q / L; }
}
__device__ __forceinline__ float lane_xor(float v, int lane, int m) {
#ifdef EMU
    (void)lane; return __shfl_xor(v, m);
#else
    return __builtin_bit_cast(float, __builtin_amdgcn_ds_bpermute((lane ^ m) << 2, __builtin_bit_cast(int, v)));
#endif
}
__device__ __forceinline__ float wave_sum(float v, int lane) {
#pragma unroll
    for (int m = 32; m >= 1; m >>= 1) v += lane_xor(v, lane, m);
    return v;
}
__device__ __forceinline__ float wave_max(float v, int lane) {
#pragma unroll
    for (int m = 32; m >= 1; m >>= 1) v = fmaxf(v, lane_xor(v, lane, m));
    return v;
}
__device__ __forceinline__ float block_sum(float v, float* red, const int TX_) {
    v = wave_sum(v, TX_ & 63);
    __syncthreads();
    if ((TX_ & 63) == 0) red[TX_ >> 6] = v;
    __syncthreads();
    float s = 0.f;
#pragma unroll
    for (int i = 0; i < NW; ++i) s += red[i];
    return s;
}
#define PHASE_FN __device__ __forceinline__
#ifdef EMU
#define WAVE_SYNC() emu::wave_sync()
#define WAVE_FENCE()
#else
#define WAVE_SYNC() asm volatile("" ::: "memory")
#define WAVE_FENCE() asm volatile("" ::: "memory")
#endif
#ifdef EMU
#define ACC_PIN12(a)
#define ACC_PIN6(a)
#else
#define ACC_PIN6(a) asm volatile("" : "+v"((a)[0]), "+v"((a)[1]), "+v"((a)[2]), "+v"((a)[3]), "+v"((a)[4]), "+v"((a)[5]))
#define ACC_PIN12(a) asm volatile("" : "+v"((a)[0]), "+v"((a)[1]), "+v"((a)[2]), "+v"((a)[3]), "+v"((a)[4]), "+v"((a)[5]), "+v"((a)[6]), "+v"((a)[7]), "+v"((a)[8]), "+v"((a)[9]), "+v"((a)[10]), "+v"((a)[11]))
#endif

namespace pg8 {
typedef short bf16x8 __attribute__((ext_vector_type(8)));
typedef float f32x4 __attribute__((ext_vector_type(4)));
typedef unsigned u32x4 __attribute__((ext_vector_type(4)));
typedef unsigned u32x2 __attribute__((ext_vector_type(2)));
constexpr int BM = 256, BK = 64, HALF = 128, HTB = HALF * BK * 2, STAGE_BYTES = 8 * HTB, NXCD = 8, WGM = 8;
__host__ __device__ __forceinline__ int lds_byte(int r, int c) { const int st = (r >> 4) * 2 + (c >> 5), rr = r & 15, cc = c & 31, ob = rr * 64 + cc * 2; return st * 1024 + (ob ^ (((ob >> 9) & 1) << 5)); }
__host__ __device__ __forceinline__ void stage_rc(int b, int& R, int& Cc) { const int st = b / 1024, sb = b % 1024, swz = sb ^ (((sb >> 9) & 1) << 5); R = (st >> 1) * 16 + swz / 64; Cc = (st & 1) * 32 + (swz % 64) / 2; }
__host__ __device__ __forceinline__ int perm32(int rho) { const int n = rho >> 4, i = rho & 15; return 8 * (i >> 2) + 4 * n + (i & 3); }
struct Unit { const char* a; const char* b; int pm, pn; };

#ifdef EMU
#define PG8_GLDS(gp, lp) __builtin_memcpy((unsigned char*)(lp) + (threadIdx.x & 63) * 16, (gp), 16)
#define PG8_WAIT_V(n)
#define PG8_WAIT_L(n)
#define PG8_BAR __syncthreads()
#define PG8_SCHED
#define PG8_PRIO(x)
#define PG8_RFL(x) (x)
#define PG8_MEMFENCE
#define PG8_OPAQUE(x)
#else
#define PG8_GLDS(gp, lp) __builtin_amdgcn_global_load_lds((const unsigned*)(gp), (LAS unsigned*)(lp), 16, 0, 0)
#define PG8_WAIT_V(n) asm volatile("s_waitcnt vmcnt(" #n ")" ::: "memory")
#define PG8_WAIT_L(n) asm volatile("s_waitcnt lgkmcnt(" #n ")" ::: "memory")
#define PG8_BAR __builtin_amdgcn_s_barrier()
#define PG8_SCHED __builtin_amdgcn_sched_barrier(0)
#define PG8_PRIO(x) __builtin_amdgcn_s_setprio(x)
#define PG8_RFL(x) __builtin_amdgcn_readfirstlane(x)
#define PG8_MEMFENCE asm volatile("" ::: "memory")
#define PG8_OPAQUE(x) asm volatile("" : "+v"(x))
#endif

struct DenseOrder {
    static constexpr bool GATHER = false;
    const char* A; const char* Bt; size_t tstepA, tstepB; int nM, nN, nwg, G, c, pm0;
    __device__ void init(const void* A_, int lda, const void* Bt_, int ldb, int pm0_, int nM_, int nN_, int G_, int c_) {
        A = (const char*)A_; Bt = (const char*)Bt_; tstepA = (size_t)BM * lda * 2; tstepB = (size_t)BM * ldb * 2; pm0 = pm0_; nM = nM_; nN = nN_; nwg = nM * nN; G = G_; c = c_; }
    __device__ bool next(int i, Unit& u) const {
        const long Lx = (long)i * G + c; if (Lx >= nwg) return false;
        int wgid = (int)Lx; { const int q = nwg / NXCD, r = nwg % NXCD, xcd = wgid % NXCD, off = wgid / NXCD; wgid = (xcd < r ? xcd * (q + 1) : r * (q + 1) + (xcd - r) * q) + off; }
        const int nig = WGM * nN, gid = wgid / nig, fm = gid * WGM, gsz = (nM - fm) < WGM ? (nM - fm) : WGM;
        u.pm = pm0 + fm + ((wgid % nig) % gsz); u.pn = (wgid % nig) / gsz;
        u.a = A + (size_t)u.pm * tstepA; u.b = Bt + (size_t)u.pn * tstepB; return true;
    }
};

struct WinOrder {
    static constexpr bool GATHER = false;
    DenseOrder lat; const char* A; const char* Bt; size_t tstepA, tstepB; int nlat, nctx, G, c; bool all_ctx;
    __device__ void init(const void* A_, const void* Bt_, int lda, int ldb, int G_, int c_, bool all_ctx_) {
        A = (const char*)A_; Bt = (const char*)Bt_; tstepA = (size_t)BM * lda * 2; tstepB = (size_t)BM * ldb * 2; G = G_; c = c_; all_ctx = all_ctx_;
        lat.init(A_, lda, Bt_, ldb, all_ctx_ ? 0 : TC / BM, all_ctx_ ? T / BM : TL / BM, IN_DIM / BM, G_, c_);
        nlat = lat.nwg; nctx = all_ctx_ ? 0 : (TC / BM) * 7; }
    __device__ bool next(int i, Unit& u) const {
        const long Lx = (long)i * G + c;
        if (Lx < nlat) return lat.next(i, u);
        const int j = (int)(Lx - nlat); if (j >= nctx) return false;
        const int q = j % 7; u.pm = j / 7;
        u.pn = (q < 5) ? (OFF_RW + RW) / BM + q : OFF_K / BM + (q - 5);
        u.a = A + (size_t)u.pm * tstepA; u.b = Bt + (size_t)u.pn * tstepB; return true;
    }
};
template <class Epi, class Sched>
__device__ __forceinline__ void gemm_phase(LAS unsigned char* lds, const int lda, const int ldb, const int K, const Sched& S, const Epi& E, const int TX_) {
    const int tid = TX_, wid = PG8_RFL(tid >> 6), lane = tid & 63, wr = wid >> 2, wc = wid & 3, fr = lane & 15, fq = lane >> 4;
    const int nt = K / BK;
    constexpr bool GA = Sched::GATHER;
    unsigned voffA[2], voffB[2];
    int gaR[2], gaC[2];
#pragma unroll
    for (int i = 0; i < 2; ++i) { int R, Cc; stage_rc(tid * 16 + i * 8192, R, Cc); const int Rb = Epi::PERM ? ((R & ~31) + perm32(R & 31)) : R;
        voffA[i] = (unsigned)(R * lda + Cc) * 2u; voffB[i] = (unsigned)(Rb * ldb + Cc) * 2u; gaR[i] = R; gaC[i] = Cc; }
    unsigned vgc[2][2], vgn[2][2];
#define PG8_GAOFF(dst, pm_) do { if constexpr (GA) { _Pragma("unroll") for (int h_ = 0; h_ < 2; ++h_) _Pragma("unroll") for (int i_ = 0; i_ < 2; ++i_) \
        dst[h_][i_] = (S.src_row((pm_), h_ * HALF + gaR[i_]) * (unsigned)lda + (unsigned)gaC[i_]) * 2u; } } while (0)
#define PG8_STAGE_A(bufoff, gptr, h, nextsel) do { if constexpr (GA) { unsigned vs_[2] = {(nextsel) ? vgn[h][0] : vgc[h][0], (nextsel) ? vgn[h][1] : vgc[h][1]}; PG8_STAGE(bufoff, gptr, vs_); } \
        else { PG8_STAGE(bufoff, (gptr) + (h) * hstepA, voffA); } } while (0)
    const size_t kstep = (size_t)(BK * 2);
    const size_t hstepA = (size_t)HALF * lda * 2, hstepB = (size_t)HALF * ldb * 2;
    const unsigned ldsw = (unsigned)wid * 1024u;
    const int aoff = lds_byte(wr * 64 + fr, fq * 8), boff = lds_byte(wc * 32 + fr, fq * 8);
#define PG8_SA(b, h) (((b) * 2 + (h)) * HTB)
#define PG8_SB(b, h) ((4 + (b) * 2 + (h)) * HTB)
#define PG8_STAGE(bufoff, gbase, voff) do { _Pragma("unroll") for (int _i = 0; _i < 2; ++_i) PG8_GLDS((const char*)(gbase) + (voff)[_i], lds + (bufoff) + ldsw + _i * 8192); } while (0)
#define PG8_LDA(dst, b, h) do { _Pragma("unroll") for (int m = 0; m < 4; ++m) _Pragma("unroll") for (int k = 0; k < 2; ++k) dst[m][k] = *(const LAS bf16x8*)(lds + PG8_SA(b, h) + aoff + m * 2048 + k * 1024); } while (0)
#define PG8_LDB(dst, b, h) do { _Pragma("unroll") for (int n = 0; n < 2; ++n) _Pragma("unroll") for (int k = 0; k < 2; ++k) dst[n][k] = *(const LAS bf16x8*)(lds + PG8_SB(b, h) + boff + n * 2048 + k * 1024); } while (0)
#define PG8_MMA(ai, bj, At, Bt) do { PG8_PRIO(1); _Pragma("unroll") for (int m = 0; m < 4; ++m) _Pragma("unroll") for (int n = 0; n < 2; ++n) _Pragma("unroll") for (int k = 0; k < 2; ++k) \
        acc[ai][bj][m][n] = __builtin_amdgcn_mfma_f32_16x16x32_bf16(Bt[n][k], At[m][k], acc[ai][bj][m][n], 0, 0, 0); PG8_PRIO(0); } while (0)
    Unit cur, nxt; int ui = 0;
    if (!S.next(0, cur)) return;
    f32x4 acc[2][2][4][2];
#pragma unroll
    for (int a = 0; a < 2; ++a)
#pragma unroll
        for (int b = 0; b < 2; ++b)
#pragma unroll
            for (int m = 0; m < 4; ++m)
#pragma unroll
                for (int n = 0; n < 2; ++n) acc[a][b][m][n] = (f32x4){0.f, 0.f, 0.f, 0.f};
    bf16x8 At[4][2], B0[2][2], B1[2][2];
    const char* cA = cur.a; const char* cB = cur.b;
    PG8_GAOFF(vgc, cur.pm);
    PG8_STAGE(PG8_SB(0, 0), cB, voffB); PG8_STAGE_A(PG8_SA(0, 0), cA, 0, false); PG8_STAGE(PG8_SB(0, 1), cB + hstepB, voffB); PG8_STAGE_A(PG8_SA(0, 1), cA, 1, false);
    if (wr == 1) PG8_BAR;
    PG8_WAIT_V(4); PG8_BAR;
    PG8_STAGE(PG8_SB(1, 0), cB + kstep, voffB); PG8_STAGE_A(PG8_SA(1, 0), cA + kstep, 0, false); PG8_STAGE(PG8_SB(1, 1), cB + hstepB + kstep, voffB);
    PG8_WAIT_V(6); PG8_BAR;
    for (;;) {
        const bool has_next = S.next(ui + 1, nxt);
        const char* nA = has_next ? nxt.a : cA; const char* nB = has_next ? nxt.b : cB;
        if (has_next) PG8_GAOFF(vgn, nxt.pm); else { if constexpr (GA) { vgn[0][0] = vgc[0][0]; vgn[0][1] = vgc[0][1]; vgn[1][0] = vgc[1][0]; vgn[1][1] = vgc[1][1]; } }
        int t = 0;
#pragma unroll 1
        for (int seg = 0; seg < Epi::NSEG; ++seg) {
        const int tend = Epi::seg_end(seg, nt);
#pragma unroll 1
        for (; t < tend; t += 2) {
            const bool last = (t == nt - 2);
            const char* a1 = cA + (size_t)(t + 1) * kstep;
            const char* a2 = last ? nA : cA + (size_t)(t + 2) * kstep; const char* b2 = last ? nB : cB + (size_t)(t + 2) * kstep;
            const char* a3 = a2 + kstep; const char* b3 = b2 + kstep;
            PG8_LDB(B0, 0, 0); PG8_SCHED; PG8_LDA(At, 0, 0); PG8_STAGE_A(PG8_SA(1, 1), a1, 1, false);
            PG8_WAIT_L(8); PG8_BAR; PG8_WAIT_L(0); PG8_MMA(0, 0, At, B0); PG8_BAR; PG8_SCHED;
            PG8_LDB(B1, 0, 1); PG8_STAGE(PG8_SB(0, 0), b2, voffB);
            PG8_BAR; PG8_WAIT_L(0); PG8_MMA(0, 1, At, B1); PG8_BAR;
            PG8_LDA(At, 0, 1); PG8_STAGE_A(PG8_SA(0, 0), a2, 0, last);
            PG8_BAR; PG8_WAIT_L(0); PG8_MMA(1, 0, At, B0); PG8_BAR; PG8_SCHED;
            PG8_STAGE(PG8_SB(0, 1), b2 + hstepB, voffB);
            PG8_WAIT_V(6); PG8_BAR; PG8_MMA(1, 1, At, B1); PG8_BAR;
            PG8_LDB(B0, 1, 0); PG8_SCHED; PG8_LDA(At, 1, 0); PG8_STAGE_A(PG8_SA(0, 1), a2, 1, last);
            PG8_WAIT_L(8); PG8_BAR; PG8_WAIT_L(0); PG8_MMA(0, 0, At, B0); PG8_BAR; PG8_SCHED;
            PG8_LDB(B1, 1, 1); PG8_STAGE(PG8_SB(1, 0), b3, voffB);
            PG8_BAR; PG8_WAIT_L(0); PG8_MMA(0, 1, At, B1); PG8_BAR;
            PG8_LDA(At, 1, 1); PG8_STAGE_A(PG8_SA(1, 0), a3, 0, last);
            PG8_BAR; PG8_WAIT_L(0); PG8_MMA(1, 0, At, B0); PG8_BAR; PG8_SCHED;
            PG8_STAGE(PG8_SB(1, 1), b3 + hstepB, voffB);
            PG8_WAIT_V(6); PG8_BAR; PG8_MMA(1, 1, At, B1); PG8_BAR;
        }
        if constexpr (Epi::NSEG > 1) { if (seg + 1 < Epi::NSEG) E.mid(acc, cur, seg, wr, wc, fr, fq); }
        }
        E(acc, cur, wr, wc, fr, fq);
        if (!has_next) break;
#pragma unroll
        for (int a = 0; a < 2; ++a)
#pragma unroll
            for (int b = 0; b < 2; ++b)
#pragma unroll
                for (int m = 0; m < 4; ++m)
#pragma unroll
                    for (int n = 0; n < 2; ++n) acc[a][b][m][n] = (f32x4){0.f, 0.f, 0.f, 0.f};
        cur = nxt; cA = nA; cB = nB; ++ui;
        if constexpr (GA) { vgc[0][0] = vgn[0][0]; vgc[0][1] = vgn[0][1]; vgc[1][0] = vgn[1][0]; vgc[1][1] = vgn[1][1]; }
    }
    PG8_WAIT_V(0);
    if (wr == 0) PG8_BAR;
    PG8_BAR;
#undef PG8_SA
#undef PG8_SB
#undef PG8_STAGE
#undef PG8_STAGE_A
#undef PG8_GAOFF
#undef PG8_LDA
#undef PG8_LDB
#undef PG8_MMA
}

__device__ __forceinline__ unsigned pk_bf16(float lo, float hi) { return cvt_pk_bf16(lo, hi); }
__device__ __forceinline__ float frcp(float x) {
#ifdef EMU
    return 1.0f / x;
#else
    return __builtin_amdgcn_rcpf(x);
#endif
}
__device__ __forceinline__ float fsig(float x) { return frcp(1.0f + __expf(-x)); }

__device__ __forceinline__ float lane_swap1(float v) {
#ifdef EMU
    return __shfl_xor(v, 1);
#else
    return __builtin_bit_cast(float, __builtin_amdgcn_update_dpp(0, __builtin_bit_cast(int, v), 0xB1, 0xf, 0xf, false));
#endif
}
__device__ __forceinline__ f32x4 lane_swap1(f32x4 v) { const float a = v[0], b = v[1], c = v[2], d = v[3]; f32x4 r; r[0] = lane_swap1(a); r[1] = lane_swap1(b); r[2] = lane_swap1(c); r[3] = lane_swap1(d); return r; }
__device__ __forceinline__ void pair_rows(const f32x4& A, const f32x4& B, bool odd, f32x4& S1, f32x4& S2) {
    const f32x4 X = lane_swap1(A), Y = lane_swap1(B);
    S1 = odd ? Y : A; S2 = odd ? B : X;
}
struct EpiWin {
    static constexpr bool PERM = true; static constexpr int NSEG = 1;
    static __device__ __forceinline__ int seg_end(int, int nt) { return nt; }
    float* U; bf16_t* SG;
    __device__ __forceinline__ void operator()(const f32x4 (&acc)[2][2][4][2], const Unit& u, int wr, int wc, int fr_in, int fq_in) const {
        int fr = fr_in, fq = fq_in; PG8_OPAQUE(fr); PG8_OPAQUE(fq);
        const int row0 = u.pm * BM + wr * 64 + fr, col0 = u.pn * BM + wc * 32 + 8 * fq;
        if (u.pn * BM >= OFF_GA) {
#pragma unroll
            for (int ai = 0; ai < 2; ++ai)
#pragma unroll
                for (int m = 0; m < 4; ++m) { bf16_t* rowp = SG + (size_t)(row0 + ai * HALF + m * 16) * (3 * D) + (col0 - OFF_GA);
#pragma unroll
                    for (int bj = 0; bj < 2; ++bj) { const f32x4 v0 = acc[ai][bj][m][0], v1 = acc[ai][bj][m][1]; u32x4 o;
                        o[0] = pk_bf16(fsig(v0[0]), fsig(v0[1])); o[1] = pk_bf16(fsig(v0[2]), fsig(v0[3])); o[2] = pk_bf16(fsig(v1[0]), fsig(v1[1])); o[3] = pk_bf16(fsig(v1[2]), fsig(v1[3]));
                        *(u32x4*)(rowp + bj * HALF) = o; } }
        } else {
            const bool odd = fr & 1;
#pragma unroll
            for (int ai = 0; ai < 2; ++ai)
#pragma unroll
                for (int m = 0; m < 4; ++m) { float* pe = U + (size_t)((row0 + ai * HALF + m * 16) & ~1) * UW + col0 + (odd ? 4 : 0);
#pragma unroll
                    for (int bj = 0; bj < 2; ++bj) { f32x4 S1, S2; pair_rows(acc[ai][bj][m][0], acc[ai][bj][m][1], odd, S1, S2);
                        *(f32x4*)(pe + bj * HALF) = S1; *(f32x4*)(pe + UW + bj * HALF) = S2; } }
        }
    }
};
struct EpiMerge {
    static constexpr bool PERM = true; static constexpr int NSEG = 3;
    static __device__ __forceinline__ int seg_end(int seg, int nt) { return seg == 0 ? PW / BK : (seg == 1 ? (PW + RW) / BK : nt); }
    const bf16_t* SG; bf16_t* O;
    __device__ __forceinline__ void mid(f32x4 (&acc)[2][2][4][2], const Unit& u, int which, int wr, int wc, int fr_in, int fq_in) const {
        int fr = fr_in, fq = fq_in; PG8_OPAQUE(fr); PG8_OPAQUE(fq);
        const int row0 = u.pm * BM + wr * 64 + fr, col0 = u.pn * BM + wc * 32 + 8 * fq;
#pragma unroll
        for (int ai = 0; ai < 2; ++ai)
#pragma unroll
            for (int m = 0; m < 4; ++m) { const bf16_t* rowp = SG + (size_t)(row0 + ai * HALF + m * 16) * (3 * D) + which * D + col0;
#pragma unroll
                for (int bj = 0; bj < 2; ++bj) {
                    const uint4 nu = *(const uint4*)(rowp + bj * HALF), de = *(const uint4*)(rowp + D + bj * HALF);
                    const unsigned nw[4] = {nu.x, nu.y, nu.z, nu.w}, dw[4] = {de.x, de.y, de.z, de.w};
#pragma unroll
                    for (int q = 0; q < 4; ++q) {
                        const float n0 = bf2f((bf16_t)(nw[q] & 0xffffu)), n1 = bf2f((bf16_t)(nw[q] >> 16)), d0 = bf2f((bf16_t)(dw[q] & 0xffffu)), d1 = bf2f((bf16_t)(dw[q] >> 16));
                        acc[ai][bj][m][q >> 1][2 * (q & 1)] *= n0 * frcp(d0); acc[ai][bj][m][q >> 1][2 * (q & 1) + 1] *= n1 * frcp(d1); } }
                PG8_MEMFENCE; }
    }
    __device__ __forceinline__ void operator()(const f32x4 (&acc)[2][2][4][2], const Unit& u, int wr, int wc, int fr_in, int fq_in) const {
        int fr = fr_in, fq = fq_in; PG8_OPAQUE(fr); PG8_OPAQUE(fq);
        const int row0 = u.pm * BM + wr * 64 + fr, col0 = u.pn * BM + wc * 32 + 8 * fq;
#pragma unroll
        for (int ai = 0; ai < 2; ++ai)
#pragma unroll
            for (int m = 0; m < 4; ++m) { const size_t ro = (size_t)(row0 + ai * HALF + m * 16);
#pragma unroll
                for (int bj = 0; bj < 2; ++bj) {
                    const uint4 sc = *(const uint4*)(SG + ro * (3 * D) + 2 * D + col0 + bj * HALF);
                    const unsigned sw[4] = {sc.x, sc.y, sc.z, sc.w}; unsigned ow[4];
#pragma unroll
                    for (int q = 0; q < 4; ++q) { const float s0 = bf2f((bf16_t)(sw[q] & 0xffffu)), s1 = bf2f((bf16_t)(sw[q] >> 16));
                        ow[q] = pk_bf16(acc[ai][bj][m][q >> 1][2 * (q & 1)] * s0, acc[ai][bj][m][q >> 1][2 * (q & 1) + 1] * s1); }
                    *(uint4*)(O + ro * D + col0 + bj * HALF) = make_uint4(ow[0], ow[1], ow[2], ow[3]); }
                PG8_MEMFENCE; }
    }
};
struct EpiWout {
    static constexpr bool PERM = false; static constexpr int NSEG = 1;
    static __device__ __forceinline__ int seg_end(int, int nt) { return nt; }
    float* X; const float* MODL; const float* inC; const float* inX;
    __device__ __forceinline__ void operator()(const f32x4 (&acc)[2][2][4][2], const Unit& u, int wr, int wc, int fr_in, int fq_in) const {
        int fr = fr_in, fq = fq_in; PG8_OPAQUE(fr); PG8_OPAQUE(fq);
        const int row0 = u.pm * BM + wr * 64 + fr, col0 = u.pn * BM + wc * 32 + 4 * fq;
        const int mr = (u.pm < TC / BM) ? NB : (u.pm - TC / BM) / (L / BM);
        const float* g1 = MODL + (size_t)mr * 6 * D + 2 * D + col0;
        f32x4 gv[2][2];
#pragma unroll
        for (int bj = 0; bj < 2; ++bj)
#pragma unroll
            for (int n = 0; n < 2; ++n) gv[bj][n] = *(const f32x4*)(g1 + bj * HALF + n * 16);
#pragma unroll
        for (int ai = 0; ai < 2; ++ai)
#pragma unroll
            for (int m = 0; m < 4; ++m) { const int row = row0 + ai * HALF + m * 16; float* rowp = X + (size_t)row * D + col0;
                const float* srcp = inX ? ((u.pm < TC / BM) ? inC + (size_t)row * D + col0 : inX + (size_t)(row - TC) * D + col0) : rowp;
#pragma unroll
                for (int bj = 0; bj < 2; ++bj)
#pragma unroll
                    for (int n = 0; n < 2; ++n) { *(f32x4*)(rowp + bj * HALF + n * 16) = *(const f32x4*)(srcp + bj * HALF + n * 16) + gv[bj][n] * acc[ai][bj][m][n]; } }
    }
};
struct EpiSwiglu {
    static constexpr bool PERM = true; static constexpr int NSEG = 1;
    static __device__ __forceinline__ int seg_end(int, int nt) { return nt; }
    bf16_t* ACT; const float* WTP;
    __device__ __forceinline__ void operator()(const f32x4 (&acc)[2][2][4][2], const Unit& u, int wr, int wc, int fr_in, int fq_in) const {
        int fr = fr_in, fq = fq_in; PG8_OPAQUE(fr); PG8_OPAQUE(fq);
        const int row0 = u.pm * BM + wr * 64 + fr, col0 = u.pn * HALF + wc * 32 + 8 * fq;
#pragma unroll
        for (int ai = 0; ai < 2; ++ai)
#pragma unroll
            for (int m = 0; m < 4; ++m) { const size_t ro = (size_t)(row0 + ai * HALF + m * 16); const float wt = WTP[ro]; unsigned ow[4];
#pragma unroll
                for (int q = 0; q < 4; ++q) { const int n = q >> 1, j = 2 * (q & 1);
                    const float g0 = acc[ai][0][m][n][j], g1 = acc[ai][0][m][n][j + 1], u0 = acc[ai][1][m][n][j], u1 = acc[ai][1][m][n][j + 1];
                    ow[q] = pk_bf16(g0 * fsig(g0) * u0 * wt, g1 * fsig(g1) * u1 * wt); }
                *(uint4*)(ACT + ro * DE + col0) = make_uint4(ow[0], ow[1], ow[2], ow[3]); PG8_MEMFENCE; }
    }
};
struct EpiDown {
    static constexpr bool PERM = true; static constexpr int NSEG = 1;
    static __device__ __forceinline__ int seg_end(int, int nt) { return nt; }
    bf16_t* YSB; const int* SLOTOF;
    __device__ __forceinline__ void operator()(const f32x4 (&acc)[2][2][4][2], const Unit& u, int wr, int wc, int fr_in, int fq_in) const {
        int fr = fr_in, fq = fq_in; PG8_OPAQUE(fr); PG8_OPAQUE(fq);
        const int row0 = u.pm * BM + wr * 64 + fr, col0 = u.pn * BM + wc * 32 + 8 * fq;
#pragma unroll
        for (int ai = 0; ai < 2; ++ai)
#pragma unroll
            for (int m = 0; m < 4; ++m) { const int slot = SLOTOF[row0 + ai * HALF + m * 16];
                if (slot >= 0) {
#pragma unroll
                    for (int bj = 0; bj < 2; ++bj) { unsigned ow[4];
#pragma unroll
                        for (int q = 0; q < 4; ++q) ow[q] = pk_bf16(acc[ai][bj][m][q >> 1][2 * (q & 1)], acc[ai][bj][m][q >> 1][2 * (q & 1) + 1]);
                        *(uint4*)(YSB + (size_t)slot * D + col0 + bj * HALF) = make_uint4(ow[0], ow[1], ow[2], ow[3]); } }
                PG8_MEMFENCE; }
    }
};
struct MoeOrder {
    static constexpr bool GATHER = false;
    const char* A; const char* Bt; size_t tstepA, estepB, tstepB; int nN, G, c; const LAS int* toff;
    __device__ bool next(int i, Unit& u) const {
        const int Lx = i * G + c; const int total = toff[NE] * nN; if (Lx >= total) return false;
        const int rt = Lx / nN, pn = Lx % nN; int e = 0;
        for (int q = 1; q < NE; ++q) e = (rt >= toff[q]) ? q : e;
        u.pm = rt; u.pn = pn; u.a = A + (size_t)rt * tstepA; u.b = Bt + (size_t)e * estepB + (size_t)pn * tstepB; return true;
    }
};
struct MoeGatherOrder {
    static constexpr bool GATHER = true;
    const char* A; const char* Bt; size_t estepB, tstepB; int nN, G, c; const LAS int* toff; const int* slotof;
    __device__ bool next(int i, Unit& u) const {
        const int Lx = i * G + c; const int total = toff[NE] * nN; if (Lx >= total) return false;
        const int rt = Lx / nN, pn = Lx % nN; int e = 0;
        for (int q = 1; q < NE; ++q) e = (rt >= toff[q]) ? q : e;
        u.pm = rt; u.pn = pn; u.a = A; u.b = Bt + (size_t)e * estepB + (size_t)pn * tstepB; return true;
    }
    __device__ __forceinline__ unsigned src_row(int pm, int r) const { const int sl = slotof[pm * BM + r]; return (unsigned)(sl < 0 ? 0 : (sl >> 1)); }
};
}

__device__ __forceinline__ void conv_tile(const float* src, int ld_src, bf16_t* dst, int ld_dst, int kt, float* lds, const int TX_) {
    const int tid = TX_;
    float* tb = lds;
    __syncthreads();
#pragma unroll
    for (int i = 0; i < 4; ++i) {
        const int idx = tid + i * NT, kr = idx >> 4, c4 = (idx & 15) * 4;
        const float4 v = *(const float4*)(src + (size_t)(kt * 128 + kr) * ld_src + c4);
        tb[kr * 65 + c4] = v.x; tb[kr * 65 + c4 + 1] = v.y; tb[kr * 65 + c4 + 2] = v.z; tb[kr * 65 + c4 + 3] = v.w;
    }
    __syncthreads();
    const int n = tid >> 3, kq = (tid & 7) * 16;
    unsigned w[8];
#pragma unroll
    for (int j = 0; j < 8; ++j) { const unsigned lo = f2bf(tb[(kq + 2 * j) * 65 + n]), hi = f2bf(tb[(kq + 2 * j + 1) * 65 + n]); w[j] = lo | (hi << 16); }
    uint4* dp = (uint4*)(dst + (size_t)n * ld_dst + kt * 128 + kq);
    dp[0] = make_uint4(w[0], w[1], w[2], w[3]); dp[1] = make_uint4(w[4], w[5], w[6], w[7]);
}
PHASE_FN void ph_conv_win0(const Params& p, float* lds) {
    const int TX_ = ltid(p.sw);
    const float* src = p.in[IWIN]; bf16_t* dst = WSH(O_WINT);
    for (int it = blockIdx.x; it < (D / 128) * (IN_DIM / 64); it += gridDim.x) { const int kt = it % (D / 128), nt = it / (D / 128); conv_tile(src + nt * 64, IN_DIM, dst + (size_t)nt * 64 * D, D, kt, lds, TX_); }
    __syncthreads();
}
PHASE_FN void ph_conv_layer(const Params& p, int l, float* lds, bool with_win) {
    const int TX_ = ltid(p.sw);
    const int G = gridDim.x; int base = 0;
#define CONV_JOB(NTILES, ...) { const int start_ = ((int)blockIdx.x - base % G + G) % G; for (int it = start_; it < (NTILES); it += G) { __VA_ARGS__ } base += (NTILES); }
    if (with_win) {
        const float* src = p.in[IWIN] + (size_t)l * D * IN_DIM; bf16_t* dst = WSH(O_WINT) + (size_t)l * IN_DIM * D;
        CONV_JOB((D / 128) * (IN_DIM / 64), { const int kt = it % (D / 128), nt = it / (D / 128); conv_tile(src + nt * 64, IN_DIM, dst + (size_t)nt * 64 * D, D, kt, lds, TX_); })
    }
    {
        bf16_t* dst = WSH(O_WMT) + (size_t)l * D * KCAT;
        const float* s0 = p.in[IPP] + (size_t)l * PW * D; const float* s1 = p.in[IPR] + (size_t)l * RW * D; const float* s2 = p.in[IPA] + (size_t)l * AW * D;
        CONV_JOB((PW / 128) * (D / 64), { const int kt = it % (PW / 128), nt = it / (PW / 128); conv_tile(s0 + nt * 64, D, dst + (size_t)nt * 64 * KCAT, KCAT, kt, lds, TX_); })
        CONV_JOB((RW / 128) * (D / 64), { const int kt = it % (RW / 128), nt = it / (RW / 128); conv_tile(s1 + nt * 64, D, dst + (size_t)nt * 64 * KCAT + PW, KCAT, kt, lds, TX_); })
        CONV_JOB((AW / 128) * (D / 64), { const int kt = it % (AW / 128), nt = it / (AW / 128); conv_tile(s2 + nt * 64, D, dst + (size_t)nt * 64 * KCAT + PW + RW, KCAT, kt, lds, TX_); })
    }
    {
        const float* src = p.in[IWOUT] + (size_t)l * D * D; bf16_t* dst = WSH(O_WOT) + (size_t)l * D * D;
        CONV_JOB((D / 128) * (D / 64), { const int kt = it % (D / 128), nt = it / (D / 128); conv_tile(src + nt * 64, D, dst + (size_t)nt * 64 * D, D, kt, lds, TX_); })
    }
    {
        constexpr int TPE = (D / 128) * (DE / 64);
        CONV_JOB(NE * 2 * TPE, { const int e = it / (2 * TPE), rem = it % (2 * TPE), which = rem / TPE, r2 = rem % TPE, kt = r2 % (D / 128), nt = r2 / (D / 128);
            const float* src = p.in[which ? IEWU : IEWG] + ((size_t)l * NE + e) * D * DE + nt * 64;
            const int drow = (nt >> 1) * 256 + which * 128 + (nt & 1) * 64;
            conv_tile(src, DE, WSH(O_EGU) + (((size_t)l * NE + e) * 2 * DE + drow) * D, D, kt, lds, TX_); })
    }
    {
        constexpr int TPE = (DE / 128) * (D / 64);
        CONV_JOB(NE * TPE, { const int e = it / TPE, r2 = it % TPE, kt = r2 % (DE / 128), nt = r2 / (DE / 128);
            conv_tile(p.in[IEWD] + ((size_t)l * NE + e) * DE * D + nt * 64, D, WSH(O_ED) + (((size_t)l * NE + e) * D + nt * 64) * DE, DE, kt, lds, TX_); })
    }
#undef CONV_JOB
    __syncthreads();
}

PHASE_FN void ph_copy(const Params& p) {
    const int TX_ = ltid(p.sw);
    const int gt = blockIdx.x * NT + TX_, gs = gridDim.x * NT;
    float4* X4 = (float4*)WSF(O_X);
    const float4* c4 = (const float4*)p.in[ICTX]; const float4* x4 = (const float4*)p.in[IX];
    for (long i = gt; i < (long)T * D / 4; i += gs) X4[i] = (i < (long)TC * D / 4) ? c4[i] : x4[i - (long)TC * D / 4];
}
PHASE_FN void ph_rope_table(const Params& p) {
    const int TX_ = ltid(p.sw);
    const int gt = blockIdx.x * NT + TX_, gs = gridDim.x * NT;
    for (int i = gt; i < L * 64; i += gs) {
        const int t = i >> 6, j = i & 63, ax = j >> 5, f = j & 31;
        const float inv = powf(10000.0f, -(float)(2 * f) / 64.0f);
        const float ang = (ax == 0 ? (float)(t / 64) : (float)(t % 64)) * inv;
        WSF(O_ROPE)[(size_t)t * 128 + j] = cosf(ang); WSF(O_ROPE)[(size_t)t * 128 + 64 + j] = sinf(ang);
    }
}
PHASE_FN void ph_pws(const Params& p) {
    const int TX_ = ltid(p.sw);
    for (int i = blockIdx.x * NT + TX_; i < DEPTH * 4 * PGD * PGD; i += gridDim.x * NT) {
        const int d = i % PGD, g = (i / (PGD * PGD)) % 4, l = i / (4 * PGD * PGD);
        WSF(O_PWS)[i] = p.in[IPOOLW][i] * p.in[IPOOLS][l * PW + g * PGD + d];
    }
}
PHASE_FN void ph_lora_pack(const Params& p) {
    const int TX_ = ltid(p.sw);
    const float* pgu = p.in[IGUP]; const float* pdu = p.in[IDUP]; const float* pau = p.in[IAUP];
#ifndef EMU
    asm volatile("" : "+s"(pgu), "+s"(pdu), "+s"(pau));
#endif
    for (int i = blockIdx.x * NT + TX_; i < DEPTH * NW * LKS * 4 * 64; i += gridDim.x * NT) {
        const int lane = i & 63, nt = (i >> 6) & 3, ks = (i >> 8) % LKS, w = (i / (256 * LKS)) % NW, l = i / (256 * LKS * NW);
        const int ch = w * 64 + (lane & 15) * 4 + nt;
        const float* src; int k0;
        if (ks < 4) { src = pgu + (size_t)l * GL * RW; k0 = ks * 32; }
        else if (ks < 8) { src = pdu + (size_t)(l * 2 + ((ks - 4) >> 1)) * DL * RW; k0 = ((ks - 4) & 1) * 32; }
        else { src = pau + (size_t)(l * 2 + ((ks - 8) >> 1)) * IL * RW; k0 = ((ks - 8) & 1) * 32; }
        k0 += (lane >> 4) * 8;
        const float* q = src + (size_t)k0 * RW + ch;
        const float x0 = q[0], x1 = q[RW], x2 = q[2 * RW], x3 = q[3 * RW], x4 = q[4 * RW], x5 = q[5 * RW], x6 = q[6 * RW], x7 = q[7 * RW];
        const bf16_t h0 = f2bf(x0), h1 = f2bf(x1), h2 = f2bf(x2), h3 = f2bf(x3), h4 = f2bf(x4), h5 = f2bf(x5), h6 = f2bf(x6), h7 = f2bf(x7);
        uint4 hi;
        hi.x = (unsigned)h0 | ((unsigned)h1 << 16); hi.y = (unsigned)h2 | ((unsigned)h3 << 16); hi.z = (unsigned)h4 | ((unsigned)h5 << 16); hi.w = (unsigned)h6 | ((unsigned)h7 << 16);
        ((uint4*)(p.ws + O_LP + (size_t)(i >> 6) * 1024))[lane] = hi;
    }
}
PHASE_FN void ph_router_pack(const Params& p) {
    const int TX_ = ltid(p.sw);
    for (int i = blockIdx.x * NT + TX_; i < DEPTH * (4 + NE) * D; i += gridDim.x * NT) {
        const int k = i % D, q = (i / D) % (4 + NE), l = i / (D * (4 + NE));
        WSF(O_WRT)[i] = (q < 4) ? p.in[IRGW][((size_t)l * D + k) * 4 + q] : p.in[IREW][((size_t)l * D + k) * NE + (q - 4)];
    }
}
PHASE_FN void ph_mod(const Params& p, float* lds) {
    const int TX_ = ltid(p.sw);
    float* sl = lds;
    float* red = lds + (NB + 1) * D;
    const int tid = TX_, kg = tid >> 3, cq = tid & 7;
    const int nitems = DEPTH * 6 * D / 32;
    if ((int)blockIdx.x < nitems) {
        for (int i = tid; i < (NB + 1) * D; i += NT) sl[i] = siluf_(i < NB * D ? p.in[IC][i] : p.in[ICCTX][i - NB * D]);
        __syncthreads();
        for (int it = blockIdx.x; it < nitems; it += gridDim.x) {
            const int l = it / (6 * D / 32), n0 = (it % (6 * D / 32)) * 32;
            float acc[NB + 1][4];
#pragma unroll
            for (int j = 0; j <= NB; ++j)
#pragma unroll
                for (int q = 0; q < 4; ++q) acc[j][q] = 0.f;
            const float* w = p.in[IMODW] + (size_t)l * D * 6 * D + n0 + cq * 4;
#pragma unroll 1
            for (int k0 = kg; k0 < D; k0 += 64 * 8) {
                float4 wv[8];
#pragma unroll
                for (int u = 0; u < 8; ++u) wv[u] = *(const float4*)(w + (size_t)(k0 + 64 * u) * 6 * D);
#pragma unroll
                for (int u = 0; u < 8; ++u)
#pragma unroll
                    for (int j = 0; j <= NB; ++j) { const float sv = sl[j * D + k0 + 64 * u]; acc[j][0] += sv * wv[u].x; acc[j][1] += sv * wv[u].y; acc[j][2] += sv * wv[u].z; acc[j][3] += sv * wv[u].w; }
            }
            __syncthreads();
#pragma unroll
            for (int j = 0; j <= NB; ++j)
#pragma unroll
                for (int q = 0; q < 4; ++q) red[(kg * (NB + 1) + j) * 32 + cq * 4 + q] = acc[j][q];
            __syncthreads();
            if (tid < (NB + 1) * 32) {
                const int j = tid / 32, cc = tid % 32;
                float sum = 0.f;
                for (int g = 0; g < 64; ++g) sum += red[(g * (NB + 1) + j) * 32 + cc];
                WSF(O_MOD)[((size_t)l * (NB + 1) + j) * 6 * D + n0 + cc] = sum + p.in[IMODB][l * 6 * D + n0 + cc];
            }
        }
    }
    __syncthreads();
}
PHASE_FN void ph_norm1(const Params& p, int l, int mode, bool dry = false) {
    const int TX_ = ltid(p.sw);
    const int wave = TX_ >> 6, lane = TX_ & 63;
    const int r_begin = (mode == 2) ? TC : 0;
    const int lp = (mode == 2) ? DEPTH - 1 : l - 1;
    for (int r = r_begin + blockIdx.x * NW + wave; r < T; r += gridDim.x * NW) {
        int t, len, mr; seq_info(r, t, len, mr);
        float* xr = WSF(O_X) + (size_t)r * D;
        const float* xsrc = (mode == 0 && l == 0) ? ((r < TC) ? p.in[ICTX] + (size_t)r * D : p.in[IX] + (size_t)(r - TC) * D) : xr;
        const bool comb = (lp >= 0) && (lp != DEPTH - 1 || r >= TC);
        float4 v[D / 256];
        float ss = 0.f;
#pragma unroll
        for (int i = 0; i < D / 256; ++i) {
            const int c = (i * 64 + lane) * 4;
            float4 x = *(const float4*)(xsrc + c);
            if (comb) {
                const float4 g2 = *(const float4*)(WSF(O_MOD) + ((size_t)lp * (NB + 1) + mr) * 6 * D + 5 * D + c);
                const uint2 y0 = *(const uint2*)(WSH(O_YSB) + (size_t)(2 * r) * D + c), y1 = *(const uint2*)(WSH(O_YSB) + (size_t)(2 * r + 1) * D + c);
                x.x += g2.x * (bf2f((bf16_t)(y0.x & 0xffffu)) + bf2f((bf16_t)(y1.x & 0xffffu))); x.y += g2.y * (bf2f((bf16_t)(y0.x >> 16)) + bf2f((bf16_t)(y1.x >> 16)));
                x.z += g2.z * (bf2f((bf16_t)(y0.y & 0xffffu)) + bf2f((bf16_t)(y1.y & 0xffffu))); x.w += g2.w * (bf2f((bf16_t)(y0.y >> 16)) + bf2f((bf16_t)(y1.y >> 16)));
                if (!dry) *(float4*)(xr + c) = x;
            }
            v[i] = x; ss += x.x * x.x + x.y * x.y + x.z * x.z + x.w * x.w;
        }
        ss = wave_sum(ss, lane);
        const float rs = rsqrtf(ss / (float)D + NORM_EPS);
#pragma unroll
        for (int i = 0; i < D / 256; ++i) {
            const int c = (i * 64 + lane) * 4;
            if (mode == 2) {
                const float4 g = *(const float4*)(p.in[IFG] + c);
                *(float4*)(p.out + (size_t)(r - TC) * D + c) = make_float4(v[i].x * rs * g.x, v[i].y * rs * g.y, v[i].z * rs * g.z, v[i].w * rs * g.w);
            } else {
                const float* md = WSF(O_MOD) + ((size_t)l * (NB + 1) + mr) * 6 * D;
                const float4 g = *(const float4*)(p.in[INORM1] + l * D + c), sh = *(const float4*)(md + c), sc = *(const float4*)(md + D + c);
                const float h0 = (v[i].x * rs * g.x) * (1.0f + sc.x) + sh.x, h1 = (v[i].y * rs * g.y) * (1.0f + sc.y) + sh.y;
                const float h2 = (v[i].z * rs * g.z) * (1.0f + sc.z) + sh.z, h3 = (v[i].w * rs * g.w) * (1.0f + sc.w) + sh.w;
                uint2 o; o.x = (unsigned)f2bf(h0) | ((unsigned)f2bf(h1) << 16); o.y = (unsigned)f2bf(h2) | ((unsigned)f2bf(h3) << 16);
                *(uint2*)(WSH(O_HB) + (size_t)r * D + c) = o;
            }
        }
    }
}

constexpr int GT_M = NT / 4;
__device__ __forceinline__ void gemm_tile(const float* A, int lda, const int* aidx, int ashift, int mvalid, int m0, const float* B, int ldb, int n0, int K, float (&acc)[4][4], float* lds, const int TX_) {
    float* As = lds;
    float* Bs = lds + 16 * (GT_M + 4);
    const int tid = TX_, tx = tid & 15, ty = tid >> 4;
    const int ar = tid >> 2, ak = (tid & 3) * 4;
    const int bk = (tid & 255) >> 4, bn = (tid & 15) * 4;
    const bool avalid = (m0 + ar) < mvalid;
    long arow = 0;
    if (avalid) arow = aidx ? (long)(aidx[m0 + ar] >> ashift) : (long)(m0 + ar);
    const float* ap = A + arow * lda + ak;
    const float* bp = B + (size_t)bk * ldb + n0 + bn;
    for (int k0 = 0; k0 < K; k0 += 16) {
        float a0 = 0.f, a1 = 0.f, a2 = 0.f, a3 = 0.f;
        if (avalid) { a0 = ap[k0]; a1 = ap[k0 + 1]; a2 = ap[k0 + 2]; a3 = ap[k0 + 3]; }
        float b0 = 0.f, b1 = 0.f, b2 = 0.f, b3 = 0.f;
        if (tid < 256) { const float* bq = bp + (size_t)k0 * ldb; b0 = bq[0]; b1 = bq[1]; b2 = bq[2]; b3 = bq[3]; }
        __syncthreads();
        As[ak * (GT_M + 4) + ar] = a0; As[(ak + 1) * (GT_M + 4) + ar] = a1; As[(ak + 2) * (GT_M + 4) + ar] = a2; As[(ak + 3) * (GT_M + 4) + ar] = a3;
        if (tid < 256) { Bs[bk * 68 + bn] = b0; Bs[bk * 68 + bn + 1] = b1; Bs[bk * 68 + bn + 2] = b2; Bs[bk * 68 + bn + 3] = b3; }
        __syncthreads();
#pragma unroll
        for (int k = 0; k < 16; ++k) {
            float a[4], b[4];
#pragma unroll
            for (int i = 0; i < 4; ++i) { a[i] = As[k * (GT_M + 4) + 4 * ty + i]; b[i] = Bs[k * 68 + 4 * tx + i]; }
#pragma unroll
            for (int i = 0; i < 4; ++i)
#pragma unroll
                for (int j = 0; j < 4; ++j) acc[i][j] += a[i] * b[j];
        }
    }
    __syncthreads();
}
#define ZERO_ACC(a) { _Pragma("unroll") for (int i_ = 0; i_ < 4; ++i_) _Pragma("unroll") for (int j_ = 0; j_ < 4; ++j_) a[i_][j_] = 0.f; }

PHASE_FN void ph_fold(const Params& p, int l, float* lds) {
    const int TX_ = ltid(p.sw);
    const int tx = TX_ & 15, ty = TX_ >> 4;
    static_assert(PGD == GT_M, "fold tile");
    for (int it = blockIdx.x; it < 4 * (D / 64); it += gridDim.x) {
        const int g = it / (D / 64), n0 = (it % (D / 64)) * 64;
        float acc[4][4]; ZERO_ACC(acc);
        gemm_tile(WSF(O_PWS) + ((size_t)l * 4 + g) * PGD * PGD, PGD, nullptr, 0, PGD, 0, p.in[IPP] + ((size_t)l * PW + g * PGD) * D, D, n0, PGD, acc, lds, TX_);
#pragma unroll
        for (int i = 0; i < 4; ++i)
#pragma unroll
            for (int j = 0; j < 4; ++j) WSH(O_WMT)[(size_t)l * D * KCAT + (size_t)(n0 + 4 * tx + j) * KCAT + g * PGD + 4 * ty + i] = f2bf(acc[i][j]);
    }
}
PHASE_FN void ph_win(const Params& p, int l, LAS unsigned char* lds) {
    static_assert((OFF_RW + RW) % 256 == 0 && (OFF_RW + RC) % 256 == 0 && OFF_K % 256 == 0 && KVW == 256, "column tiles of the context-only subset");
    pg8::WinOrder S; S.init(WSH(O_HB), WSH(O_WINT) + (size_t)l * IN_DIM * D, D, D, gridDim.x, blockIdx.x, l != DEPTH - 1);
    pg8::EpiWin E{WSF(O_U), WSH(O_SG)};
    pg8::gemm_phase<pg8::EpiWin, pg8::WinOrder>(lds, D, D, D, S, E, ltid(p.sw));
}

__device__ __forceinline__ float dpp_sum16(float v);
#ifdef EMU
__device__ __forceinline__ float wave_total63(float v) { for (int m = 32; m >= 1; m >>= 1) v += __shfl_xor(v, m); return v; }
__device__ __forceinline__ float wave_bcast63(float v) { return __shfl(v, 63); }
#else
template <int CTRL, int RMASK> __device__ __forceinline__ float dpp_mov_rm(float v) { return __builtin_bit_cast(float, __builtin_amdgcn_update_dpp(0, __builtin_bit_cast(int, v), CTRL, RMASK, 0xf, false)); }
__device__ __forceinline__ float wave_total63(float v) {
    v = dpp_sum16(v); v += dpp_mov_rm<0x142, 0xa>(v); v += dpp_mov_rm<0x143, 0xc>(v); return v;
}
__device__ __forceinline__ float wave_bcast63(float v) { return __builtin_bit_cast(float, __builtin_amdgcn_readlane(__builtin_bit_cast(int, v), 63)); }
#endif
#ifdef EMU
struct BufRsrc { const char* p; };
__device__ __forceinline__ BufRsrc make_rsrc(const void* p, size_t) { return BufRsrc{(const char*)p}; }
__device__ __forceinline__ float buf_load4(BufRsrc r, int voff, int soff) { return *(const float*)(r.p + voff + soff); }
__device__ __forceinline__ pg8::bf16x8 buf_load16(BufRsrc r, int voff, int soff) { return *(const pg8::bf16x8*)(r.p + voff + soff); }
#else
typedef __amdgpu_buffer_rsrc_t BufRsrc;
__device__ __forceinline__ BufRsrc make_rsrc(const void* p, size_t bytes) { return __builtin_amdgcn_make_buffer_rsrc((void*)p, 0, (int)bytes, 0x00020000); }
__device__ __forceinline__ float buf_load4(BufRsrc r, int voff, int soff) { return __builtin_bit_cast(float, __builtin_amdgcn_raw_buffer_load_b32(r, voff, soff, 0)); }
__device__ __forceinline__ pg8::bf16x8 buf_load16(BufRsrc r, int voff, int soff) { return __builtin_bit_cast(pg8::bf16x8, __builtin_amdgcn_raw_buffer_load_b128(r, voff, soff, 0)); }
#endif
constexpr int PR = 9;
constexpr int LAS_A = 264;
static_assert(DL == 64 && IL == 64 && GL == 128 && RC == 3 * RW + 256, "LoRA geometry");
static_assert(RW == NT, "prep geometry");
PHASE_FN void ph_prep(const Params& p, int l, float* lds) {
    const int TX_ = ltid(p.sw);
    float* us = lds;
    bf16_t* Ahi = (bf16_t*)(us + PR * RC);
    bf16_t* Alo = Ahi + 16 * LAS_A;
    const int tid0 = TX_;
    for (int i = tid0; i < 16 * LAS_A; i += NT) { Ahi[i] = 0; Alo[i] = 0; }
    const float* U = WSF(O_U);
    const float* mu = p.in[IMU] + l * RC;
    for (int grp = blockIdx.x; grp < (T + PR - 1) / PR; grp += gridDim.x) {
        const int r0 = grp * PR, nr = min(PR, T - r0);
        int tid = tid0; PG8_OPAQUE(tid);
        const int lane = tid & 63;
        __syncthreads();
#if PROBE_MASK & 0x10000000
        for (int rep1_ = 0; rep1_ < 2; ++rep1_) {
        PG8_OPAQUE(rep1_);
#endif
        {
            const int ch = tid, gi = ch / PGD, hw = 1 << gi;
            float xv[PR + 16];
#pragma unroll
            for (int q = 0; q < PR + 16; ++q) { const int row = r0 - 8 + q; xv[q] = (row >= 0 && row < T) ? U[(size_t)row * UW + OFF_XA + ch] : 0.f; }
#pragma unroll
            for (int rr = 0; rr < PR; ++rr) if (rr < nr) {
                const int r = r0 + rr; int t, len, mr; seq_info(r, t, len, mr);
                float sacc = 0.f;
#pragma unroll
                for (int dq = -8; dq < 8; ++dq) { const int tt = t + dq; const bool ok = dq >= -hw && dq < hw && tt >= 0 && tt < len; sacc += ok ? xv[8 + rr + dq] : 0.f; }
                const int lo = max(t - hw, 0), hi = min(t + hw, len);
                WSH(O_OCAT)[(size_t)r * KCAT + ch] = f2bf(sacc * pg8::frcp((float)(hi - lo)) - xv[8 + rr]);
            }
        }
        WAVE_FENCE();
        for (int q = tid; q < PR * (QH + KVH) * 8; q += NT) {
            const int fo = q & 3, ax = (q >> 2) & 1, hh = (q >> 3) % (QH + KVH), rr = q / (8 * (QH + KVH)), e1 = ax * 64 + fo * 8;
            const int soff = (hh < QH) ? (OFF_Q + hh * 128) : (OFF_K + (hh - QH) * 128);
            if (rr < nr) {
                const int r = r0 + rr; int t, len, mr; seq_info(r, t, len, mr); const bool lat = r >= TC;
                const float* src = U + (size_t)r * UW + soff + e1;
                const pg8::f32x4 xa0 = *(const pg8::f32x4*)src, xa1 = *(const pg8::f32x4*)(src + 4), xb0 = *(const pg8::f32x4*)(src + 32), xb1 = *(const pg8::f32x4*)(src + 36);
                const float* rt = WSF(O_ROPE) + (size_t)(lat ? t : 0) * 128 + ax * 32 + fo * 8;
                const pg8::f32x4 c0 = *(const pg8::f32x4*)rt, c1 = *(const pg8::f32x4*)(rt + 4), s0 = *(const pg8::f32x4*)(rt + 64), s1 = *(const pg8::f32x4*)(rt + 68);
                pg8::f32x4 ya0 = xa0, ya1 = xa1, yb0 = xb0, yb1 = xb1;
                if (lat) { ya0 = xa0 * c0 - xb0 * s0; ya1 = xa1 * c1 - xb1 * s1; yb0 = xa0 * s0 + xb0 * c0; yb1 = xa1 * s1 + xb1 * c1; }
#define PK8(lo_, hi_) pg8::u32x4{pg8::pk_bf16((lo_)[0], (lo_)[1]), pg8::pk_bf16((lo_)[2], (lo_)[3]), pg8::pk_bf16((hi_)[0], (hi_)[1]), pg8::pk_bf16((hi_)[2], (hi_)[3])}
                if (hh < QH) {
                    bf16_t* qu = WSH(O_QB) + (size_t)r * AW + hh * 128 + e1; *(pg8::u32x4*)qu = PK8(xa0, xa1); *(pg8::u32x4*)(qu + 32) = PK8(xb0, xb1);
                    if (lat) { bf16_t* qr = WSH(O_QRB) + (size_t)(r - TC) * AW + hh * 128 + e1; *(pg8::u32x4*)qr = PK8(ya0, ya1); *(pg8::u32x4*)(qr + 32) = PK8(yb0, yb1); }
                } else {
                    bf16_t* kd = WSH(O_KB) + (size_t)r * KVW + (hh - QH) * 128 + e1; *(pg8::u32x4*)kd = PK8(ya0, ya1); *(pg8::u32x4*)(kd + 32) = PK8(yb0, yb1);
                }
#undef PK8
            }
        }
        WAVE_FENCE();
#pragma unroll 2
        for (int i = tid; i < nr * (KVW / 4); i += NT) {
            const int rr = i / (KVW / 4), c4 = (i % (KVW / 4)) * 4, r = r0 + rr;
            const float4 v = *(const float4*)(U + (size_t)r * UW + OFF_V + c4);
            uint2 o; o.x = pg8::pk_bf16(v.x, v.y); o.y = pg8::pk_bf16(v.z, v.w);
            *(uint2*)(WSH(O_VB) + (size_t)r * KVW + c4) = o;
        }
        WAVE_FENCE();
        if (tid < RC / 4) {
            const int c4 = tid * 4;
            float4 uv[PR + 2];
#pragma unroll
            for (int q = 0; q < PR + 2; ++q) { const int row = r0 - 1 + q; uv[q] = (row >= 0 && row < T) ? *(const float4*)(U + (size_t)row * UW + OFF_RW + c4) : make_float4(0.f, 0.f, 0.f, 0.f); }
            const float4 m4 = *(const float4*)(mu + c4);
#pragma unroll
            for (int rr = 0; rr < PR; ++rr) if (rr < nr) {
                const int r = r0 + rr; int t, len, mr; seq_info(r, t, len, mr);
                const float4 u0 = uv[rr + 1];
                const float4 up = (t > 0) ? uv[rr] : make_float4(0.f, 0.f, 0.f, 0.f), un = (t < len - 1) ? uv[rr + 2] : make_float4(0.f, 0.f, 0.f, 0.f);
                float* d = us + rr * RC + c4;
                d[0] = u0.x + m4.x * (0.5f * (up.x + un.x) - u0.x); d[1] = u0.y + m4.y * (0.5f * (up.y + un.y) - u0.y);
                d[2] = u0.z + m4.z * (0.5f * (up.z + un.z) - u0.z); d[3] = u0.w + m4.w * (0.5f * (up.w + un.w) - u0.w);
            }
        }
#if PROBE_MASK & 0x10000000
        }
#endif
        __syncthreads();
        for (int i = tid; i < PR * 256; i += NT) {
            const int rr = i >> 8, j = i & 255;
            const float v = (rr < nr) ? us[rr * RC + 3 * RW + j] : 0.f;
            const float tv = (j < DL) ? 1.0f - 2.0f * pg8::frcp(1.0f + __expf(2.0f * v)) : ((j < DL + IL) ? v : pg8::fsig(v));
            const bf16_t h = f2bf(tv);
            const int ar = 4 * (rr / 3) + rr % 3;
            Ahi[ar * LAS_A + j] = h; Alo[ar * LAS_A + j] = f2bf(tv - bf2f(h));
        }
        __syncthreads();
#ifdef EMU
        const int hd = tid >> 6;
#else
        const int hd = p.sw;
#endif
        const int mrow = lane & 15, kg = lane >> 4;
        pg8::f32x4 aG[4], aW0[4], aW1[4], aA0[4], aA1[4];
#pragma unroll
        for (int nt = 0; nt < 4; ++nt) {
            const int chn = hd * 64 + 4 * mrow + nt;
            const float w00 = p.in[IDW0][(l * 2 + 0) * RW + chn], w01 = p.in[IDW0][(l * 2 + 1) * RW + chn], a00 = p.in[IA0][(l * 2 + 0) * RW + chn], a01 = p.in[IA0][(l * 2 + 1) * RW + chn];
            aG[nt] = pg8::f32x4{0.f, 0.f, 0.f, 0.f}; aW0[nt] = pg8::f32x4{w00, w00, w00, w00}; aW1[nt] = pg8::f32x4{w01, w01, w01, w01};
            aA0[nt] = pg8::f32x4{a00, a00, a00, a00}; aA1[nt] = pg8::f32x4{a01, a01, a01, a01};
        }
        {
            const BufRsrc rlp = make_rsrc(p.ws + O_LP + (size_t)(l * NW + hd) * LKS * 4 * 1024, (size_t)LKS * 4 * 1024);
            const int vo = lane * 16;
            const bf16_t* arow_h = Ahi + mrow * LAS_A + kg * 8; const bf16_t* arow_l = Alo + mrow * LAS_A + kg * 8;
            pg8::bf16x8 bh[2][4];
#pragma unroll
            for (int nt = 0; nt < 4; ++nt) bh[0][nt] = buf_load16(rlp, vo, nt * 1024);
#pragma unroll
            for (int ks = 0; ks < LKS; ++ks) {
                const int cur = ks & 1, nxt = cur ^ 1;
                if (ks + 1 < LKS) {
#pragma unroll
                    for (int nt = 0; nt < 4; ++nt) bh[nxt][nt] = buf_load16(rlp, vo, ((ks + 1) * 4 + nt) * 1024);
                }
                const int kb = (ks < 4) ? 128 + 32 * ks : ((ks < 8) ? 32 * ((ks - 4) & 1) : 64 + 32 * ((ks - 8) & 1));
                const pg8::bf16x8 ah = *(const pg8::bf16x8*)(arow_h + kb), al = *(const pg8::bf16x8*)(arow_l + kb);
#pragma unroll
                for (int nt = 0; nt < 4; ++nt) {
                    pg8::f32x4& acc = (ks < 4) ? aG[nt] : ((ks < 6) ? aW0[nt] : ((ks < 8) ? aW1[nt] : ((ks < 10) ? aA0[nt] : aA1[nt])));
                    acc = __builtin_amdgcn_mfma_f32_16x16x32_bf16(ah, bh[cur][nt], acc, 0, 0, 0);
                    acc = __builtin_amdgcn_mfma_f32_16x16x32_bf16(al, bh[cur][nt], acc, 0, 0, 0);
                }
                WAVE_FENCE();
            }
        }
        float ssq[3] = {0.f, 0.f, 0.f}, bsm[3] = {0.f, 0.f, 0.f};
#pragma unroll
        for (int nt = 0; nt < 4; ++nt) {
            const int chn = hd * 64 + 4 * mrow + nt;
            const float kkc = p.in[IKK][l * RW + chn], kac = p.in[IKA][l * RW + chn], rkc = p.in[IRK][l * RW + chn];
#pragma unroll
            for (int i = 0; i < 3; ++i) {
                const int rr = kg * 3 + i;
                const float rv = us[rr * RC + chn], kv = us[rr * RC + RW + chn];
                aW0[nt][i] = __expf(-0.6065306597f * pg8::frcp(1.0f + __expf(-aW0[nt][i]))); aW1[nt][i] = __expf(-0.6065306597f * pg8::frcp(1.0f + __expf(-aW1[nt][i])));
                const float a0 = pg8::fsig(aA0[nt][i]), a1 = pg8::fsig(aA1[nt][i]);
                aA0[nt][i] = a0; aA1[nt][i] = a1;
                const float key0 = kv * (1.0f + (a0 - 1.0f) * kac), key1 = kv * (1.0f + (a1 - 1.0f) * kac);
                const float kkr = kv * kkc;
                ssq[i] += kkr * kkr; bsm[i] += rv * (key0 + key1) * rkc;
            }
        }
#pragma unroll
        for (int i = 0; i < 3; ++i) { ssq[i] = dpp_sum16(ssq[i]); bsm[i] = dpp_sum16(bsm[i]); }
        const int ch4 = hd * 64 + 4 * mrow;
        const pg8::f32x4 kkc4 = *(const pg8::f32x4*)(p.in[IKK] + l * RW + ch4), kac4 = *(const pg8::f32x4*)(p.in[IKA] + l * RW + ch4);
#pragma unroll
        for (int i = 0; i < 3; ++i) {
            const int rr = kg * 3 + i;
            if (kg < 3 && rr < nr) {
                const int r = r0 + rr;
                const float inv = pg8::frcp(fmaxf(sqrtf(ssq[i]), 1e-12f));
                const pg8::f32x4 rv = *(const pg8::f32x4*)(us + rr * RC + ch4), kv = *(const pg8::f32x4*)(us + rr * RC + RW + ch4), vv = *(const pg8::f32x4*)(us + rr * RC + 2 * RW + ch4);
                pg8::f32x4 w0, w1, a0, a1, gg;
#pragma unroll
                for (int nt = 0; nt < 4; ++nt) { w0[nt] = aW0[nt][i]; w1[nt] = aW1[nt][i]; a0[nt] = aA0[nt][i]; a1[nt] = aA1[nt][i]; gg[nt] = aG[nt][i]; }
                const pg8::f32x4 key0 = kv * (1.0f + (a0 - 1.0f) * kac4), key1 = kv * (1.0f + (a1 - 1.0f) * kac4), kn = kv * kkc4 * inv;
                pg8::u32x2 rb, vb; rb[0] = pg8::pk_bf16(rv[0], rv[1]); rb[1] = pg8::pk_bf16(rv[2], rv[3]); vb[0] = pg8::pk_bf16(vv[0], vv[1]); vb[1] = pg8::pk_bf16(vv[2], vv[3]);
                unsigned char* pk0 = p.ws + O_PACK + (((size_t)0 * T + r) * RH + hd) * REC + 16 * mrow;
                unsigned char* pk1 = p.ws + O_PACK + (((size_t)1 * T + r) * RH + hd) * REC + 16 * mrow;
                *(pg8::f32x4*)pk0 = w0; *(pg8::f32x4*)(pk0 + 256) = key0; *(pg8::f32x4*)(pk0 + 512) = kn * a0; *(pg8::f32x4*)(pk0 + 768) = kn;
                *(pg8::u32x2*)(pk0 + 1024 - 8 * mrow) = rb; *(pg8::u32x2*)(pk0 + 1152 - 8 * mrow) = vb;
                *(pg8::f32x4*)pk1 = w1; *(pg8::f32x4*)(pk1 + 256) = key1; *(pg8::f32x4*)(pk1 + 512) = kn * a1; *(pg8::f32x4*)(pk1 + 768) = kn;
                *(pg8::u32x2*)(pk1 + 1024 - 8 * mrow) = rb; *(pg8::u32x2*)(pk1 + 1152 - 8 * mrow) = vb;
                *(pg8::f32x4*)(WSF(O_V) + (size_t)r * RW + ch4) = vv;
                *(pg8::f32x4*)(WSF(O_G) + (size_t)r * RW + ch4) = gg;
                if (mrow == 0) WSF(O_BON)[(size_t)r * RH + hd] = 0.5f * bsm[i];
            }
            WAVE_FENCE();
        }
    }
    __syncthreads();
}

constexpr int SCAN_RING = 16, SCAN_SLOT = REC;
constexpr int SH_ROUNDS = 5;
static_assert(SH_ROUNDS * 16 * SCAN_SLOT + 64 <= LDS_BYTES - 16 && (C % 16) == 0 && ((C + L) % 16) == 0, "shared scan ring");
static_assert((C + L) % SCAN_RING == 0 && C % SCAN_RING == 0 && SCAN_RING == 16, "scan ring depth");
#ifdef EMU
__device__ __forceinline__ float dpp_sum16(float v) { v += __shfl_xor(v, 1); v += __shfl_xor(v, 2); v += __shfl_xor(v, 4); v += __shfl_xor(v, 8); return v; }
static thread_local unsigned char* emu_m0[16];
__device__ __forceinline__ void scan_set_m0(unsigned char* slot) { emu_m0[threadIdx.x >> 6] = slot; }
__device__ __forceinline__ void scan_dma2(int q, BufRsrc rs, int voff, int voffb, int soff_adj) {
    __builtin_memcpy(emu_m0[threadIdx.x >> 6] + q * 1280 + voff, rs.p + soff_adj + q * 1280 + voff, 16);
    __builtin_memcpy(emu_m0[threadIdx.x >> 6] + q * 1280 + 1024 + voffb, rs.p + soff_adj + q * 1280 + 1024 + voffb, 4);
}
__device__ __forceinline__ void scan_dma2_settled(BufRsrc rs, int voff, int voffb, int soff_adj) { scan_dma2(0, rs, voff, voffb, soff_adj); }
#define SCAN_WAIT(n) emu::wave_sync()
#define SH_RELAX() emu::yield()
#define SH_FENCE() ((void)0)
#define SCAN_SGPR_SETTLE(rs_, so_) ((void)0)
__device__ __forceinline__ float row_push(float keep, float v, int kq) { const float up = __shfl(keep, (int)(threadIdx.x & 63) - 1); return kq ? up : v; }
__device__ __forceinline__ void scan_store(float* q, float v) { *q = v; }
#else
template <int CTRL> __device__ __forceinline__ float dpp_mov(float v) { return __builtin_bit_cast(float, __builtin_amdgcn_update_dpp(0, __builtin_bit_cast(int, v), CTRL, 0xf, 0xf, false)); }
__device__ __forceinline__ float dpp_sum16(float v) {
    v += dpp_mov<0xB1>(v); v += dpp_mov<0x4E>(v); v += dpp_mov<0x141>(v); v += dpp_mov<0x140>(v); return v;
}
__device__ __forceinline__ void scan_set_m0(LAS unsigned char* slot) { const unsigned dst = (unsigned)(uintptr_t)slot; asm volatile("s_mov_b32 m0, %0\n\ts_nop 0" :: "s"(dst) : "memory", "m0"); }
__device__ __forceinline__ void scan_dma2_settled(BufRsrc rs, int voff, int voffb, int soff_adj) {
    asm volatile("s_nop 4\n\tbuffer_load_dwordx4 %0, %2, %3 offen lds\n\tbuffer_load_dword %1, %2, %3 offen offset:1024 lds" :: "v"(voff), "v"(voffb), "s"(rs), "s"(soff_adj) : "memory");
}
__device__ __forceinline__ void scan_dma2(int q, BufRsrc rs, int voff, int voffb, int soff_adj) {
    if (q == 0) asm volatile("buffer_load_dwordx4 %0, %2, %3 offen lds\n\tbuffer_load_dword %1, %2, %3 offen offset:1024 lds" :: "v"(voff), "v"(voffb), "s"(rs), "s"(soff_adj) : "memory");
    else if (q == 1) asm volatile("buffer_load_dwordx4 %0, %2, %3 offen offset:1280 lds\n\tbuffer_load_dword %1, %2, %3 offen offset:2304 lds" :: "v"(voff), "v"(voffb), "s"(rs), "s"(soff_adj) : "memory");
    else asm volatile("buffer_load_dwordx4 %0, %2, %3 offen offset:2560 lds\n\tbuffer_load_dword %1, %2, %3 offen offset:3584 lds" :: "v"(voff), "v"(voffb), "s"(rs), "s"(soff_adj) : "memory");
}
#define SCAN_WAIT(n) asm volatile("s_waitcnt vmcnt(" #n ")" ::: "memory")
#define SH_RELAX() __builtin_amdgcn_s_sleep(1)
#define SH_FENCE() asm volatile("" ::: "memory")
#define SCAN_SGPR_SETTLE(rs_, so_) asm volatile("s_nop 4" :: "s"(rs_), "s"(so_) : "memory")
__device__ __forceinline__ float row_push(float keep, float v, int) {
    return __builtin_bit_cast(float, __builtin_amdgcn_update_dpp(__builtin_bit_cast(int, v), __builtin_bit_cast(int, keep), 0x111, 0xf, 0xf, false));
}
__device__ __forceinline__ void scan_store(float* q, float v) { asm volatile("global_store_dword %0, %1, off" :: "v"(q), "v"(v) : "memory"); }
#endif
__device__ __forceinline__ int scan_row(int s, int d, int b) {
    const int in_ctx = s < C;
    const int len = in_ctx ? C : L, base = in_ctx ? b * C : TC + b * L, t = in_ctx ? s : s - C;
    return base + (d == 0 ? t : len - 1 - t);
}
struct ScanOps { pg8::f32x4 w, k, b, kk; pg8::u32x2 rq; bf16_t vq; };
__device__ __forceinline__ pg8::f32x4 bf4_to_f32(pg8::u32x2 q) {
    pg8::f32x4 o; o[0] = __builtin_bit_cast(float, q[0] << 16); o[1] = __builtin_bit_cast(float, q[0] & 0xffff0000u); o[2] = __builtin_bit_cast(float, q[1] << 16); o[3] = __builtin_bit_cast(float, q[1] & 0xffff0000u); return o;
}
__device__ __forceinline__ ScanOps scan_read(const LAS unsigned char* slot, int kq, int vrow) {
    ScanOps o;
    o.w = *(const LAS pg8::f32x4*)(slot + kq * 16); o.k = *(const LAS pg8::f32x4*)(slot + 256 + kq * 16); o.b = *(const LAS pg8::f32x4*)(slot + 512 + kq * 16); o.kk = *(const LAS pg8::f32x4*)(slot + 768 + kq * 16);
    o.rq = *(const LAS pg8::u32x2*)(slot + 1024 + kq * 8);
    o.vq = *(const LAS bf16_t*)(slot + 1152 + vrow * 2); return o;
}
struct ConvTile { const float* src; bf16_t* dst; int ld_src, ld_dst; };
__device__ __forceinline__ int conv_total(int l) {
    return (KCAT / 64) * (D / 64) + (D / 64) * (D / 64) + NE * 2 * (D / 64) * (DE / 64) + NE * (DE / 64) * (D / 64) + ((l + 1 < DEPTH) ? (D / 64) * (IN_DIM / 64) : 0);
}
__device__ __forceinline__ ConvTile conv_tile_of(const Params& p, int l, int it) {
    ConvTile c;
    const float* ppp = p.in[IPP]; const float* ppr = p.in[IPR]; const float* ppa = p.in[IPA]; const float* pwg = p.in[IEWG]; const float* pwu = p.in[IEWU];
#ifndef EMU
    asm volatile("" : "+s"(ppp), "+s"(ppr), "+s"(ppa), "+s"(pwg), "+s"(pwu));
#endif
    constexpr int N0 = (PW / 64) * (D / 64), N1 = N0 + (RW / 64) * (D / 64), N2 = N1 + (AW / 64) * (D / 64), N3 = N2 + (D / 64) * (D / 64);
    constexpr int TPE1 = (D / 64) * (DE / 64), N4 = N3 + NE * 2 * TPE1, TPE2 = (DE / 64) * (D / 64), N5 = N4 + NE * TPE2;
    if (it < N2) {
        const int j = it < N0 ? it : (it < N1 ? it - N0 : it - N1);
        const int nk = it < N0 ? PW / 64 : (it < N1 ? RW / 64 : AW / 64), koff = it < N0 ? 0 : (it < N1 ? PW : PW + RW);
        const float* sb = it < N0 ? ppp + (size_t)l * PW * D : (it < N1 ? ppr + (size_t)l * RW * D : ppa + (size_t)l * AW * D);
        const int kt = j % nk, nt = j / nk;
        c.src = sb + (size_t)kt * 64 * D + nt * 64; c.ld_src = D; c.dst = WSH(O_WMT) + (size_t)l * D * KCAT + (size_t)nt * 64 * KCAT + koff + kt * 64; c.ld_dst = KCAT;
    } else if (it < N3) {
        const int j = it - N2, kt = j % (D / 64), nt = j / (D / 64);
        c.src = p.in[IWOUT] + (size_t)l * D * D + (size_t)kt * 64 * D + nt * 64; c.ld_src = D; c.dst = WSH(O_WOT) + (size_t)l * D * D + (size_t)nt * 64 * D + kt * 64; c.ld_dst = D;
    } else if (it < N4) {
        const int j = it - N3, e = j / (2 * TPE1), rem = j % (2 * TPE1), which = rem / TPE1, r2 = rem % TPE1, kt = r2 % (D / 64), nt = r2 / (D / 64);
        c.src = (which ? pwu : pwg) + ((size_t)l * NE + e) * D * DE + (size_t)kt * 64 * DE + nt * 64; c.ld_src = DE;
        const int drow = (nt >> 1) * 256 + which * 128 + (nt & 1) * 64;
        c.dst = WSH(O_EGU) + (((size_t)l * NE + e) * 2 * DE + drow) * D + kt * 64; c.ld_dst = D;
    } else if (it < N5) {
        const int j = it - N4, e = j / TPE2, r2 = j % TPE2, kt = r2 % (DE / 64), nt = r2 / (DE / 64);
        c.src = p.in[IEWD] + ((size_t)l * NE + e) * DE * D + (size_t)kt * 64 * D + nt * 64; c.ld_src = D; c.dst = WSH(O_ED) + (((size_t)l * NE + e) * D + nt * 64) * DE + kt * 64; c.ld_dst = DE;
    } else {
        const int j = it - N5, kt = j % (D / 64), nt = j / (D / 64);
        c.src = p.in[IWIN] + (size_t)(l + 1) * D * IN_DIM + (size_t)kt * 64 * IN_DIM + nt * 64; c.ld_src = IN_DIM; c.dst = WSH(O_WINT) + (size_t)(l + 1) * IN_DIM * D + (size_t)nt * 64 * D + kt * 64; c.ld_dst = D;
    }
    return c;
}
__device__ __forceinline__ void conv_load(const ConvTile& c, int lane, float (&v)[64]) {
    const BufRsrc rs = make_rsrc(c.src, (size_t)64 * c.ld_src * 4);
#pragma unroll
    for (int k = 0; k < 64; ++k) v[k] = buf_load4(rs, lane * 4, k * c.ld_src * 4);
}
__device__ __forceinline__ void conv_emit(const ConvTile& c, int lane, const float (&v)[64]) {
#ifdef EMU
    bf16_t* q = c.dst + (size_t)lane * c.ld_dst;
#pragma unroll
    for (int j = 0; j < 8; ++j)
        *(uint4*)(q + 8 * j) = make_uint4(pg8::pk_bf16(v[8 * j], v[8 * j + 1]), pg8::pk_bf16(v[8 * j + 2], v[8 * j + 3]), pg8::pk_bf16(v[8 * j + 4], v[8 * j + 5]), pg8::pk_bf16(v[8 * j + 6], v[8 * j + 7]));
#else
    const BufRsrc rd = make_rsrc(c.dst, (size_t)64 * c.ld_dst * 2);
    const int vo = lane * c.ld_dst * 2;
#pragma unroll
    for (int j = 0; j < 8; ++j) {
        pg8::u32x4 w; w[0] = pg8::pk_bf16(v[8 * j], v[8 * j + 1]); w[1] = pg8::pk_bf16(v[8 * j + 2], v[8 * j + 3]); w[2] = pg8::pk_bf16(v[8 * j + 4], v[8 * j + 5]); w[3] = pg8::pk_bf16(v[8 * j + 6], v[8 * j + 7]);
        __builtin_amdgcn_raw_buffer_store_b128(w, rd, vo + 16 * j, 0, 0);
    }
#endif
}
__device__ __forceinline__ void conv_role(const Params& p, int l, int cw, int ncw, int lane) {
    constexpr int NFOLD = (PW / 64) * (D / 64);
    const int total = conv_total(l);
    cw += NFOLD;
    while (cw >= NFOLD + ncw) cw -= ncw;
    if (cw >= total) return;
    float va[64], vb[64];
    ConvTile ca = conv_tile_of(p, l, cw);
    conv_load(ca, lane, va);
#pragma unroll 1
    for (int it = cw; it < total; it += ncw) {
        const int nx = it + ncw;
        const ConvTile cb = conv_tile_of(p, l, nx < total ? nx : it);
        conv_load(cb, lane, vb);
        conv_emit(ca, lane, va);
        ca = cb;
#pragma unroll
        for (int i = 0; i < 64; ++i) va[i] = vb[i];
    }
}
PHASE_FN void ph_scan(const Params& p, int l, LAS unsigned char* lds) {
    (void)l;
    const int TX_ = ltid(p.sw);
#ifdef EMU
    const int wave = TX_ >> 6;
#else
    const int wave = p.sw;
#endif
    const int lane = TX_ & 63, g = lane >> 4, kq = lane & 15;
    constexpr int NS = C + L, nitems = 2 * NB * RH * 16;
    const BufRsrc rs = make_rsrc((const unsigned char*)WSF(O_PACK) - 4096, PACK_BYTES + 4096);
    volatile LAS int* flg = (volatile LAS int*)(lds + SH_ROUNDS * 16 * SCAN_SLOT);
    if (TX_ < 8) flg[TX_] = 0;
    __syncthreads();
    if (wave < 4) {
        LAS unsigned char* ring = lds + wave * (SCAN_RING * SCAN_SLOT);
        const bool xcd_deal = (gridDim.x % 8 == 0) && (nitems % (8 * 16) == 0) && (gridDim.x * 4 == nitems);
        if (xcd_deal) {
            constexpr int NR = NS / 16;
            const int x = blockIdx.x % 8, slot = (blockIdx.x / 8) * 4 + wave;
            const int item = (x + 8 * (slot >> 4)) * 16 + (slot & 15);
            const int chain = item >> 4, rg = item & 15;
            const int d = chain / (NB * RH), b = (chain / RH) % NB, h = chain % RH;
            const int vrow = rg * 4 + g;
            const int dstep = (d == 0 ? 1 : -1) * RH * REC;
#define SCAN_SOFF(s) ((int)((((size_t)d * T + scan_row((s), d, b)) * RH + h) * REC))
            const int voff = lane * 16, voffb = lane * 4;
#define SH_ISSUE(q_, phq_) { int so_ = SCAN_SOFF(16 * (q_) + wave) + 4096; SCAN_SGPR_SETTLE(rs, so_); LAS unsigned char* sb_ = lds + (((phq_) * 16 + wave) * SCAN_SLOT); \
                _Pragma("unroll") for (int k_ = 0; k_ < 4; ++k_) { scan_set_m0(sb_ + k_ * 4 * SCAN_SLOT); scan_dma2_settled(rs, voff, voffb, so_); so_ += 4 * dstep; } }
#define SH_SPIN(needl_, needc_) { unsigned sp_ = 0; for (;;) { const int l0_ = flg[0], l1_ = flg[1], l2_ = flg[2], l3_ = flg[3], c0_ = flg[4], c1_ = flg[5], c2_ = flg[6], c3_ = flg[7]; \
                if ((min(min(l0_, l1_), min(l2_, l3_)) >= (needl_) && min(min(c0_, c1_), min(c2_, c3_)) >= (needc_)) || ++sp_ > (1u << 20)) break; SH_RELAX(); } SH_FENCE(); }
            SH_ISSUE(0, 0) SH_ISSUE(1, 1) SH_ISSUE(2, 2)
            SCAN_WAIT(0);
            SH_FENCE();
            if (lane == 0) flg[wave] = 3;
            float S0 = 0.f, S1 = 0.f, S2 = 0.f, S3 = 0.f;
            float* Yb = WSF(O_Y) + (size_t)d * T * RW + h * 64 + vrow;
            SH_SPIN(1, -1)
            ScanOps cur = scan_read(lds, kq, vrow);
            float yprev = 0.f, ykA = 0.f;
            int ph = 0;
#pragma unroll 1
            for (int r = 0; r < NR; ++r) {
                SH_FENCE();
                if (lane == 0) flg[4 + wave] = r;
                SH_SPIN(min(r + 2, NR), r - 1)
                const int ph3 = (ph + 3 >= SH_ROUNDS) ? ph + 3 - SH_ROUNDS : ph + 3;
                if (r + 3 < NR) { SH_ISSUE(r + 3, ph3) SCAN_WAIT(8); } else { SCAN_WAIT(0); }
                SH_FENCE();
                if (lane == 0) flg[wave] = min(r + 3, NR);
                const int phn = (ph + 1 >= SH_ROUNDS) ? 0 : ph + 1;
                const LAS unsigned char* rb = lds + ph * 16 * SCAN_SLOT;
                const LAS unsigned char* rbn = lds + phn * 16 * SCAN_SLOT;
                const int s0 = r * 16;
#pragma unroll
                for (int j = 0; j < 16; ++j) {
                    const ScanOps nxt = scan_read(j < 15 ? rb + (j + 1) * SCAN_SLOT : rbn, kq, vrow);
                    float dot = S0 * cur.kk[0] + S1 * cur.kk[1] + S2 * cur.kk[2] + S3 * cur.kk[3];
                    const float cv = bf2f(cur.vq); const pg8::f32x4 cr = bf4_to_f32(cur.rq);
                    const float t0 = S0 * cur.w[0] + cv * cur.k[0], t1 = S1 * cur.w[1] + cv * cur.k[1], t2 = S2 * cur.w[2] + cv * cur.k[2], t3 = S3 * cur.w[3] + cv * cur.k[3];
                    dot = dpp_sum16(dot);
                    const float yred = dpp_sum16(yprev);
                    ykA = row_push(ykA, yred, kq);
                    S0 = t0 - dot * cur.b[0]; S1 = t1 - dot * cur.b[1]; S2 = t2 - dot * cur.b[2]; S3 = t3 - dot * cur.b[3];
                    yprev = S0 * cr[0] + S1 * cr[1] + S2 * cr[2] + S3 * cr[3];
                    cur = nxt;
                }
                {
                    const int sa = s0 + 14 - kq;
                    if (sa >= 0) scan_store(Yb + (size_t)scan_row(sa, d, b) * RW, ykA);
                }
                ph = phn;
            }
            scan_store(Yb + (size_t)scan_row(NS - 1, d, b) * RW, dpp_sum16(yprev));
            SCAN_WAIT(0);
#undef SCAN_SOFF
#undef SH_ISSUE
#undef SH_SPIN
        }
#if PROBE_MASK & 0x200000
        for (int rep_ = 0; rep_ < 2; ++rep_)
#endif
        for (int it0 = xcd_deal ? nitems : wave * gridDim.x + blockIdx.x; it0 < nitems; it0 += 4 * gridDim.x) {
            int item = it0;
            if (xcd_deal) { const int x = blockIdx.x % 8, slot = (blockIdx.x / 8) * 4 + wave;
                item = (x + 8 * (slot >> 4)) * 16 + (slot & 15); }
            const int chain = item >> 4, rg = item & 15;
            const int d = chain / (NB * RH), b = (chain / RH) % NB, h = chain % RH;
            const int vrow = rg * 4 + g;
            const int dstep = (d == 0 ? 1 : -1) * RH * REC;
#define SCAN_SOFF(s) ((int)((((size_t)d * T + scan_row((s), d, b)) * RH + h) * REC))
            const int voff = lane * 16;
            const int dstepA = dstep - SCAN_SLOT, dstepB = dstep + 2 * SCAN_SLOT;
            const int voffb = lane * 4;
            {
                int so = SCAN_SOFF(0) + 4096;
                SCAN_SGPR_SETTLE(rs, so);
#pragma unroll
                for (int j = 0; j < SCAN_RING; ++j) { if (j % 3 == 0) scan_set_m0(ring + j * SCAN_SLOT); scan_dma2(j % 3, rs, voff, voffb, so); so += ((j + 1) % 3) ? dstepA : dstepB; }
            }
            float S0 = 0.f, S1 = 0.f, S2 = 0.f, S3 = 0.f;
            float* Yb = WSF(O_Y) + (size_t)d * T * RW + h * 64 + vrow;
            SCAN_WAIT(30);
            ScanOps cur = scan_read(ring, kq, vrow);
            float yprev = 0.f, ykA = 0.f;
#pragma unroll 1
            for (int s0 = 0; s0 < NS; s0 += SCAN_RING) {
                const int sn0 = (s0 + SCAN_RING < NS) ? s0 + SCAN_RING : s0;
                int so = SCAN_SOFF(sn0) + 4096;
                SCAN_SGPR_SETTLE(rs, so);
#pragma unroll
                for (int j = 0; j < SCAN_RING; ++j) {
                    SCAN_WAIT(28);
                    const ScanOps nxt = scan_read(ring + ((j + 1) % SCAN_RING) * SCAN_SLOT, kq, vrow);
                    float dot = S0 * cur.kk[0] + S1 * cur.kk[1] + S2 * cur.kk[2] + S3 * cur.kk[3];
                    const float cv = bf2f(cur.vq); const pg8::f32x4 cr = bf4_to_f32(cur.rq);
                    const float t0 = S0 * cur.w[0] + cv * cur.k[0], t1 = S1 * cur.w[1] + cv * cur.k[1], t2 = S2 * cur.w[2] + cv * cur.k[2], t3 = S3 * cur.w[3] + cv * cur.k[3];
                    dot = dpp_sum16(dot);
                    const float yred = dpp_sum16(yprev);
                    ykA = row_push(ykA, yred, kq);
                    S0 = t0 - dot * cur.b[0]; S1 = t1 - dot * cur.b[1]; S2 = t2 - dot * cur.b[2]; S3 = t3 - dot * cur.b[3];
                    yprev = S0 * cr[0] + S1 * cr[1] + S2 * cr[2] + S3 * cr[3];
                    if (j % 3 == 0) scan_set_m0(ring + j * SCAN_SLOT);
                    scan_dma2(j % 3, rs, voff, voffb, so); so += ((j + 1) % 3) ? dstepA : dstepB;
                    cur = nxt;
                }
                {
                    const int sa = s0 + 14 - kq;
                    if (sa >= 0) scan_store(Yb + (size_t)scan_row(sa, d, b) * RW, ykA);
                }
            }
            scan_store(Yb + (size_t)scan_row(NS - 1, d, b) * RW, dpp_sum16(yprev));
            SCAN_WAIT(0);
#undef SCAN_SOFF
        }
#if PROBE_MASK & 0x4000000
        __syncthreads();
#endif
    } else {
#if PROBE_MASK & 0x4000000
        __syncthreads();
#endif
        conv_role(p, l, (int)blockIdx.x * 4 + (wave - 4), (int)gridDim.x * 4, lane);
#if PROBE_MASK & 0x100000
        conv_role(p, l, (int)blockIdx.x * 4 + (wave - 4), (int)gridDim.x * 4, lane);
#endif
    }
    __syncthreads();
}

PHASE_FN void ph_readout(const Params& p, int l) {
    static_assert(RW == 512 && RH == 8, "readout geometry");
    const int TX_ = ltid(p.sw);
    const int wave = TX_ >> 6, lane = TX_ & 63;
    for (int r = blockIdx.x * NW + wave; r < T; r += gridDim.x * NW) {
        pg8::f32x4 y[2], vv[2], gg[2];
#pragma unroll
        for (int j = 0; j < 2; ++j) { const size_t o = (size_t)r * RW + j * 256 + lane * 4;
            y[j] = *(const pg8::f32x4*)(WSF(O_Y) + o) + *(const pg8::f32x4*)(WSF(O_Y) + (size_t)T * RW + o); vv[j] = *(const pg8::f32x4*)(WSF(O_V) + o); gg[j] = *(const pg8::f32x4*)(WSF(O_G) + o); }
#pragma unroll
        for (int j = 0; j < 2; ++j) { const int ch = j * 256 + lane * 4;
            const float mean = dpp_sum16(y[j][0] + y[j][1] + y[j][2] + y[j][3]) * (1.0f / 64.0f);
            const pg8::f32x4 dv = y[j] - mean;
            const float var = dpp_sum16(dv[0] * dv[0] + dv[1] * dv[1] + dv[2] * dv[2] + dv[3] * dv[3]) * (1.0f / 64.0f);
            const float rs = rsqrtf(var + GN_EPS), bon = WSF(O_BON)[(size_t)r * RH + (ch >> 6)];
            const pg8::f32x4 lg = *(const pg8::f32x4*)(p.in[ILNG] + l * RW + ch), lb = *(const pg8::f32x4*)(p.in[ILNB] + l * RW + ch);
            const pg8::f32x4 o4 = (dv * rs * lg + lb + bon * vv[j]) * gg[j];
            pg8::u32x2 w2; w2[0] = pg8::pk_bf16(o4[0], o4[1]); w2[1] = pg8::pk_bf16(o4[2], o4[3]);
            *(pg8::u32x2*)(WSH(O_OCAT) + (size_t)r * KCAT + PW + ch) = w2; }
    }
}

constexpr int AT_KS = 272, AT_VS = 144, AT_PS = 144;
constexpr int AT_K = 0, AT_V = 64 * AT_KS, AT_P = AT_V + 128 * AT_VS, AT_ST = AT_P + NW * 32 * AT_PS;
typedef float f32x16 __attribute__((ext_vector_type(16)));
struct AttnRegs { pg8::u32x4 k[2], v[2]; };
template <bool WITHV> __device__ __forceinline__ void attn_load(const Params& p, AttnRegs& r, int krow0, int rlo, int rhi, int kvh, int tid) {
#pragma unroll
    for (int i = 0; i < 2; ++i) {
        const int chunk = tid + i * NT, key = chunk >> 4, part = chunk & 15;
        int row = krow0 + key; row = row < rlo ? rlo : (row > rhi ? rhi : row);
        r.k[i] = *(const pg8::u32x4*)(WSH(O_KB) + (size_t)row * KVW + kvh * 128 + part * 8);
        if (WITHV) {
            const int keyv = chunk & 63, partv = chunk >> 6;
            int rowv = krow0 + keyv; rowv = rowv < rlo ? rlo : (rowv > rhi ? rhi : rowv);
            r.v[i] = *(const pg8::u32x4*)(WSH(O_VB) + (size_t)rowv * KVW + kvh * 128 + partv * 8);
        }
    }
}
template <bool WITHV> __device__ __forceinline__ void attn_store(LAS unsigned char* lds, const AttnRegs& r, int tid) {
#pragma unroll
    for (int i = 0; i < 2; ++i) {
        const int chunk = tid + i * NT, key = chunk >> 4, part = chunk & 15;
        *(LAS pg8::u32x4*)(lds + AT_K + key * AT_KS + part * 16) = r.k[i];
        if (WITHV) {
            const int keyv = chunk & 63, partv = chunk >> 6;
            const unsigned w4[4] = {r.v[i][0], r.v[i][1], r.v[i][2], r.v[i][3]};
#pragma unroll
            for (int q = 0; q < 4; ++q) {
                *(LAS bf16_t*)(lds + AT_V + (partv * 8 + 2 * q) * AT_VS + keyv * 2) = (bf16_t)(w4[q] & 0xffffu);
                *(LAS bf16_t*)(lds + AT_V + (partv * 8 + 2 * q + 1) * AT_VS + keyv * 2) = (bf16_t)(w4[q] >> 16);
            }
        }
    }
}
PHASE_FN void ph_attn(const Params& p, int l, bool need_ctx, LAS unsigned char* lds) {
    const int TX_ = ltid(p.sw);
#ifdef EMU
    const int wave = TX_ >> 6;
#else
    const int wave = p.sw;
#endif
    const int g = wave & 3, th = wave >> 2;
    constexpr int NCT = C / 64, NQT = L / 64, n_lat = NB * KVH * NQT;
    const int n_ctx = need_ctx ? NB * KVH * NCT : 0;
    const float SC = 0.08838834764831845f;
    LAS unsigned char* Pw = lds + AT_P + wave * 32 * AT_PS;
    LAS float* st = (LAS float*)(lds + AT_ST + wave * 512);
    for (int u = blockIdx.x; u < n_lat + n_ctx; u += gridDim.x) {
        int txo = TX_; PG8_OPAQUE(txo);
        const int lane = txo & 63, c = lane & 31, h = lane >> 5;
        const bool lat = u < n_lat;
        const int uu = lat ? u : u - n_lat, nqt = lat ? NQT : NCT;
        const int tq = uu % nqt, kvh = (uu / nqt) % KVH, b = uu / (nqt * KVH);
        const int hq = kvh * 4 + g, ntile = lat ? NCT + 5 : NCT;
        const int tw = tq * 64 + th * 32 + c;
        const int qrow = lat ? TC + b * L + tw : b * C + tw;
        const float sink = p.in[ISINK][l * QH + hq];
        pg8::bf16x8 Qu[8], Qr[8];
#pragma unroll
        for (int ks = 0; ks < 8; ++ks) {
            Qu[ks] = *(const pg8::bf16x8*)(WSH(O_QB) + (size_t)qrow * AW + hq * 128 + ks * 16 + h * 8);
            Qr[ks] = lat ? *(const pg8::bf16x8*)(WSH(O_QRB) + (size_t)(qrow - TC) * AW + hq * 128 + ks * 16 + h * 8) : Qu[ks];
        }
#define AT_TILE(kt, krow0, rlo, rhi, jpos0) const bool ctxt = (kt) < NCT; \
        const int jpos0 = ctxt ? 0 : tq * 64 - 128 + ((kt) - NCT) * 64; \
        const int krow0 = ctxt ? b * C + (kt) * 64 : TC + b * L + jpos0, rlo = ctxt ? b * C : TC + b * L, rhi = ctxt ? b * C + C - 1 : TC + b * L + L - 1;
#define AT_SCORES(acc, kb, ctxt) { acc = (f32x16){0.f, 0.f, 0.f, 0.f, 0.f, 0.f, 0.f, 0.f, 0.f, 0.f, 0.f, 0.f, 0.f, 0.f, 0.f, 0.f}; \
        _Pragma("unroll") for (int ks = 0; ks < 8; ++ks) { const pg8::bf16x8 kf = *(const LAS pg8::bf16x8*)(lds + AT_K + ((kb) * 32 + c) * AT_KS + ks * 32 + h * 16); \
            acc = __builtin_amdgcn_mfma_f32_32x32x16_bf16(kf, (ctxt) ? Qu[ks] : Qr[ks], acc, 0, 0, 0); } }
        float mloc = -1e30f;
        AttnRegs ar;
        { AT_TILE(0, krow0, rlo, rhi, jpos0) (void)jpos0; attn_load<false>(p, ar, krow0, rlo, rhi, kvh, txo); }
        for (int kt = 0; kt < ntile; ++kt) {
            AT_TILE(kt, krow0, rlo, rhi, jpos0)
            __syncthreads();
            attn_store<false>(lds, ar, txo);
            __syncthreads();
            if (kt + 1 < ntile) { const int kn = kt + 1; const bool ctxt2 = kn < NCT; const int jp2 = ctxt2 ? 0 : tq * 64 - 128 + (kn - NCT) * 64;
              attn_load<false>(p, ar, ctxt2 ? b * C + kn * 64 : TC + b * L + jp2, ctxt2 ? b * C : TC + b * L, ctxt2 ? b * C + C - 1 : TC + b * L + L - 1, kvh, txo); }
#pragma unroll
            for (int kb = 0; kb < 2; ++kb) {
                f32x16 acc; AT_SCORES(acc, kb, ctxt)
#pragma unroll
                for (int i = 0; i < 16; ++i) {
                    const int j = jpos0 + kb * 32 + (i & 3) + 8 * (i >> 2) + 4 * h;
                    const bool valid = ctxt || (j >= 0 && j < L && j - tw <= 128 && tw - j <= 128);
                    mloc = fmaxf(mloc, valid ? acc[i] : -1e30f);
                }
            }
        }
        st[h * 32 + c] = mloc;
        WAVE_SYNC();
        const float m = fmaxf(fmaxf(st[c], st[32 + c]) * SC, sink);
        WAVE_SYNC();
        f32x16 O[4];
#pragma unroll
        for (int db = 0; db < 4; ++db) O[db] = (f32x16){0.f, 0.f, 0.f, 0.f, 0.f, 0.f, 0.f, 0.f, 0.f, 0.f, 0.f, 0.f, 0.f, 0.f, 0.f, 0.f};
        float lsum = 0.f;
        { AT_TILE(0, krow0, rlo, rhi, jpos0) (void)jpos0; attn_load<true>(p, ar, krow0, rlo, rhi, kvh, txo); }
        for (int kt = 0; kt < ntile; ++kt) {
            AT_TILE(kt, krow0, rlo, rhi, jpos0)
            __syncthreads();
            attn_store<true>(lds, ar, txo);
            __syncthreads();
            if (kt + 1 < ntile) { const int kn = kt + 1; const bool ctxt2 = kn < NCT; const int jp2 = ctxt2 ? 0 : tq * 64 - 128 + (kn - NCT) * 64;
              attn_load<true>(p, ar, ctxt2 ? b * C + kn * 64 : TC + b * L + jp2, ctxt2 ? b * C : TC + b * L, ctxt2 ? b * C + C - 1 : TC + b * L + L - 1, kvh, txo); }
#pragma unroll
            for (int kb = 0; kb < 2; ++kb) {
                f32x16 acc; AT_SCORES(acc, kb, ctxt)
#pragma unroll
                for (int grp = 0; grp < 4; ++grp) {
                    float pv[4];
#pragma unroll
                    for (int q = 0; q < 4; ++q) {
                        const int i = grp * 4 + q, j = jpos0 + kb * 32 + q + 8 * grp + 4 * h;
                        const bool valid = ctxt || (j >= 0 && j < L && j - tw <= 128 && tw - j <= 128);
                        const float e = valid ? __expf(acc[i] * SC - m) : 0.f;
                        lsum += e; pv[q] = e;
                    }
                    pg8::u32x2 w2; w2[0] = pg8::pk_bf16(pv[0], pv[1]); w2[1] = pg8::pk_bf16(pv[2], pv[3]);
                    *(LAS pg8::u32x2*)(Pw + c * AT_PS + (kb * 32 + 8 * grp + 4 * h) * 2) = w2;
                }
            }
            WAVE_SYNC();
#pragma unroll
            for (int ks = 0; ks < 4; ++ks) {
                const pg8::bf16x8 pf = *(const LAS pg8::bf16x8*)(Pw + c * AT_PS + ks * 32 + h * 16);
#pragma unroll
                for (int db = 0; db < 4; ++db) {
                    const pg8::bf16x8 vf = *(const LAS pg8::bf16x8*)(lds + AT_V + (db * 32 + c) * AT_VS + ks * 32 + h * 16);
                    O[db] = __builtin_amdgcn_mfma_f32_32x32x16_bf16(pf, vf, O[db], 0, 0, 0);
                }
            }
            WAVE_SYNC();
        }
        st[64 + h * 32 + c] = lsum;
        WAVE_SYNC();
        float rinv[16];
#pragma unroll
        for (int i = 0; i < 16; ++i) { const int q = (i & 3) + 8 * (i >> 2) + 4 * h; const float mm = fmaxf(fmaxf(st[q], st[32 + q]) * SC, sink); rinv[i] = pg8::frcp(st[64 + q] + st[96 + q] + __expf(sink - mm)); }
        WAVE_SYNC();
        const int orow0 = (lat ? TC + b * L : b * C) + tq * 64 + th * 32;
#pragma unroll
        for (int dh = 0; dh < 2; ++dh) {
#pragma unroll
            for (int d2 = 0; d2 < 2; ++d2)
#pragma unroll
                for (int i = 0; i < 16; ++i) { const int q = (i & 3) + 8 * (i >> 2) + 4 * h;
                    *(LAS bf16_t*)(Pw + q * AT_PS + (d2 * 32 + c) * 2) = f2bf(O[dh * 2 + d2][i] * rinv[i]); }
            WAVE_SYNC();
#pragma unroll
            for (int pz = 0; pz < 4; ++pz) { const int row = pz * 8 + (lane >> 3), ck = lane & 7;
                const pg8::u32x4 w4 = *(const LAS pg8::u32x4*)(Pw + row * AT_PS + ck * 16);
                *(pg8::u32x4*)(WSH(O_OCAT) + (size_t)(orow0 + row) * KCAT + PW + RW + hq * 128 + dh * 64 + ck * 8) = w4; }
            WAVE_SYNC();
        }
#undef AT_TILE
#undef AT_SCORES
    }
    __syncthreads();
}

PHASE_FN void ph_poolmm(const Params& p, int l, float* lds) {
    const int TX_ = ltid(p.sw);
    const int tx = TX_ & 15, ty = TX_ >> 4;
    const int nM = T / GT_M, nN = PW / 64;
    for (int it = blockIdx.x; it < nM * nN; it += gridDim.x) {
        const int m0 = (it / nN) * GT_M, n0 = (it % nN) * 64, g = n0 / PGD;
        float acc[4][4]; ZERO_ACC(acc);
        gemm_tile(WSF(O_POOLED) + g * PGD, PW, nullptr, 0, T, m0, p.in[IPOOLW] + ((size_t)l * 4 + g) * PGD * PGD, PGD, n0 - g * PGD, PGD, acc, lds, TX_);
#pragma unroll
        for (int i = 0; i < 4; ++i)
#pragma unroll
            for (int j = 0; j < 4; ++j) { const int n = n0 + 4 * tx + j; WSH(O_OCAT)[(size_t)(m0 + 4 * ty + i) * KCAT + n] = f2bf(acc[i][j] * p.in[IPOOLS][l * PW + n]); }
    }
}

PHASE_FN void ph_merge(const Params& p, int l, bool need_ctx, LAS unsigned char* lds) {
    const int pm0 = need_ctx ? 0 : TC / 256;
    pg8::DenseOrder S; S.init(WSH(O_OCAT), KCAT, WSH(O_WMT) + (size_t)l * D * KCAT, KCAT, pm0, T / 256 - pm0, D / 256, gridDim.x, blockIdx.x);
    pg8::EpiMerge E{WSH(O_SG), WSH(O_MBB)};
    pg8::gemm_phase<pg8::EpiMerge, pg8::DenseOrder>(lds, KCAT, KCAT, KCAT, S, E, ltid(p.sw));
}
PHASE_FN void ph_wout(const Params& p, int l, bool need_ctx, LAS unsigned char* lds) {
    const int pm0 = need_ctx ? 0 : TC / 256;
    pg8::DenseOrder S; S.init(WSH(O_MBB), D, WSH(O_WOT) + (size_t)l * D * D, D, pm0, T / 256 - pm0, D / 256, gridDim.x, blockIdx.x);
    pg8::EpiWout E{WSF(O_X), WSF(O_MOD) + (size_t)l * (NB + 1) * 6 * D, l == 0 ? p.in[ICTX] : nullptr, l == 0 ? p.in[IX] : nullptr};
    pg8::gemm_phase<pg8::EpiWout, pg8::DenseOrder>(lds, D, D, D, S, E, ltid(p.sw));
}

PHASE_FN void ph_norm2(const Params& p, int l, bool need_ctx, LAS unsigned char* lds, bool dry = false) {
    const int TX_ = ltid(p.sw);
#ifdef EMU
    const int wave = TX_ >> 6;
#else
    const int wave = p.sw;
#endif
    const int lane = TX_ & 63;
    LAS float* Wc = (LAS float*)lds;
    LAS float* lg = (LAS float*)lds + 6 * D + wave * 200;
    const int r_begin = need_ctx ? 0 : TC, nrows_all = T - r_begin;
    const int per = min((nrows_all + (int)gridDim.x - 1) / (int)gridDim.x, 40);
    const int nblk = (nrows_all + per - 1) / per;
    for (int blk = blockIdx.x; blk < nblk; blk += gridDim.x) {
    const int rb0 = r_begin + blk * per, rb1 = min(rb0 + per, T);
    const int q4 = per / 8, extra = per - 8 * q4;
    const int myn = q4 + (wave < extra ? 1 : 0), myr0 = rb0 + wave * q4 + min(wave, extra);
    const int nrow = max(0, min(myn, rb1 - myr0));
    const float* g2 = p.in[INORM2] + l * D;
    int ln = lane; PG8_OPAQUE(ln);
    float hv[5][D / 64];
#pragma unroll
    for (int rr = 0; rr < 5; ++rr) {
        const int r = min(myr0 + rr, T - 1); int t, len, mr; seq_info(r, t, len, mr);
        const float* xr = WSF(O_X) + (size_t)r * D;
        float ss = 0.f;
#pragma unroll
        for (int i = 0; i < D / 256; ++i) { const float4 x = *(const float4*)(xr + (i * 64 + ln) * 4); hv[rr][4 * i] = x.x; hv[rr][4 * i + 1] = x.y; hv[rr][4 * i + 2] = x.z; hv[rr][4 * i + 3] = x.w; ss += x.x * x.x + x.y * x.y + x.z * x.z + x.w * x.w; }
        ss = wave_bcast63(wave_total63(ss));
        const float rs = rsqrtf(ss / (float)D + NORM_EPS);
        const float* md = WSF(O_MOD) + ((size_t)l * (NB + 1) + mr) * 6 * D;
#pragma unroll
        for (int i = 0; i < D / 256; ++i) {
            const int c = (i * 64 + ln) * 4;
            const float4 g = *(const float4*)(g2 + c), sh = *(const float4*)(md + 3 * D + c), sc = *(const float4*)(md + 4 * D + c);
            const float h0 = (hv[rr][4 * i] * rs * g.x) * (1.0f + sc.x) + sh.x, h1 = (hv[rr][4 * i + 1] * rs * g.y) * (1.0f + sc.y) + sh.y;
            const float h2 = (hv[rr][4 * i + 2] * rs * g.z) * (1.0f + sc.z) + sh.z, h3 = (hv[rr][4 * i + 3] * rs * g.w) * (1.0f + sc.w) + sh.w;
            hv[rr][4 * i] = h0; hv[rr][4 * i + 1] = h1; hv[rr][4 * i + 2] = h2; hv[rr][4 * i + 3] = h3;
            if (rr < nrow) { uint2 o; o.x = pg8::pk_bf16(h0, h1); o.y = pg8::pk_bf16(h2, h3); *(uint2*)(WSH(O_H2B) + (size_t)r * D + c) = o; }
        }
        WAVE_FENCE();
    }
#pragma unroll 1
    for (int ch = 0; ch < 6; ++ch) {
        __syncthreads();
        {
            const float* wsrc = WSF(O_WRT) + ((size_t)l * (4 + NE) + ch * 6) * D;
            for (int i4 = TX_; i4 < 6 * D / 4; i4 += NT) *(LAS pg8::f32x4*)(Wc + i4 * 4) = *(const pg8::f32x4*)(wsrc + i4 * 4);
        }
        __syncthreads();
        float acc[5][6];
#pragma unroll
        for (int rr = 0; rr < 5; ++rr)
#pragma unroll
            for (int n = 0; n < 6; ++n) acc[rr][n] = 0.f;
#pragma unroll
        for (int i = 0; i < D / 256; ++i) {
#pragma unroll
            for (int n = 0; n < 6; ++n) {
                const pg8::f32x4 wq = *(const LAS pg8::f32x4*)(Wc + n * D + (i * 64 + lane) * 4);
#pragma unroll
                for (int rr = 0; rr < 5; ++rr) acc[rr][n] += hv[rr][4 * i] * wq[0] + hv[rr][4 * i + 1] * wq[1] + hv[rr][4 * i + 2] * wq[2] + hv[rr][4 * i + 3] * wq[3];
            }
#pragma unroll
            for (int rr = 0; rr < 5; ++rr) ACC_PIN6(acc[rr]);
            WAVE_FENCE();
        }
#pragma unroll
        for (int rr = 0; rr < 5; ++rr)
#pragma unroll
            for (int n = 0; n < 6; ++n) { const float tsum = wave_total63(acc[rr][n]); if (lane == 63) lg[rr * 40 + ch * 6 + n] = tsum; }
    }
    WAVE_SYNC();
    if (lane < nrow && !dry) {
        const int r = myr0 + lane; const LAS float* q = lg + lane * 40;
        float lgv[36];
#pragma unroll
        for (int i = 0; i < 36; ++i) lgv[i] = q[i] + (i < 4 ? p.in[IRGB][l * 4 + i] : p.in[IREB][l * NE + i - 4]);
        int gi = 0; float gm = lgv[0];
#pragma unroll
        for (int i = 1; i < 4; ++i) if (lgv[i] > gm) { gm = lgv[i]; gi = i; }
        float gs = 0.f;
#pragma unroll
        for (int i = 0; i < 4; ++i) gs += expf(lgv[i] - gm);
        const float g_top = 1.0f / gs;
        float el[8];
#pragma unroll
        for (int i = 0; i < 8; ++i) el[i] = (gi == 0) ? lgv[4 + i] : (gi == 1 ? lgv[12 + i] : (gi == 2 ? lgv[20 + i] : lgv[28 + i]));
        int e0 = 0; float m0 = el[0];
#pragma unroll
        for (int i = 1; i < 8; ++i) if (el[i] > m0) { m0 = el[i]; e0 = i; }
        int e1 = -1; float m1 = -3.0e38f;
#pragma unroll
        for (int i = 0; i < 8; ++i) if (i != e0 && el[i] > m1) { m1 = el[i]; e1 = i; }
        const float p1 = expf(m1 - m0);
        const float w0 = g_top / (1.0f + p1), w1 = g_top * p1 / (1.0f + p1);
        const int id0 = gi * 8 + e0, id1 = gi * 8 + e1;
        WSI(O_EID)[2 * r] = id0; WSI(O_EID)[2 * r + 1] = id1; WSF(O_EWT)[2 * r] = w0; WSF(O_EWT)[2 * r + 1] = w1;
        WSI(O_POS)[2 * r] = atomicAdd(&WSI(O_ECNT)[l * NE + id0], 1);
        WSI(O_POS)[2 * r + 1] = atomicAdd(&WSI(O_ECNT)[l * NE + id1], 1);
    }
    WAVE_SYNC();
    }
    __syncthreads();
}

constexpr int LDS_TOFF = pg8::STAGE_BYTES;
__device__ __forceinline__ void moe_offsets(const Params& p, int l, LAS int* toff) {
    const int TX_ = ltid(p.sw);
    __syncthreads();
    if (TX_ < NE) toff[64 + TX_] = WSI(O_ECNT)[l * NE + TX_];
    __syncthreads();
    if (TX_ <= NE) { int s = 0; for (int q = 0; q < TX_; ++q) s += (toff[64 + q] + 255) >> 8; toff[TX_] = s; }
    __syncthreads();
}
PHASE_FN void ph_gather(const Params& p, int l, bool need_ctx, LAS unsigned char* lds) {
    const int TX_ = ltid(p.sw);
    LAS int* toff = (LAS int*)(lds + LDS_TOFF);
    moe_offsets(p, l, toff);
    const int wave = TX_ >> 6, lane = TX_ & 63;
    const int s_begin = need_ctx ? 0 : 2 * TC;
    for (int sl = s_begin + blockIdx.x * NT + TX_; sl < 2 * T; sl += gridDim.x * NT) {
        const int e = WSI(O_EID)[sl], dst = toff[e] * 256 + WSI(O_POS)[sl];
        WSI(O_SLOTOF)[dst] = sl; WSF(O_WTP)[dst] = WSF(O_EWT)[sl];
    }
    for (int e = blockIdx.x; e < NE; e += gridDim.x) {
        const int r0 = toff[e] * 256 + toff[64 + e], r1 = toff[e + 1] * 256;
        for (int r = r0 + TX_; r < r1; r += NT) { WSI(O_SLOTOF)[r] = -1; WSF(O_WTP)[r] = 0.f; }
    }
    __syncthreads();
}
PHASE_FN void ph_moe1(const Params& p, int l, LAS unsigned char* lds) {
    LAS int* toff = (LAS int*)(lds + LDS_TOFF);
    moe_offsets(p, l, toff);
    pg8::MoeGatherOrder S{(const char*)WSH(O_H2B), (const char*)(WSH(O_EGU) + (size_t)l * NE * 2 * DE * D), (size_t)2 * DE * D * 2, (size_t)256 * D * 2, 2 * DE / 256, (int)gridDim.x, (int)blockIdx.x, toff, WSI(O_SLOTOF)};
    pg8::EpiSwiglu E{WSH(O_ACTB), WSF(O_WTP)};
    pg8::gemm_phase<pg8::EpiSwiglu, pg8::MoeGatherOrder>(lds, D, D, D, S, E, ltid(p.sw));
}
PHASE_FN void ph_moe2(const Params& p, int l, LAS unsigned char* lds) {
    LAS int* toff = (LAS int*)(lds + LDS_TOFF);
    moe_offsets(p, l, toff);
    pg8::MoeOrder S{(const char*)WSH(O_ACTB), (const char*)(WSH(O_ED) + (size_t)l * NE * D * DE), (size_t)256 * DE * 2, (size_t)D * DE * 2, (size_t)256 * DE * 2, D / 256, (int)gridDim.x, (int)blockIdx.x, toff};
    pg8::EpiDown E{WSH(O_YSB), WSI(O_SLOTOF)};
    pg8::gemm_phase<pg8::EpiDown, pg8::MoeOrder>(lds, DE, DE, DE, S, E, ltid(p.sw));
}

enum { PH_P0 = 0, PH_NORM1, PH_WIN, PH_PREP, PH_MIX, PH_READOUT, PH_MERGE, PH_WOUT, PH_NORM2, PH_GATHER, PH_MOE1, PH_MOE2, PH_FINAL };
template <int PH> __device__ __forceinline__ void run_phase(const Params& p_in, int l, unsigned char* smem, int sw) {
    const bool need_ctx = (l != DEPTH - 1);
    float* ldsf = (float*)smem;
    Params p;
#ifdef EMU
    p = p_in; p.sw = sw;
#else
    typedef const __attribute__((address_space(4))) Params* KP;
    KP kp = (KP)__builtin_amdgcn_kernarg_segment_ptr();
    asm volatile("" : "+s"(kp));
#pragma unroll
    for (int i = 0; i < N_IN; ++i) p.in[i] = kp->in[i];
    p.out = kp->out; p.ws = kp->ws; p.sw = sw; p.pad = 0;
    (void)p_in;
#endif
    LAS unsigned char* ldsl = (LAS unsigned char*)smem;
    if (PH == PH_P0) {
#if PROBE_MASK & 0x2000000
        {
            const int TX_ = ltid(p.sw); unsigned acc_ = 0;
            const size_t gt_ = (size_t)blockIdx.x * NT + TX_, gs_ = (size_t)gridDim.x * NT;
            for (size_t pg = gt_; pg < O_END / 4096; pg += gs_) acc_ += ((const volatile unsigned*)p.ws)[pg * 1024];
            for (size_t pg = gt_; pg < (size_t)DEPTH * D * 6 * D / 1024; pg += gs_) acc_ += ((const volatile unsigned*)p.in[IMODW])[pg * 1024];
            for (size_t pg = gt_; pg < (size_t)DEPTH * D * IN_DIM / 1024; pg += gs_) acc_ += ((const volatile unsigned*)p.in[IWIN])[pg * 1024];
            for (size_t pg = gt_; pg < (size_t)DEPTH * NE * D * DE / 1024; pg += gs_) { acc_ += ((const volatile unsigned*)p.in[IEWG])[pg * 1024]; acc_ += ((const volatile unsigned*)p.in[IEWU])[pg * 1024]; acc_ += ((const volatile unsigned*)p.in[IEWD])[pg * 1024]; }
            for (size_t pg = gt_; pg < (size_t)NB * L * D / 1024; pg += gs_) acc_ += ((const volatile unsigned*)p.in[IX])[pg * 1024];
            if (acc_ == 0x12345678u) WSI(O_EID)[0] = 1;
        }
#endif
        ph_pws(p); ph_rope_table(p); ph_lora_pack(p); ph_router_pack(p); ph_mod(p, ldsf); ph_conv_win0(p, ldsf); }
    if (PH == PH_NORM1) {
#if PROBE_MASK & 0x800000
        ph_norm1(p, l, 0, true);
#endif
        ph_norm1(p, l, 0); ph_fold(p, l, ldsf); }
    if (PH == PH_WIN) ph_win(p, l, ldsl);
    if (PH == PH_PREP) ph_prep(p, l, ldsf);
    if (PH == PH_MIX) {
        ph_scan(p, l, ldsl);
#if PROBE_MASK & 0x10000
        ph_scan(p, l, ldsl);
#endif
        ph_attn(p, l, need_ctx, ldsl);
#if PROBE_MASK & 0x20000
        ph_attn(p, l, need_ctx, ldsl);
#endif
    }
    if (PH == PH_READOUT) ph_readout(p, l);
    if (PH == PH_MERGE) ph_merge(p, l, need_ctx, ldsl);
    if (PH == PH_WOUT) ph_wout(p, l, need_ctx, ldsl);
    if (PH == PH_NORM2) {
#if PROBE_MASK & 0x400000
        ph_norm2(p, l, need_ctx, ldsl, true);
#endif
        ph_norm2(p, l, need_ctx, ldsl); }
    if (PH == PH_GATHER) ph_gather(p, l, need_ctx, ldsl);
    if (PH == PH_MOE1) ph_moe1(p, l, ldsl);
    if (PH == PH_MOE2) ph_moe2(p, l, ldsl);
    if (PH == PH_FINAL) {
#if PROBE_MASK & 0x800000
        ph_norm1(p, 0, 2, true);
#endif
        ph_norm1(p, 0, 2); }
}

#ifdef EMU
__shared__ unsigned char emu_smem[LDS_BYTES] __attribute__((aligned(16)));
template <int PH> __global__ void k_phase(Params p, int l) { run_phase<PH>(p, l, emu_smem, 0); }
#else
#define XB_TMO      128
#define XB_XCNT(j)  (256  + 64 * (j))
#define XB_XSUB(j)  (1280 + 64 * (j))
#define XB_XGEN(j)  (2304 + 64 * (j))
#define XB_TOP      3328
#define XB_TOPGEN   3392
#define XCD_BAR_WORDS 3456
#define XB_SPIN_CAP (1u << 18)
__device__ __forceinline__ unsigned xb_ld(unsigned* p)              { return __hip_atomic_load(p, __ATOMIC_RELAXED, __HIP_MEMORY_SCOPE_AGENT); }
__device__ __forceinline__ unsigned xb_add(unsigned* p, unsigned v) { return __hip_atomic_fetch_add(p, v, __ATOMIC_RELAXED, __HIP_MEMORY_SCOPE_AGENT); }
__device__ __forceinline__ unsigned xb_xcc_id() { return (unsigned)__builtin_amdgcn_s_getreg((3 << 11) | 20) & 0xFu; }
#define XB_SPIN(cond, bar) do { unsigned _sp = 0; while (cond) { __builtin_amdgcn_s_sleep(1); \
    if ((++_sp & 255u) == 0u) { if (xb_ld(&(bar)[XB_TMO])) break; if (_sp > XB_SPIN_CAP) { atomicAdd(&(bar)[XB_TMO], 1u); break; } } } } while (0)
struct XcdBarrier { unsigned* bar; unsigned x; volatile LAS unsigned* st; };
__device__ __forceinline__ XcdBarrier xcd_barrier_post(unsigned* bar, volatile LAS unsigned* st) {
    XcdBarrier b; b.bar = bar; b.x = xb_xcc_id(); b.st = st;
    if (threadIdx.x == 0) (void)xb_add(&bar[XB_XCNT(b.x)], 1u);
    return b;
}
__device__ __forceinline__ void xcd_barrier_complete(unsigned* bar, unsigned x, unsigned& nloc, unsigned& nx) {
    const unsigned G = gridDim.x * gridDim.y * gridDim.z;
    unsigned sum, cnt, mine, sp = 0u;
    for (;;) {
        sum = 0u; cnt = 0u; mine = 0u;
#pragma unroll
        for (unsigned j = 0; j < 16; ++j) { const unsigned c = xb_ld(&bar[XB_XCNT(j)]); sum += c; cnt += (c > 0u) ? 1u : 0u; mine = (j == x) ? c : mine; }
        if (sum == G) break;
        __builtin_amdgcn_s_sleep(1);
        if ((++sp & 255u) == 0u) { if (xb_ld(&bar[XB_TMO])) break; if (sp > XB_SPIN_CAP) { atomicAdd(&bar[XB_TMO], 1u); break; } }
    }
    nloc = mine > 0u ? mine : 1u; nx = cnt > 0u ? cnt : 1u;
}
__device__ __forceinline__ void xcd_barrier(const XcdBarrier& b_in, const int sw) {
    asm volatile("s_waitcnt vmcnt(0)" ::: "memory");
    __syncthreads();
    XcdBarrier b = b_in;
    asm volatile("" : "+s"(b.bar), "+s"(b.x));
    if (ltid(sw) == 0) {
        unsigned* bar = b.bar;
        __builtin_amdgcn_s_waitcnt(0);
        unsigned nloc = b.st[0], nx = b.st[1];
        if (nloc == 0u) { xcd_barrier_complete(bar, b.x, nloc, nx); b.st[0] = nloc; b.st[1] = nx; }
        const unsigned old = xb_add(&bar[XB_XSUB(b.x)], 1u);
        const unsigned gen = old / nloc;
        if (old + 1u == (gen + 1u) * nloc) {
            __builtin_amdgcn_fence(__ATOMIC_RELEASE, "agent");
            asm volatile("s_waitcnt vmcnt(0)" ::: "memory");
            const unsigned og = xb_add(&bar[XB_TOP], 1u);
            const unsigned tg = og / nx;
            if (og + 1u == (tg + 1u) * nx) xb_add(&bar[XB_TOPGEN], 1u);
            else XB_SPIN(xb_ld(&bar[XB_TOPGEN]) == tg, bar);
            __builtin_amdgcn_fence(__ATOMIC_ACQUIRE, "agent");
            xb_add(&bar[XB_XGEN(b.x)], 1u);
            asm volatile("s_waitcnt vmcnt(0)" ::: "memory");
        } else {
            XB_SPIN(xb_ld(&bar[XB_XGEN(b.x)]) == gen, bar);
            __builtin_amdgcn_fence(__ATOMIC_ACQUIRE, "agent");
            asm volatile("s_waitcnt vmcnt(0)" ::: "memory");
        }
    }
    __syncthreads();
}

#define RUNB(PH, l) { run_phase<PH>(p, l, smem, sw); if ((PROBE_MASK >> PH) & 1) run_phase<PH>(p, l, smem, sw); xcd_barrier(bar, sw); if (PROBE_MASK & 0x1000000) xcd_barrier(bar, sw); }
__global__ void __launch_bounds__(NT, 2) k_mega(Params p) {
    extern __shared__ __attribute__((aligned(16))) unsigned char smem[];
    const int sw = __builtin_amdgcn_readfirstlane((int)(threadIdx.x >> 6));
    volatile LAS unsigned* xbw = (volatile LAS unsigned*)((LAS unsigned char*)smem + LDS_BYTES - 16);
    if (threadIdx.x == 0) { xbw[0] = 0u; xbw[1] = 0u; xbw[2] = 0u; xbw[3] = 0u; }
    __syncthreads();
    XcdBarrier bar = xcd_barrier_post((unsigned*)(p.ws + O_BAR), xbw);
    RUNB(PH_P0, 0)
    for (int l = 0; l < DEPTH; ++l) {
        RUNB(PH_NORM1, l)
        RUNB(PH_WIN, l)
        RUNB(PH_PREP, l)
        RUNB(PH_MIX, l)
        RUNB(PH_READOUT, l)
        RUNB(PH_MERGE, l)
        RUNB(PH_WOUT, l)
        RUNB(PH_NORM2, l)
        RUNB(PH_GATHER, l)
        RUNB(PH_MOE1, l)
        RUNB(PH_MOE2, l)
    }
    run_phase<PH_FINAL>(p, 0, smem, sw);
}
#endif
}

extern "C" void kernel_launch(void* const* d_in, const int* in_sizes, int n_in, void* d_out, int out_size, void* d_ws, size_t ws_size, hipStream_t stream) {
    Params p{};
    for (int i = 0; i < N_IN; ++i) p.in[i] = (const float*)d_in[i];
    p.out = (float*)d_out;
    p.ws = (unsigned char*)d_ws;
    (void)in_sizes; (void)n_in; (void)out_size;
    if (ws_size < O_END) return;
#ifndef EMU
    static int grid = 0;
    if (!grid) {
        int dev = 0, cus = 0, per_cu = 0;
        (void)hipGetDevice(&dev);
        (void)hipDeviceGetAttribute(&cus, hipDeviceAttributeMultiprocessorCount, dev);
        (void)hipFuncSetAttribute((const void*)k_mega, hipFuncAttributeMaxDynamicSharedMemorySize, LDS_BYTES);
        (void)hipOccupancyMaxActiveBlocksPerMultiprocessor(&per_cu, (const void*)k_mega, NT, LDS_BYTES);
        (void)hipGetLastError();
        grid = cus;
    }
    (void)hipMemsetAsync(p.ws, 0, ZERO_BYTES, stream);
    hipLaunchKernelGGL(k_mega, dim3(grid), dim3(NT), LDS_BYTES, stream, p);
#else
    memset(p.ws, 0, ZERO_BYTES);
    const int G = 64;
#define LAUNCH(PH, l) emu::launch([=] { k_phase<PH>(p, l); }, dim3(G), dim3(NT))
    LAUNCH(PH_P0, 0);
    for (int l = 0; l < DEPTH; ++l) {
        LAUNCH(PH_NORM1, l); LAUNCH(PH_WIN, l); LAUNCH(PH_PREP, l); LAUNCH(PH_MIX, l); LAUNCH(PH_READOUT, l);
        LAUNCH(PH_MERGE, l); LAUNCH(PH_WOUT, l); LAUNCH(PH_NORM2, l); LAUNCH(PH_GATHER, l); LAUNCH(PH_MOE1, l); LAUNCH(PH_MOE2, l);
    }
    LAUNCH(PH_FINAL, 0);
#endif
}
```

```cpp
#ifndef EMU
#include <hip/hip_runtime.h>
#endif
#include <stdint.h>
#include <stddef.h>

#ifndef CFG_D
#define CFG_D 2048
#define CFG_B 4
#define CFG_L 2048
#define CFG_C 256
#endif
#ifndef PROBE_MASK
#define PROBE_MASK 0
#endif
#ifdef EMU
#define LAS
#else
#define LAS __attribute__((address_space(3)))
#endif
namespace {
constexpr int D = CFG_D, NB = CFG_B, L = CFG_L, C = CFG_C, DEPTH = 2;
constexpr int TC = NB * C, TL = NB * L, T = TC + TL;
constexpr int PGD = D / 16, PW = 4 * PGD;
constexpr int RH = D / 256, RW = RH * 64, DL = D / 32, IL = D / 32, GL = D / 16, RC = 3 * RW + DL + IL + GL;
constexpr int QH = D / 256, KVH = QH / 4, AW = QH * 128, KVW = KVH * 128;
constexpr int IN_DIM = PW + RC + AW + 2 * KVW + 3 * D;
constexpr int OFF_XA = 0, OFF_RW = PW, OFF_Q = PW + RC, OFF_K = OFF_Q + AW, OFF_V = OFF_K + KVW, OFF_GA = OFF_V + KVW, OFF_GB = OFF_GA + D, OFF_GC = OFF_GB + D;
constexpr int DE = D / 4, NE = 32;
constexpr float NORM_EPS = 1e-6f, GN_EPS = 64e-5f;
constexpr int NT = 512, NW = NT / 64;
constexpr int LDS_BYTES = 147456;
static_assert(T % 256 == 0 && TC % 256 == 0 && IN_DIM % 256 == 0 && D % 256 == 0, "tile shapes");

typedef unsigned short bf16_t;
enum { IX = 0, IC, ICTX, ICCTX, IMODW, IMODB, INORM1, IWIN, IPOOLW, IPOOLS, IMU, IDW0, IDUP, IA0, IAUP, IGUP, IKK, IKA, IRK, ILNG, ILNB, ISINK, IPP, IPR, IPA, IWOUT, INORM2, IRGW, IRGB, IREW, IREB, IEWG, IEWU, IEWD, IFG, N_IN };

struct Params { const float* in[N_IN]; float* out; unsigned char* ws; int sw, pad; };

constexpr size_t A256(size_t x) { return (x + 255) & ~(size_t)255; }
constexpr size_t O_BAR = 0;
constexpr size_t O_ECNT = 16384;
constexpr size_t ZERO_BYTES = O_ECNT + 1024;
constexpr int UW = OFF_GA;
constexpr int KCAT = PW + RW + AW;
constexpr int RPAD = 2 * T + NE * 256;
constexpr size_t MAXS(size_t a, size_t b) { return a > b ? a : b; }
constexpr size_t O_X = ZERO_BYTES;
constexpr size_t O_MOD = O_X + A256((size_t)T * D * 4);
constexpr size_t O_HB = O_MOD + A256((size_t)DEPTH * (NB + 1) * 6 * D * 4);
constexpr size_t O_MBB = O_HB, O_H2B = O_HB;
constexpr size_t O_U = O_HB + A256((size_t)T * D * 2);
constexpr size_t O_POOLED = O_U + A256((size_t)T * UW * 4);
constexpr size_t O_LP = O_POOLED;
constexpr size_t O_WRT = O_LP + A256((size_t)DEPTH * NW * 12 * 4 * 1024);
constexpr int LKS = 12;
constexpr size_t O_QB = O_POOLED + A256((size_t)T * PW * 4);
static_assert(O_WRT + (size_t)DEPTH * (4 + NE) * D * 4 <= O_QB, "LoRA fragments and router table must fit the former pooled buffer");
constexpr size_t O_QRB = O_QB + A256((size_t)T * AW * 2);
constexpr size_t O_KB = O_QRB + A256((size_t)TL * AW * 2);
constexpr size_t O_VB = O_KB + A256((size_t)T * KVW * 2);
constexpr size_t O_KR = O_VB + A256((size_t)T * KVW * 2);
constexpr size_t O_RA = O_KR;
constexpr size_t O_V = O_RA;
constexpr size_t O_G = O_V + A256((size_t)T * RW * 4);
constexpr size_t O_BON = O_G + A256((size_t)T * RW * 4);
constexpr size_t O_Y = O_BON + A256((size_t)T * RH * 4);
constexpr size_t O_PACK = O_Y + A256((size_t)2 * T * RW * 4);
constexpr int REC = 1536;
constexpr size_t PACK_BYTES = (size_t)2 * T * RH * REC;
constexpr size_t O_RA_END1 = O_PACK + A256(PACK_BYTES);
constexpr size_t O_H2G = O_RA;
constexpr size_t O_ACTB = O_H2G + A256((size_t)RPAD * D * 2);
constexpr size_t O_YSB = O_ACTB + A256((size_t)RPAD * DE * 2);
constexpr size_t O_RA_END2 = O_YSB + A256((size_t)2 * T * D * 2);
constexpr size_t O_SG = MAXS(O_RA_END1, O_RA_END2);
constexpr size_t O_OCAT = O_SG + A256((size_t)T * 3 * D * 2);
constexpr size_t O_WTP = O_OCAT + A256((size_t)T * KCAT * 2);
constexpr size_t O_SLOTOF = O_WTP + A256((size_t)RPAD * 4);
constexpr size_t O_POS = O_SLOTOF + A256((size_t)RPAD * 4);
constexpr size_t O_EWT = O_POS + A256((size_t)2 * T * 4);
constexpr size_t O_EID = O_EWT + A256((size_t)2 * T * 4);
constexpr size_t O_ROPE = O_EID + A256((size_t)2 * T * 4);
constexpr size_t O_PWS = O_ROPE + A256((size_t)L * 128 * 4);
constexpr size_t O_WINT = O_PWS + A256((size_t)DEPTH * 4 * PGD * PGD * 4);
constexpr size_t O_WMT = O_WINT + A256((size_t)DEPTH * IN_DIM * D * 2);
constexpr size_t O_WOT = O_WMT + A256((size_t)DEPTH * D * KCAT * 2);
constexpr size_t O_EGU = O_WOT + A256((size_t)DEPTH * D * D * 2);
constexpr size_t O_ED = O_EGU + A256((size_t)DEPTH * NE * 2 * DE * D * 2);
constexpr size_t O_END = O_ED + A256((size_t)DEPTH * NE * D * DE * 2);
#define WSF(off) ((float*)(p.ws + (off)))
#define WSI(off) ((int*)(p.ws + (off)))
#define WSH(off) ((bf16_t*)(p.ws + (off)))

__device__ __forceinline__ float sigmoidf_(float x) { return 1.0f / (1.0f + expf(-x)); }
__device__ __forceinline__ float siluf_(float x) { return x * sigmoidf_(x); }
__device__ __forceinline__ float softplusf_(float x) { return fmaxf(x, 0.0f) + log1pf(expf(-fabsf(x))); }
#ifdef EMU
__device__ __forceinline__ bf16_t f2bf(float f) { unsigned u; __builtin_memcpy(&u, &f, 4); u += 0x7FFFu + ((u >> 16) & 1u); return (bf16_t)(u >> 16); }
__device__ __forceinline__ unsigned cvt_pk_bf16(float lo, float hi) { return (unsigned)f2bf(lo) | ((unsigned)f2bf(hi) << 16); }
#else
typedef float cv_f32x2 __attribute__((ext_vector_type(2)));
typedef __bf16 cv_bf16x2 __attribute__((ext_vector_type(2)));
__device__ __forceinline__ unsigned cvt_pk_bf16(float lo, float hi) { const cv_f32x2 v = {lo, hi}; return __builtin_bit_cast(unsigned, __builtin_convertvector(v, cv_bf16x2)); }
__device__ __forceinline__ bf16_t f2bf(float f) { return (bf16_t)(cvt_pk_bf16(f, 0.f) & 0xffffu); }
#endif
__device__ __forceinline__ float bf2f(bf16_t h) { unsigned u = ((unsigned)h) << 16; float f; __builtin_memcpy(&f, &u, 4); return f; }

__device__ __forceinline__ int ltid(int sw) {
#ifdef EMU
    (void)sw; return threadIdx.x;
#else
    int t;
    asm volatile("v_mbcnt_lo_u32_b32 %0, -1, 0\n\tv_mbcnt_hi_u32_b32 %0, -1, %0" : "=v"(t));
    return t | (sw << 6);
#endif
}
__device__ __forceinline__ void seq_info(int r, int& t, int& len, int& modrow) {
    if (r < TC) { t = r % C; len = C; modrow = NB; }
    else { const int q = r - TC; t = q % L; len = L; modrow = q / L; }
}
__device__ __forceinline__ float lane_xor(float v, int lane, int m) {
#ifdef EMU
    (void)lane; return __shfl_xor(v, m);
#else
    return __builtin_bit_cast(float, __builtin_amdgcn_ds_bpermute((lane ^ m) << 2, __builtin_bit_cast(int, v)));
#endif
}
__device__ __forceinline__ float wave_sum(float v, int lane) {
#pragma unroll
    for (int m = 32; m >= 1; m >>= 1) v += lane_xor(v, lane, m);
    return v;
}
__device__ __forceinline__ float wave_max(float v, int lane) {
#pragma unroll
    for (int m = 32; m >= 1; m >>= 1) v = fmaxf(v, lane_xor(v, lane, m));
    return v;
}
__device__ __forceinline__ float block_sum(float v, float* red, const int TX_) {
    v = wave_sum(v, TX_ & 63);
    __syncthreads();
    if ((TX_ & 63) == 0) red[TX_ >> 6] = v;
    __syncthreads();
    float s = 0.f;
#pragma unroll
    for (int i = 0; i < NW; ++i) s += red[i];
    return s;
}
#define PHASE_FN __device__ __forceinline__
#ifdef EMU
#define WAVE_SYNC() emu::wave_sync()
#define WAVE_FENCE()
#else
#define WAVE_SYNC() asm volatile("" ::: "memory")
#define WAVE_FENCE() asm volatile("" ::: "memory")
#endif
#ifdef EMU
#define ACC_PIN12(a)
#define ACC_PIN6(a)
#else
#define ACC_PIN6(a) asm volatile("" : "+v"((a)[0]), "+v"((a)[1]), "+v"((a)[2]), "+v"((a)[3]), "+v"((a)[4]), "+v"((a)[5]))
#define ACC_PIN12(a) asm volatile("" : "+v"((a)[0]), "+v"((a)[1]), "+v"((a)[2]), "+v"((a)[3]), "+v"((a)[4]), "+v"((a)[5]), "+v"((a)[6]), "+v"((a)[7]), "+v"((a)[8]), "+v"((a)[9]), "+v"((a)[10]), "+v"((a)[11]))
#endif

namespace pg8 {
typedef short bf16x8 __attribute__((ext_vector_type(8)));
typedef float f32x4 __attribute__((ext_vector_type(4)));
typedef unsigned u32x4 __attribute__((ext_vector_type(4)));
typedef unsigned u32x2 __attribute__((ext_vector_type(2)));
constexpr int BM = 256, BK = 64, HALF = 128, HTB = HALF * BK * 2, STAGE_BYTES = 8 * HTB, NXCD = 8, WGM = 8;
__host__ __device__ __forceinline__ int lds_byte(int r, int c) { const int st = (r >> 4) * 2 + (c >> 5), rr = r & 15, cc = c & 31, ob = rr * 64 + cc * 2; return st * 1024 + (ob ^ (((ob >> 9) & 1) << 5)); }
__host__ __device__ __forceinline__ void stage_rc(int b, int& R, int& Cc) { const int st = b / 1024, sb = b % 1024, swz = sb ^ (((sb >> 9) & 1) << 5); R = (st >> 1) * 16 + swz / 64; Cc = (st & 1) * 32 + (swz % 64) / 2; }
__host__ __device__ __forceinline__ int perm32(int rho) { const int n = rho >> 4, i = rho & 15; return 8 * (i >> 2) + 4 * n + (i & 3); }
struct Unit { const char* a; const char* b; int pm, pn; };

#ifdef EMU
#define PG8_GLDS(gp, lp) __builtin_memcpy((unsigned char*)(lp) + (threadIdx.x & 63) * 16, (gp), 16)
#define PG8_WAIT_V(n)
#define PG8_WAIT_L(n)
#define PG8_BAR __syncthreads()
#define PG8_SCHED
#define PG8_PRIO(x)
#define PG8_RFL(x) (x)
#define PG8_MEMFENCE
#define PG8_OPAQUE(x)
#else
#define PG8_GLDS(gp, lp) __builtin_amdgcn_global_load_lds((const unsigned*)(gp), (LAS unsigned*)(lp), 16, 0, 0)
#define PG8_WAIT_V(n) asm volatile("s_waitcnt vmcnt(" #n ")" ::: "memory")
#define PG8_WAIT_L(n) asm volatile("s_waitcnt lgkmcnt(" #n ")" ::: "memory")
#define PG8_BAR __builtin_amdgcn_s_barrier()
#define PG8_SCHED __builtin_amdgcn_sched_barrier(0)
#define PG8_PRIO(x) __builtin_amdgcn_s_setprio(x)
#define PG8_RFL(x) __builtin_amdgcn_readfirstlane(x)
#define PG8_MEMFENCE asm volatile("" ::: "memory")
#define PG8_OPAQUE(x) asm volatile("" : "+v"(x))
#endif

struct DenseOrder {
    static constexpr bool GATHER = false;
    const char* A; const char* Bt; size_t tstepA, tstepB; int nM, nN, nwg, G, c, pm0;
    __device__ void init(const void* A_, int lda, const void* Bt_, int ldb, int pm0_, int nM_, int nN_, int G_, int c_) {
        A = (const char*)A_; Bt = (const char*)Bt_; tstepA = (size_t)BM * lda * 2; tstepB = (size_t)BM * ldb * 2; pm0 = pm0_; nM = nM_; nN = nN_; nwg = nM * nN; G = G_; c = c_; }
    __device__ bool next(int i, Unit& u) const {
        const long Lx = (long)i * G + c; if (Lx >= nwg) return false;
        int wgid = (int)Lx; { const int q = nwg / NXCD, r = nwg % NXCD, xcd = wgid % NXCD, off = wgid / NXCD; wgid = (xcd < r ? xcd * (q + 1) : r * (q + 1) + (xcd - r) * q) + off; }
        const int nig = WGM * nN, gid = wgid / nig, fm = gid * WGM, gsz = (nM - fm) < WGM ? (nM - fm) : WGM;
        u.pm = pm0 + fm + ((wgid % nig) % gsz); u.pn = (wgid % nig) / gsz;
        u.a = A + (size_t)u.pm * tstepA; u.b = Bt + (size_t)u.pn * tstepB; return true;
    }
};

struct WinOrder {
    static constexpr bool GATHER = false;
    DenseOrder lat; const char* A; const char* Bt; size_t tstepA, tstepB; int nlat, nctx, G, c; bool all_ctx;
    __device__ void init(const void* A_, const void* Bt_, int lda, int ldb, int G_, int c_, bool all_ctx_) {
        A = (const char*)A_; Bt = (const char*)Bt_; tstepA = (size_t)BM * lda * 2; tstepB = (size_t)BM * ldb * 2; G = G_; c = c_; all_ctx = all_ctx_;
        lat.init(A_, lda, Bt_, ldb, all_ctx_ ? 0 : TC / BM, all_ctx_ ? T / BM : TL / BM, IN_DIM / BM, G_, c_);
        nlat = lat.nwg; nctx = all_ctx_ ? 0 : (TC / BM) * 7; }
    __device__ bool next(int i, Unit& u) const {
        const long Lx = (long)i * G + c;
        if (Lx < nlat) return lat.next(i, u);
        const int j = (int)(Lx - nlat); if (j >= nctx) return false;
        const int q = j % 7; u.pm = j / 7;
        u.pn = (q < 5) ? (OFF_RW + RW) / BM + q : OFF_K / BM + (q - 5);
        u.a = A + (size_t)u.pm * tstepA; u.b = Bt + (size_t)u.pn * tstepB; return true;
    }
};
template <class Epi, class Sched>
__device__ __forceinline__ void gemm_phase(LAS unsigned char* lds, const int lda, const int ldb, const int K, const Sched& S, const Epi& E, const int TX_) {
    const int tid = TX_, wid = PG8_RFL(tid >> 6), lane = tid & 63, wr = wid >> 2, wc = wid & 3, fr = lane & 15, fq = lane >> 4;
    const int nt = K / BK;
    constexpr bool GA = Sched::GATHER;
    unsigned voffA[2], voffB[2];
    int gaR[2], gaC[2];
#pragma unroll
    for (int i = 0; i < 2; ++i) { int R, Cc; stage_rc(tid * 16 + i * 8192, R, Cc); const int Rb = Epi::PERM ? ((R & ~31) + perm32(R & 31)) : R;
        voffA[i] = (unsigned)(R * lda + Cc) * 2u; voffB[i] = (unsigned)(Rb * ldb + Cc) * 2u; gaR[i] = R; gaC[i] = Cc; }
    unsigned vgc[2][2], vgn[2][2];
#define PG8_GAOFF(dst, pm_) do { if constexpr (GA) { _Pragma("unroll") for (int h_ = 0; h_ < 2; ++h_) _Pragma("unroll") for (int i_ = 0; i_ < 2; ++i_) \
        dst[h_][i_] = (S.src_row((pm_), h_ * HALF + gaR[i_]) * (unsigned)lda + (unsigned)gaC[i_]) * 2u; } } while (0)
#define PG8_STAGE_A(bufoff, gptr, h, nextsel) do { if constexpr (GA) { unsigned vs_[2] = {(nextsel) ? vgn[h][0] : vgc[h][0], (nextsel) ? vgn[h][1] : vgc[h][1]}; PG8_STAGE(bufoff, gptr, vs_); } \
        else { PG8_STAGE(bufoff, (gptr) + (h) * hstepA, voffA); } } while (0)
    const size_t kstep = (size_t)(BK * 2);
    const size_t hstepA = (size_t)HALF * lda * 2, hstepB = (size_t)HALF * ldb * 2;
    const unsigned ldsw = (unsigned)wid * 1024u;
    const int aoff = lds_byte(wr * 64 + fr, fq * 8), boff = lds_byte(wc * 32 + fr, fq * 8);
#define PG8_SA(b, h) (((b) * 2 + (h)) * HTB)
#define PG8_SB(b, h) ((4 + (b) * 2 + (h)) * HTB)
#define PG8_STAGE(bufoff, gbase, voff) do { _Pragma("unroll") for (int _i = 0; _i < 2; ++_i) PG8_GLDS((const char*)(gbase) + (voff)[_i], lds + (bufoff) + ldsw + _i * 8192); } while (0)
#define PG8_LDA(dst, b, h) do { _Pragma("unroll") for (int m = 0; m < 4; ++m) _Pragma("unroll") for (int k = 0; k < 2; ++k) dst[m][k] = *(const LAS bf16x8*)(lds + PG8_SA(b, h) + aoff + m * 2048 + k * 1024); } while (0)
#define PG8_LDB(dst, b, h) do { _Pragma("unroll") for (int n = 0; n < 2; ++n) _Pragma("unroll") for (int k = 0; k < 2; ++k) dst[n][k] = *(const LAS bf16x8*)(lds + PG8_SB(b, h) + boff + n * 2048 + k * 1024); } while (0)
#define PG8_MMA(ai, bj, At, Bt) do { PG8_PRIO(1); _Pragma("unroll") for (int m = 0; m < 4; ++m) _Pragma("unroll") for (int n = 0; n < 2; ++n) _Pragma("unroll") for (int k = 0; k < 2; ++k) \
        acc[ai][bj][m][n] = __builtin_amdgcn_mfma_f32_16x16x32_bf16(Bt[n][k], At[m][k], acc[ai][bj][m][n], 0, 0, 0); PG8_PRIO(0); } while (0)
    Unit cur, nxt; int ui = 0;
    if (!S.next(0, cur)) return;
    f32x4 acc[2][2][4][2];
#pragma unroll
    for (int a = 0; a < 2; ++a)
#pragma unroll
        for (int b = 0; b < 2; ++b)
#pragma unroll
            for (int m = 0; m < 4; ++m)
#pragma unroll
                for (int n = 0; n < 2; ++n) acc[a][b][m][n] = (f32x4){0.f, 0.f, 0.f, 0.f};
    bf16x8 At[4][2], B0[2][2], B1[2][2];
    const char* cA = cur.a; const char* cB = cur.b;
    PG8_GAOFF(vgc, cur.pm);
    PG8_STAGE(PG8_SB(0, 0), cB, voffB); PG8_STAGE_A(PG8_SA(0, 0), cA, 0, false); PG8_STAGE(PG8_SB(0, 1), cB + hstepB, voffB); PG8_STAGE_A(PG8_SA(0, 1), cA, 1, false);
    if (wr == 1) PG8_BAR;
    PG8_WAIT_V(4); PG8_BAR;
    PG8_STAGE(PG8_SB(1, 0), cB + kstep, voffB); PG8_STAGE_A(PG8_SA(1, 0), cA + kstep, 0, false); PG8_STAGE(PG8_SB(1, 1), cB + hstepB + kstep, voffB);
    PG8_WAIT_V(6); PG8_BAR;
    for (;;) {
        const bool has_next = S.next(ui + 1, nxt);
        const char* nA = has_next ? nxt.a : cA; const char* nB = has_next ? nxt.b : cB;
        if (has_next) PG8_GAOFF(vgn, nxt.pm); else { if constexpr (GA) { vgn[0][0] = vgc[0][0]; vgn[0][1] = vgc[0][1]; vgn[1][0] = vgc[1][0]; vgn[1][1] = vgc[1][1]; } }
        int t = 0;
#pragma unroll 1
        for (int seg = 0; seg < Epi::NSEG; ++seg) {
        const int tend = Epi::seg_end(seg, nt);
#pragma unroll 1
        for (; t < tend; t += 2) {
            const bool last = (t == nt - 2);
            const char* a1 = cA + (size_t)(t + 1) * kstep;
            const char* a2 = last ? nA : cA + (size_t)(t + 2) * kstep; const char* b2 = last ? nB : cB + (size_t)(t + 2) * kstep;
            const char* a3 = a2 + kstep; const char* b3 = b2 + kstep;
            PG8_LDB(B0, 0, 0); PG8_SCHED; PG8_LDA(At, 0, 0); PG8_STAGE_A(PG8_SA(1, 1), a1, 1, false);
            PG8_WAIT_L(8); PG8_BAR; PG8_WAIT_L(0); PG8_MMA(0, 0, At, B0); PG8_BAR; PG8_SCHED;
            PG8_LDB(B1, 0, 1); PG8_STAGE(PG8_SB(0, 0), b2, voffB);
            PG8_BAR; PG8_WAIT_L(0); PG8_MMA(0, 1, At, B1); PG8_BAR;
            PG8_LDA(At, 0, 1); PG8_STAGE_A(PG8_SA(0, 0), a2, 0, last);
            PG8_BAR; PG8_WAIT_L(0); PG8_MMA(1, 0, At, B0); PG8_BAR; PG8_SCHED;
            PG8_STAGE(PG8_SB(0, 1), b2 + hstepB, voffB);
            PG8_WAIT_V(6); PG8_BAR; PG8_MMA(1, 1, At, B1); PG8_BAR;
            PG8_LDB(B0, 1, 0); PG8_SCHED; PG8_LDA(At, 1, 0); PG8_STAGE_A(PG8_SA(0, 1), a2, 1, last);
            PG8_WAIT_L(8); PG8_BAR; PG8_WAIT_L(0); PG8_MMA(0, 0, At, B0); PG8_BAR; PG8_SCHED;
            PG8_LDB(B1, 1, 1); PG8_STAGE(PG8_SB(1, 0), b3, voffB);
            PG8_BAR; PG8_WAIT_L(0); PG8_MMA(0, 1, At, B1); PG8_BAR;
            PG8_LDA(At, 1, 1); PG8_STAGE_A(PG8_SA(1, 0), a3, 0, last);
            PG8_BAR; PG8_WAIT_L(0); PG8_MMA(1, 0, At, B0); PG8_BAR; PG8_SCHED;
            PG8_STAGE(PG8_SB(1, 1), b3 + hstepB, voffB);
            PG8_WAIT_V(6); PG8_BAR; PG8_MMA(1, 1, At, B1); PG8_BAR;
        }
        if constexpr (Epi::NSEG > 1) { if (seg + 1 < Epi::NSEG) E.mid(acc, cur, seg, wr, wc, fr, fq); }
        }
        E(acc, cur, wr, wc, fr, fq);
        if (!has_next) break;
#pragma unroll
        for (int a = 0; a < 2; ++a)
#pragma unroll
            for (int b = 0; b < 2; ++b)
#pragma unroll
                for (int m = 0; m < 4; ++m)
#pragma unroll
                    for (int n = 0; n < 2; ++n) acc[a][b][m][n] = (f32x4){0.f, 0.f, 0.f, 0.f};
        cur = nxt; cA = nA; cB = nB; ++ui;
        if constexpr (GA) { vgc[0][0] = vgn[0][0]; vgc[0][1] = vgn[0][1]; vgc[1][0] = vgn[1][0]; vgc[1][1] = vgn[1][1]; }
    }
    PG8_WAIT_V(0);
    if (wr == 0) PG8_BAR;
    PG8_BAR;
#undef PG8_SA
#undef PG8_SB
#undef PG8_STAGE
#undef PG8_STAGE_A
#undef PG8_GAOFF
#undef PG8_LDA
#undef PG8_LDB
#undef PG8_MMA
}

__device__ __forceinline__ unsigned pk_bf16(float lo, float hi) { return cvt_pk_bf16(lo, hi); }
__device__ __forceinline__ float frcp(float x) {
#ifdef EMU
    return 1.0f / x;
#else
    return __builtin_amdgcn_rcpf(x);
#endif
}
__device__ __forceinline__ float fsig(float x) { return frcp(1.0f + __expf(-x)); }

__device__ __forceinline__ float lane_swap1(float v) {
#ifdef EMU
    return __shfl_xor(v, 1);
#else
    return __builtin_bit_cast(float, __builtin_amdgcn_update_dpp(0, __builtin_bit_cast(int, v), 0xB1, 0xf, 0xf, false));
#endif
}
__device__ __forceinline__ f32x4 lane_swap1(f32x4 v) { const float a = v[0], b = v[1], c = v[2], d = v[3]; f32x4 r; r[0] = lane_swap1(a); r[1] = lane_swap1(b); r[2] = lane_swap1(c); r[3] = lane_swap1(d); return r; }
__device__ __forceinline__ void pair_rows(const f32x4& A, const f32x4& B, bool odd, f32x4& S1, f32x4& S2) {
    const f32x4 X = lane_swap1(A), Y = lane_swap1(B);
    S1 = odd ? Y : A; S2 = odd ? B : X;
}
struct EpiWin {
    static constexpr bool PERM = true; static constexpr int NSEG = 1;
    static __device__ __forceinline__ int seg_end(int, int nt) { return nt; }
    float* U; bf16_t* SG;
    __device__ __forceinline__ void operator()(const f32x4 (&acc)[2][2][4][2], const Unit& u, int wr, int wc, int fr_in, int fq_in) const {
        int fr = fr_in, fq = fq_in; PG8_OPAQUE(fr); PG8_OPAQUE(fq);
        const int row0 = u.pm * BM + wr * 64 + fr, col0 = u.pn * BM + wc * 32 + 8 * fq;
        if (u.pn * BM >= OFF_GA) {
#pragma unroll
            for (int ai = 0; ai < 2; ++ai)
#pragma unroll
                for (int m = 0; m < 4; ++m) { bf16_t* rowp = SG + (size_t)(row0 + ai * HALF + m * 16) * (3 * D) + (col0 - OFF_GA);
#pragma unroll
                    for (int bj = 0; bj < 2; ++bj) { const f32x4 v0 = acc[ai][bj][m][0], v1 = acc[ai][bj][m][1]; u32x4 o;
                        o[0] = pk_bf16(fsig(v0[0]), fsig(v0[1])); o[1] = pk_bf16(fsig(v0[2]), fsig(v0[3])); o[2] = pk_bf16(fsig(v1[0]), fsig(v1[1])); o[3] = pk_bf16(fsig(v1[2]), fsig(v1[3]));
                        *(u32x4*)(rowp + bj * HALF) = o; } }
        } else {
            const bool odd = fr & 1;
#pragma unroll
            for (int ai = 0; ai < 2; ++ai)
#pragma unroll
                for (int m = 0; m < 4; ++m) { float* pe = U + (size_t)((row0 + ai * HALF + m * 16) & ~1) * UW + col0 + (odd ? 4 : 0);
#pragma unroll
                    for (int bj = 0; bj < 2; ++bj) { f32x4 S1, S2; pair_rows(acc[ai][bj][m][0], acc[ai][bj][m][1], odd, S1, S2);
                        *(f32x4*)(pe + bj * HALF) = S1; *(f32x4*)(pe + UW + bj * HALF) = S2; } }
        }
    }
};
struct EpiMerge {
    static constexpr bool PERM = true; static constexpr int NSEG = 3;
    static __device__ __forceinline__ int seg_end(int seg, int nt) { return seg == 0 ? PW / BK : (seg == 1 ? (PW + RW) / BK : nt); }
    const bf16_t* SG; bf16_t* O;
    __device__ __forceinline__ void mid(f32x4 (&acc)[2][2][4][2], const Unit& u, int which, int wr, int wc, int fr_in, int fq_in) const {
        int fr = fr_in, fq = fq_in; PG8_OPAQUE(fr); PG8_OPAQUE(fq);
        const int row0 = u.pm * BM + wr * 64 + fr, col0 = u.pn * BM + wc * 32 + 8 * fq;
#pragma unroll
        for (int ai = 0; ai < 2; ++ai)
#pragma unroll
            for (int m = 0; m < 4; ++m) { const bf16_t* rowp = SG + (size_t)(row0 + ai * HALF + m * 16) * (3 * D) + which * D + col0;
#pragma unroll
                for (int bj = 0; bj < 2; ++bj) {
                    const uint4 nu = *(const uint4*)(rowp + bj * HALF), de = *(const uint4*)(rowp + D + bj * HALF);
                    const unsigned nw[4] = {nu.x, nu.y, nu.z, nu.w}, dw[4] = {de.x, de.y, de.z, de.w};
#pragma unroll
                    for (int q = 0; q < 4; ++q) {
                        const float n0 = bf2f((bf16_t)(nw[q] & 0xffffu)), n1 = bf2f((bf16_t)(nw[q] >> 16)), d0 = bf2f((bf16_t)(dw[q] & 0xffffu)), d1 = bf2f((bf16_t)(dw[q] >> 16));
                        acc[ai][bj][m][q >> 1][2 * (q & 1)] *= n0 * frcp(d0); acc[ai][bj][m][q >> 1][2 * (q & 1) + 1] *= n1 * frcp(d1); } }
                PG8_MEMFENCE; }
    }
    __device__ __forceinline__ void operator()(const f32x4 (&acc)[2][2][4][2], const Unit& u, int wr, int wc, int fr_in, int fq_in) const {
        int fr = fr_in, fq = fq_in; PG8_OPAQUE(fr); PG8_OPAQUE(fq);
        const int row0 = u.pm * BM + wr * 64 + fr, col0 = u.pn * BM + wc * 32 + 8 * fq;
#pragma unroll
        for (int ai = 0; ai < 2; ++ai)
#pragma unroll
            for (int m = 0; m < 4; ++m) { const size_t ro = (size_t)(row0 + ai * HALF + m * 16);
#pragma unroll
                for (int bj = 0; bj < 2; ++bj) {
                    const uint4 sc = *(const uint4*)(SG + ro * (3 * D) + 2 * D + col0 + bj * HALF);
                    const unsigned sw[4] = {sc.x, sc.y, sc.z, sc.w}; unsigned ow[4];
#pragma unroll
                    for (int q = 0; q < 4; ++q) { const float s0 = bf2f((bf16_t)(sw[q] & 0xffffu)), s1 = bf2f((bf16_t)(sw[q] >> 16));
                        ow[q] = pk_bf16(acc[ai][bj][m][q >> 1][2 * (q & 1)] * s0, acc[ai][bj][m][q >> 1][2 * (q & 1) + 1] * s1); }
                    *(uint4*)(O + ro * D + col0 + bj * HALF) = make_uint4(ow[0], ow[1], ow[2], ow[3]); }
                PG8_MEMFENCE; }
    }
};
struct EpiWout {
    static constexpr bool PERM = false; static constexpr int NSEG = 1;
    static __device__ __forceinline__ int seg_end(int, int nt) { return nt; }
    float* X; const float* MODL; const float* inC; const float* inX;
    __device__ __forceinline__ void operator()(const f32x4 (&acc)[2][2][4][2], const Unit& u, int wr, int wc, int fr_in, int fq_in) const {
        int fr = fr_in, fq = fq_in; PG8_OPAQUE(fr); PG8_OPAQUE(fq);
        const int row0 = u.pm * BM + wr * 64 + fr, col0 = u.pn * BM + wc * 32 + 4 * fq;
        const int mr = (u.pm < TC / BM) ? NB : (u.pm - TC / BM) / (L / BM);
        const float* g1 = MODL + (size_t)mr * 6 * D + 2 * D + col0;
        f32x4 gv[2][2];
#pragma unroll
        for (int bj = 0; bj < 2; ++bj)
#pragma unroll
            for (int n = 0; n < 2; ++n) gv[bj][n] = *(const f32x4*)(g1 + bj * HALF + n * 16);
#pragma unroll
        for (int ai = 0; ai < 2; ++ai)
#pragma unroll
            for (int m = 0; m < 4; ++m) { const int row = row0 + ai * HALF + m * 16; float* rowp = X + (size_t)row * D + col0;
                const float* srcp = inX ? ((u.pm < TC / BM) ? inC + (size_t)row * D + col0 : inX + (size_t)(row - TC) * D + col0) : rowp;
#pragma unroll
                for (int bj = 0; bj < 2; ++bj)
#pragma unroll
                    for (int n = 0; n < 2; ++n) { *(f32x4*)(rowp + bj * HALF + n * 16) = *(const f32x4*)(srcp + bj * HALF + n * 16) + gv[bj][n] * acc[ai][bj][m][n]; } }
    }
};
struct EpiSwiglu {
    static constexpr bool PERM = true; static constexpr int NSEG = 1;
    static __device__ __forceinline__ int seg_end(int, int nt) { return nt; }
    bf16_t* ACT; const float* WTP;
    __device__ __forceinline__ void operator()(const f32x4 (&acc)[2][2][4][2], const Unit& u, int wr, int wc, int fr_in, int fq_in) const {
        int fr = fr_in, fq = fq_in; PG8_OPAQUE(fr); PG8_OPAQUE(fq);
        const int row0 = u.pm * BM + wr * 64 + fr, col0 = u.pn * HALF + wc * 32 + 8 * fq;
#pragma unroll
        for (int ai = 0; ai < 2; ++ai)
#pragma unroll
            for (int m = 0; m < 4; ++m) { const size_t ro = (size_t)(row0 + ai * HALF + m * 16); const float wt = WTP[ro]; unsigned ow[4];
#pragma unroll
                for (int q = 0; q < 4; ++q) { const int n = q >> 1, j = 2 * (q & 1);
                    const float g0 = acc[ai][0][m][n][j], g1 = acc[ai][0][m][n][j + 1], u0 = acc[ai][1][m][n][j], u1 = acc[ai][1][m][n][j + 1];
                    ow[q] = pk_bf16(g0 * fsig(g0) * u0 * wt, g1 * fsig(g1) * u1 * wt); }
                *(uint4*)(ACT + ro * DE + col0) = make_uint4(ow[0], ow[1], ow[2], ow[3]); PG8_MEMFENCE; }
    }
};
struct EpiDown {
    static constexpr bool PERM = true; static constexpr int NSEG = 1;
    static __device__ __forceinline__ int seg_end(int, int nt) { return nt; }
    bf16_t* YSB; const int* SLOTOF;
    __device__ __forceinline__ void operator()(const f32x4 (&acc)[2][2][4][2], const Unit& u, int wr, int wc, int fr_in, int fq_in) const {
        int fr = fr_in, fq = fq_in; PG8_OPAQUE(fr); PG8_OPAQUE(fq);
        const int row0 = u.pm * BM + wr * 64 + fr, col0 = u.pn * BM + wc * 32 + 8 * fq;
#pragma unroll
        for (int ai = 0; ai < 2; ++ai)
#pragma unroll
            for (int m = 0; m < 4; ++m) { const int slot = SLOTOF[row0 + ai * HALF + m * 16];
                if (slot >= 0) {
#pragma unroll
                    for (int bj = 0; bj < 2; ++bj) { unsigned ow[4];
#pragma unroll
                        for (int q = 0; q < 4; ++q) ow[q] = pk_bf16(acc[ai][bj][m][q >> 1][2 * (q & 1)], acc[ai][bj][m][q >> 1][2 * (q & 1) + 1]);
                        *(uint4*)(YSB + (size_t)slot * D + col0 + bj * HALF) = make_uint4(ow[0], ow[1], ow[2], ow[3]); } }
                PG8_MEMFENCE; }
    }
};
struct MoeOrder {
    static constexpr bool GATHER = false;
    const char* A; const char* Bt; size_t tstepA, estepB, tstepB; int nN, G, c; const LAS int* toff;
    __device__ bool next(int i, Unit& u) const {
        const int Lx = i * G + c; const int total = toff[NE] * nN; if (Lx >= total) return false;
        const int rt = Lx / nN, pn = Lx % nN; int e = 0;
        for (int q = 1; q < NE; ++q) e = (rt >= toff[q]) ? q : e;
        u.pm = rt; u.pn = pn; u.a = A + (size_t)rt * tstepA; u.b = Bt + (size_t)e * estepB + (size_t)pn * tstepB; return true;
    }
};
struct MoeGatherOrder {
    static constexpr bool GATHER = true;
    const char* A; const char* Bt; size_t estepB, tstepB; int nN, G, c; const LAS int* toff; const int* slotof;
    __device__ bool next(int i, Unit& u) const {
        const int Lx = i * G + c; const int total = toff[NE] * nN; if (Lx >= total) return false;
        const int rt = Lx / nN, pn = Lx % nN; int e = 0;
        for (int q = 1; q < NE; ++q) e = (rt >= toff[q]) ? q : e;
        u.pm = rt; u.pn = pn; u.a = A; u.b = Bt + (size_t)e * estepB + (size_t)pn * tstepB; return true;
    }
    __device__ __forceinline__ unsigned src_row(int pm, int r) const { const int sl = slotof[pm * BM + r]; return (unsigned)(sl < 0 ? 0 : (sl >> 1)); }
};
}

__device__ __forceinline__ void conv_tile(const float* src, int ld_src, bf16_t* dst, int ld_dst, int kt, float* lds, const int TX_) {
    const int tid = TX_;
    float* tb = lds;
    __syncthreads();
#pragma unroll
    for (int i = 0; i < 4; ++i) {
        const int idx = tid + i * NT, kr = idx >> 4, c4 = (idx & 15) * 4;
        const float4 v = *(const float4*)(src + (size_t)(kt * 128 + kr) * ld_src + c4);
        tb[kr * 65 + c4] = v.x; tb[kr * 65 + c4 + 1] = v.y; tb[kr * 65 + c4 + 2] = v.z; tb[kr * 65 + c4 + 3] = v.w;
    }
    __syncthreads();
    const int n = tid >> 3, kq = (tid & 7) * 16;
    unsigned w[8];
#pragma unroll
    for (int j = 0; j < 8; ++j) { const unsigned lo = f2bf(tb[(kq + 2 * j) * 65 + n]), hi = f2bf(tb[(kq + 2 * j + 1) * 65 + n]); w[j] = lo | (hi << 16); }
    uint4* dp = (uint4*)(dst + (size_t)n * ld_dst + kt * 128 + kq);
    dp[0] = make_uint4(w[0], w[1], w[2], w[3]); dp[1] = make_uint4(w[4], w[5], w[6], w[7]);
}
PHASE_FN void ph_conv_win0(const Params& p, float* lds) {
    const int TX_ = ltid(p.sw);
    const float* src = p.in[IWIN]; bf16_t* dst = WSH(O_WINT);
    for (int it = blockIdx.x; it < (D / 128) * (IN_DIM / 64); it += gridDim.x) { const int kt = it % (D / 128), nt = it / (D / 128); conv_tile(src + nt * 64, IN_DIM, dst + (size_t)nt * 64 * D, D, kt, lds, TX_); }
    __syncthreads();
}
PHASE_FN void ph_conv_layer(const Params& p, int l, float* lds, bool with_win) {
    const int TX_ = ltid(p.sw);
    const int G = gridDim.x; int base = 0;
#define CONV_JOB(NTILES, ...) { const int start_ = ((int)blockIdx.x - base % G + G) % G; for (int it = start_; it < (NTILES); it += G) { __VA_ARGS__ } base += (NTILES); }
    if (with_win) {
        const float* src = p.in[IWIN] + (size_t)l * D * IN_DIM; bf16_t* dst = WSH(O_WINT) + (size_t)l * IN_DIM * D;
        CONV_JOB((D / 128) * (IN_DIM / 64), { const int kt = it % (D / 128), nt = it / (D / 128); conv_tile(src + nt * 64, IN_DIM, dst + (size_t)nt * 64 * D, D, kt, lds, TX_); })
    }
    {
        bf16_t* dst = WSH(O_WMT) + (size_t)l * D * KCAT;
        const float* s0 = p.in[IPP] + (size_t)l * PW * D; const float* s1 = p.in[IPR] + (size_t)l * RW * D; const float* s2 = p.in[IPA] + (size_t)l * AW * D;
        CONV_JOB((PW / 128) * (D / 64), { const int kt = it % (PW / 128), nt = it / (PW / 128); conv_tile(s0 + nt * 64, D, dst + (size_t)nt * 64 * KCAT, KCAT, kt, lds, TX_); })
        CONV_JOB((RW / 128) * (D / 64), { const int kt = it % (RW / 128), nt = it / (RW / 128); conv_tile(s1 + nt * 64, D, dst + (size_t)nt * 64 * KCAT + PW, KCAT, kt, lds, TX_); })
        CONV_JOB((AW / 128) * (D / 64), { const int kt = it % (AW / 128), nt = it / (AW / 128); conv_tile(s2 + nt * 64, D, dst + (size_t)nt * 64 * KCAT + PW + RW, KCAT, kt, lds, TX_); })
    }
    {
        const float* src = p.in[IWOUT] + (size_t)l * D * D; bf16_t* dst = WSH(O_WOT) + (size_t)l * D * D;
        CONV_JOB((D / 128) * (D / 64), { const int kt = it % (D / 128), nt = it / (D / 128); conv_tile(src + nt * 64, D, dst + (size_t)nt * 64 * D, D, kt, lds, TX_); })
    }
    {
        constexpr int TPE = (D / 128) * (DE / 64);
        CONV_JOB(NE * 2 * TPE, { const int e = it / (2 * TPE), rem = it % (2 * TPE), which = rem / TPE, r2 = rem % TPE, kt = r2 % (D / 128), nt = r2 / (D / 128);
            const float* src = p.in[which ? IEWU : IEWG] + ((size_t)l * NE + e) * D * DE + nt * 64;
            const int drow = (nt >> 1) * 256 + which * 128 + (nt & 1) * 64;
            conv_tile(src, DE, WSH(O_EGU) + (((size_t)l * NE + e) * 2 * DE + drow) * D, D, kt, lds, TX_); })
    }
    {
        constexpr int TPE = (DE / 128) * (D / 64);
        CONV_JOB(NE * TPE, { const int e = it / TPE, r2 = it % TPE, kt = r2 % (DE / 128), nt = r2 / (DE / 128);
            conv_tile(p.in[IEWD] + ((size_t)l * NE + e) * DE * D + nt * 64, D, WSH(O_ED) + (((size_t)l * NE + e) * D + nt * 64) * DE, DE, kt, lds, TX_); })
    }
#undef CONV_JOB
    __syncthreads();
}

PHASE_FN void ph_copy(const Params& p) {
    const int TX_ = ltid(p.sw);
    const int gt = blockIdx.x * NT + TX_, gs = gridDim.x * NT;
    float4* X4 = (float4*)WSF(O_X);
    const float4* c4 = (const float4*)p.in[ICTX]; const float4* x4 = (const float4*)p.in[IX];
    for (long i = gt; i < (long)T * D / 4; i += gs) X4[i] = (i < (long)TC * D / 4) ? c4[i] : x4[i - (long)TC * D / 4];
}
PHASE_FN void ph_rope_table(const Params& p) {
    const int TX_ = ltid(p.sw);
    const int gt = blockIdx.x * NT + TX_, gs = gridDim.x * NT;
    for (int i = gt; i < L * 64; i += gs) {
        const int t = i >> 6, j = i & 63, ax = j >> 5, f = j & 31;
        const float inv = powf(10000.0f, -(float)(2 * f) / 64.0f);
        const float ang = (ax == 0 ? (float)(t / 64) : (float)(t % 64)) * inv;
        WSF(O_ROPE)[(size_t)t * 128 + j] = cosf(ang); WSF(O_ROPE)[(size_t)t * 128 + 64 + j] = sinf(ang);
    }
}
PHASE_FN void ph_pws(const Params& p) {
    const int TX_ = ltid(p.sw);
    for (int i = blockIdx.x * NT + TX_; i < DEPTH * 4 * PGD * PGD; i += gridDim.x * NT) {
        const int d = i % PGD, g = (i / (PGD * PGD)) % 4, l = i / (4 * PGD * PGD);
        WSF(O_PWS)[i] = p.in[IPOOLW][i] * p.in[IPOOLS][l * PW + g * PGD + d];
    }
}
PHASE_FN void ph_lora_pack(const Params& p) {
    const int TX_ = ltid(p.sw);
    const float* pgu = p.in[IGUP]; const float* pdu = p.in[IDUP]; const float* pau = p.in[IAUP];
#ifndef EMU
    asm volatile("" : "+s"(pgu), "+s"(pdu), "+s"(pau));
#endif
    for (int i = blockIdx.x * NT + TX_; i < DEPTH * NW * LKS * 4 * 64; i += gridDim.x * NT) {
        const int lane = i & 63, nt = (i >> 6) & 3, ks = (i >> 8) % LKS, w = (i / (256 * LKS)) % NW, l = i / (256 * LKS * NW);
        const int ch = w * 64 + (lane & 15) * 4 + nt;
        const float* src; int k0;
        if (ks < 4) { src = pgu + (size_t)l * GL * RW; k0 = ks * 32; }
        else if (ks < 8) { src = pdu + (size_t)(l * 2 + ((ks - 4) >> 1)) * DL * RW; k0 = ((ks - 4) & 1) * 32; }
        else { src = pau + (size_t)(l * 2 + ((ks - 8) >> 1)) * IL * RW; k0 = ((ks - 8) & 1) * 32; }
        k0 += (lane >> 4) * 8;
        const float* q = src + (size_t)k0 * RW + ch;
        const float x0 = q[0], x1 = q[RW], x2 = q[2 * RW], x3 = q[3 * RW], x4 = q[4 * RW], x5 = q[5 * RW], x6 = q[6 * RW], x7 = q[7 * RW];
        const bf16_t h0 = f2bf(x0), h1 = f2bf(x1), h2 = f2bf(x2), h3 = f2bf(x3), h4 = f2bf(x4), h5 = f2bf(x5), h6 = f2bf(x6), h7 = f2bf(x7);
        uint4 hi;
        hi.x = (unsigned)h0 | ((unsigned)h1 << 16); hi.y = (unsigned)h2 | ((unsigned)h3 << 16); hi.z = (unsigned)h4 | ((unsigned)h5 << 16); hi.w = (unsigned)h6 | ((unsigned)h7 << 16);
        ((uint4*)(p.ws + O_LP + (size_t)(i >> 6) * 1024))[lane] = hi;
    }
}
PHASE_FN void ph_router_pack(const Params& p) {
    const int TX_ = ltid(p.sw);
    for (int i = blockIdx.x * NT + TX_; i < DEPTH * (4 + NE) * D; i += gridDim.x * NT) {
        const int k = i % D, q = (i / D) % (4 + NE), l = i / (D * (4 + NE));
        WSF(O_WRT)[i] = (q < 4) ? p.in[IRGW][((size_t)l * D + k) * 4 + q] : p.in[IREW][((size_t)l * D + k) * NE + (q - 4)];
    }
}
PHASE_FN void ph_mod(const Params& p, float* lds) {
    const int TX_ = ltid(p.sw);
    float* sl = lds;
    float* red = lds + (NB + 1) * D;
    const int tid = TX_, kg = tid >> 3, cq = tid & 7;
    const int nitems = DEPTH * 6 * D / 32;
    if ((int)blockIdx.x < nitems) {
        for (int i = tid; i < (NB + 1) * D; i += NT) sl[i] = siluf_(i < NB * D ? p.in[IC][i] : p.in[ICCTX][i - NB * D]);
        __syncthreads();
        for (int it = blockIdx.x; it < nitems; it += gridDim.x) {
            const int l = it / (6 * D / 32), n0 = (it % (6 * D / 32)) * 32;
            float acc[NB + 1][4];
#pragma unroll
            for (int j = 0; j <= NB; ++j)
#pragma unroll
                for (int q = 0; q < 4; ++q) acc[j][q] = 0.f;
            const float* w = p.in[IMODW] + (size_t)l * D * 6 * D + n0 + cq * 4;
#pragma unroll 1
            for (int k0 = kg; k0 < D; k0 += 64 * 8) {
                float4 wv[8];
#pragma unroll
                for (int u = 0; u < 8; ++u) wv[u] = *(const float4*)(w + (size_t)(k0 + 64 * u) * 6 * D);
#pragma unroll
                for (int u = 0; u < 8; ++u)
#pragma unroll
                    for (int j = 0; j <= NB; ++j) { const float sv = sl[j * D + k0 + 64 * u]; acc[j][0] += sv * wv[u].x; acc[j][1] += sv * wv[u].y; acc[j][2] += sv * wv[u].z; acc[j][3] += sv * wv[u].w; }
            }
            __syncthreads();
#pragma unroll
            for (int j = 0; j <= NB; ++j)
#pragma unroll
                for (int q = 0; q < 4; ++q) red[(kg * (NB + 1) + j) * 32 + cq * 4 + q] = acc[j][q];
            __syncthreads();
            if (tid < (NB + 1) * 32) {
                const int j = tid / 32, cc = tid % 32;
                float sum = 0.f;
                for (int g = 0; g < 64; ++g) sum += red[(g * (NB + 1) + j) * 32 + cc];
                WSF(O_MOD)[((size_t)l * (NB + 1) + j) * 6 * D + n0 + cc] = sum + p.in[IMODB][l * 6 * D + n0 + cc];
            }
        }
    }
    __syncthreads();
}
PHASE_FN void ph_norm1(const Params& p, int l, int mode, bool dry = false) {
    const int TX_ = ltid(p.sw);
    const int wave = TX_ >> 6, lane = TX_ & 63;
    const int r_begin = (mode == 2) ? TC : 0;
    const int lp = (mode == 2) ? DEPTH - 1 : l - 1;
    for (int r = r_begin + blockIdx.x * NW + wave; r < T; r += gridDim.x * NW) {
        int t, len, mr; seq_info(r, t, len, mr);
        float* xr = WSF(O_X) + (size_t)r * D;
        const float* xsrc = (mode == 0 && l == 0) ? ((r < TC) ? p.in[ICTX] + (size_t)r * D : p.in[IX] + (size_t)(r - TC) * D) : xr;
        const bool comb = (lp >= 0) && (lp != DEPTH - 1 || r >= TC);
        float4 v[D / 256];
        float ss = 0.f;
#pragma unroll
        for (int i = 0; i < D / 256; ++i) {
            const int c = (i * 64 + lane) * 4;
            float4 x = *(const float4*)(xsrc + c);
            if (comb) {
                const float4 g2 = *(const float4*)(WSF(O_MOD) + ((size_t)lp * (NB + 1) + mr) * 6 * D + 5 * D + c);
                const uint2 y0 = *(const uint2*)(WSH(O_YSB) + (size_t)(2 * r) * D + c), y1 = *(const uint2*)(WSH(O_YSB) + (size_t)(2 * r + 1) * D + c);
                x.x += g2.x * (bf2f((bf16_t)(y0.x & 0xffffu)) + bf2f((bf16_t)(y1.x & 0xffffu))); x.y += g2.y * (bf2f((bf16_t)(y0.x >> 16)) + bf2f((bf16_t)(y1.x >> 16)));
                x.z += g2.z * (bf2f((bf16_t)(y0.y & 0xffffu)) + bf2f((bf16_t)(y1.y & 0xffffu))); x.w += g2.w * (bf2f((bf16_t)(y0.y >> 16)) + bf2f((bf16_t)(y1.y >> 16)));
                if (!dry) *(float4*)(xr + c) = x;
            }
            v[i] = x; ss += x.x * x.x + x.y * x.y + x.z * x.z + x.w * x.w;
        }
        ss = wave_sum(ss, lane);
        const float rs = rsqrtf(ss / (float)D + NORM_EPS);
#pragma unroll
        for (int i = 0; i < D / 256; ++i) {
            const int c = (i * 64 + lane) * 4;
            if (mode == 2) {
                const float4 g = *(const float4*)(p.in[IFG] + c);
                *(float4*)(p.out + (size_t)(r - TC) * D + c) = make_float4(v[i].x * rs * g.x, v[i].y * rs * g.y, v[i].z * rs * g.z, v[i].w * rs * g.w);
            } else {
                const float* md = WSF(O_MOD) + ((size_t)l * (NB + 1) + mr) * 6 * D;
                const float4 g = *(const float4*)(p.in[INORM1] + l * D + c), sh = *(const float4*)(md + c), sc = *(const float4*)(md + D + c);
                const float h0 = (v[i].x * rs * g.x) * (1.0f + sc.x) + sh.x, h1 = (v[i].y * rs * g.y) * (1.0f + sc.y) + sh.y;
                const float h2 = (v[i].z * rs * g.z) * (1.0f + sc.z) + sh.z, h3 = (v[i].w * rs * g.w) * (1.0f + sc.w) + sh.w;
                uint2 o; o.x = (unsigned)f2bf(h0) | ((unsigned)f2bf(h1) << 16); o.y = (unsigned)f2bf(h2) | ((unsigned)f2bf(h3) << 16);
                *(uint2*)(WSH(O_HB) + (size_t)r * D + c) = o;
            }
        }
    }
}

constexpr int GT_M = NT / 4;
__device__ __forceinline__ void gemm_tile(const float* A, int lda, const int* aidx, int ashift, int mvalid, int m0, const float* B, int ldb, int n0, int K, float (&acc)[4][4], float* lds, const int TX_) {
    float* As = lds;
    float* Bs = lds + 16 * (GT_M + 4);
    const int tid = TX_, tx = tid & 15, ty = tid >> 4;
    const int ar = tid >> 2, ak = (tid & 3) * 4;
    const int bk = (tid & 255) >> 4, bn = (tid & 15) * 4;
    const bool avalid = (m0 + ar) < mvalid;
    long arow = 0;
    if (avalid) arow = aidx ? (long)(aidx[m0 + ar] >> ashift) : (long)(m0 + ar);
    const float* ap = A + arow * lda + ak;
    const float* bp = B + (size_t)bk * ldb + n0 + bn;
    for (int k0 = 0; k0 < K; k0 += 16) {
        float a0 = 0.f, a1 = 0.f, a2 = 0.f, a3 = 0.f;
        if (avalid) { a0 = ap[k0]; a1 = ap[k0 + 1]; a2 = ap[k0 + 2]; a3 = ap[k0 + 3]; }
        float b0 = 0.f, b1 = 0.f, b2 = 0.f, b3 = 0.f;
        if (tid < 256) { const float* bq = bp + (size_t)k0 * ldb; b0 = bq[0]; b1 = bq[1]; b2 = bq[2]; b3 = bq[3]; }
        __syncthreads();
        As[ak * (GT_M + 4) + ar] = a0; As[(ak + 1) * (GT_M + 4) + ar] = a1; As[(ak + 2) * (GT_M + 4) + ar] = a2; As[(ak + 3) * (GT_M + 4) + ar] = a3;
        if (tid < 256) { Bs[bk * 68 + bn] = b0; Bs[bk * 68 + bn + 1] = b1; Bs[bk * 68 + bn + 2] = b2; Bs[bk * 68 + bn + 3] = b3; }
        __syncthreads();
#pragma unroll
        for (int k = 0; k < 16; ++k) {
            float a[4], b[4];
#pragma unroll
            for (int i = 0; i < 4; ++i) { a[i] = As[k * (GT_M + 4) + 4 * ty + i]; b[i] = Bs[k * 68 + 4 * tx + i]; }
#pragma unroll
            for (int i = 0; i < 4; ++i)
#pragma unroll
                for (int j = 0; j < 4; ++j) acc[i][j] += a[i] * b[j];
        }
    }
    __syncthreads();
}
#define ZERO_ACC(a) { _Pragma("unroll") for (int i_ = 0; i_ < 4; ++i_) _Pragma("unroll") for (int j_ = 0; j_ < 4; ++j_) a[i_][j_] = 0.f; }

PHASE_FN void ph_fold(const Params& p, int l, float* lds) {
    const int TX_ = ltid(p.sw);
    const int tx = TX_ & 15, ty = TX_ >> 4;
    static_assert(PGD == GT_M, "fold tile");
    for (int it = blockIdx.x; it < 4 * (D / 64); it += gridDim.x) {
        const int g = it / (D / 64), n0 = (it % (D / 64)) * 64;
        float acc[4][4]; ZERO_ACC(acc);
        gemm_tile(WSF(O_PWS) + ((size_t)l * 4 + g) * PGD * PGD, PGD, nullptr, 0, PGD, 0, p.in[IPP] + ((size_t)l * PW + g * PGD) * D, D, n0, PGD, acc, lds, TX_);
#pragma unroll
        for (int i = 0; i < 4; ++i)
#pragma unroll
            for (int j = 0; j < 4; ++j) WSH(O_WMT)[(size_t)l * D * KCAT + (size_t)(n0 + 4 * tx + j) * KCAT + g * PGD + 4 * ty + i] = f2bf(acc[i][j]);
    }
}
PHASE_FN void ph_win(const Params& p, int l, LAS unsigned char* lds) {
    static_assert((OFF_RW + RW) % 256 == 0 && (OFF_RW + RC) % 256 == 0 && OFF_K % 256 == 0 && KVW == 256, "column tiles of the context-only subset");
    pg8::WinOrder S; S.init(WSH(O_HB), WSH(O_WINT) + (size_t)l * IN_DIM * D, D, D, gridDim.x, blockIdx.x, l != DEPTH - 1);
    pg8::EpiWin E{WSF(O_U), WSH(O_SG)};
    pg8::gemm_phase<pg8::EpiWin, pg8::WinOrder>(lds, D, D, D, S, E, ltid(p.sw));
}

__device__ __forceinline__ float dpp_sum16(float v);
#ifdef EMU
__device__ __forceinline__ float wave_total63(float v) { for (int m = 32; m >= 1; m >>= 1) v += __shfl_xor(v, m); return v; }
__device__ __forceinline__ float wave_bcast63(float v) { return __shfl(v, 63); }
#else
template <int CTRL, int RMASK> __device__ __forceinline__ float dpp_mov_rm(float v) { return __builtin_bit_cast(float, __builtin_amdgcn_update_dpp(0, __builtin_bit_cast(int, v), CTRL, RMASK, 0xf, false)); }
__device__ __forceinline__ float wave_total63(float v) {
    v = dpp_sum16(v); v += dpp_mov_rm<0x142, 0xa>(v); v += dpp_mov_rm<0x143, 0xc>(v); return v;
}
__device__ __forceinline__ float wave_bcast63(float v) { return __builtin_bit_cast(float, __builtin_amdgcn_readlane(__builtin_bit_cast(int, v), 63)); }
#endif
#ifdef EMU
struct BufRsrc { const char* p; };
__device__ __forceinline__ BufRsrc make_rsrc(const void* p, size_t) { return BufRsrc{(const char*)p}; }
__device__ __forceinline__ float buf_load4(BufRsrc r, int voff, int soff) { return *(const float*)(r.p + voff + soff); }
__device__ __forceinline__ pg8::bf16x8 buf_load16(BufRsrc r, int voff, int soff) { return *(const pg8::bf16x8*)(r.p + voff + soff); }
#else
typedef __amdgpu_buffer_rsrc_t BufRsrc;
__device__ __forceinline__ BufRsrc make_rsrc(const void* p, size_t bytes) { return __builtin_amdgcn_make_buffer_rsrc((void*)p, 0, (int)bytes, 0x00020000); }
__device__ __forceinline__ float buf_load4(BufRsrc r, int voff, int soff) { return __builtin_bit_cast(float, __builtin_amdgcn_raw_buffer_load_b32(r, voff, soff, 0)); }
__device__ __forceinline__ pg8::bf16x8 buf_load16(BufRsrc r, int voff, int soff) { return __builtin_bit_cast(pg8::bf16x8, __builtin_amdgcn_raw_buffer_load_b128(r, voff, soff, 0)); }
#endif
constexpr int PR = 9;
constexpr int LAS_A = 264;
static_assert(DL == 64 && IL == 64 && GL == 128 && RC == 3 * RW + 256, "LoRA geometry");
static_assert(RW == NT, "prep geometry");
PHASE_FN void ph_prep(const Params& p, int l, float* lds) {
    const int TX_ = ltid(p.sw);
    float* us = lds;
    bf16_t* Ahi = (bf16_t*)(us + PR * RC);
    bf16_t* Alo = Ahi + 16 * LAS_A;
    const int tid0 = TX_;
    for (int i = tid0; i < 16 * LAS_A; i += NT) { Ahi[i] = 0; Alo[i] = 0; }
    const float* U = WSF(O_U);
    const float* mu = p.in[IMU] + l * RC;
    for (int grp = blockIdx.x; grp < (T + PR - 1) / PR; grp += gridDim.x) {
        const int r0 = grp * PR, nr = min(PR, T - r0);
        int tid = tid0; PG8_OPAQUE(tid);
        const int lane = tid & 63;
        __syncthreads();
#if PROBE_MASK & 0x10000000
        for (int rep1_ = 0; rep1_ < 2; ++rep1_) {
        PG8_OPAQUE(rep1_);
#endif
        {
            const int ch = tid, gi = ch / PGD, hw = 1 << gi;
            float xv[PR + 16];
#pragma unroll
            for (int q = 0; q < PR + 16; ++q) { const int row = r0 - 8 + q; xv[q] = (row >= 0 && row < T) ? U[(size_t)row * UW + OFF_XA + ch] : 0.f; }
#pragma unroll
            for (int rr = 0; rr < PR; ++rr) if (rr < nr) {
                const int r = r0 + rr; int t, len, mr; seq_info(r, t, len, mr);
                float sacc = 0.f;
#pragma unroll
                for (int dq = -8; dq < 8; ++dq) { const int tt = t + dq; const bool ok = dq >= -hw && dq < hw && tt >= 0 && tt < len; sacc += ok ? xv[8 + rr + dq] : 0.f; }
                const int lo = max(t - hw, 0), hi = min(t + hw, len);
                WSH(O_OCAT)[(size_t)r * KCAT + ch] = f2bf(sacc * pg8::frcp((float)(hi - lo)) - xv[8 + rr]);
            }
        }
        WAVE_FENCE();
        for (int q = tid; q < PR * (QH + KVH) * 8; q += NT) {
            const int fo = q & 3, ax = (q >> 2) & 1, hh = (q >> 3) % (QH + KVH), rr = q / (8 * (QH + KVH)), e1 = ax * 64 + fo * 8;
            const int soff = (hh < QH) ? (OFF_Q + hh * 128) : (OFF_K + (hh - QH) * 128);
            if (rr < nr) {
                const int r = r0 + rr; int t, len, mr; seq_info(r, t, len, mr); const bool lat = r >= TC;
                const float* src = U + (size_t)r * UW + soff + e1;
                const pg8::f32x4 xa0 = *(const pg8::f32x4*)src, xa1 = *(const pg8::f32x4*)(src + 4), xb0 = *(const pg8::f32x4*)(src + 32), xb1 = *(const pg8::f32x4*)(src + 36);
                const float* rt = WSF(O_ROPE) + (size_t)(lat ? t : 0) * 128 + ax * 32 + fo * 8;
                const pg8::f32x4 c0 = *(const pg8::f32x4*)rt, c1 = *(const pg8::f32x4*)(rt + 4), s0 = *(const pg8::f32x4*)(rt + 64), s1 = *(const pg8::f32x4*)(rt + 68);
                pg8::f32x4 ya0 = xa0, ya1 = xa1, yb0 = xb0, yb1 = xb1;
                if (lat) { ya0 = xa0 * c0 - xb0 * s0; ya1 = xa1 * c1 - xb1 * s1; yb0 = xa0 * s0 + xb0 * c0; yb1 = xa1 * s1 + xb1 * c1; }
#define PK8(lo_, hi_) pg8::u32x4{pg8::pk_bf16((lo_)[0], (lo_)[1]), pg8::pk_bf16((lo_)[2], (lo_)[3]), pg8::pk_bf16((hi_)[0], (hi_)[1]), pg8::pk_bf16((hi_)[2], (hi_)[3])}
                if (hh < QH) {
                    bf16_t* qu = WSH(O_QB) + (size_t)r * AW + hh * 128 + e1; *(pg8::u32x4*)qu = PK8(xa0, xa1); *(pg8::u32x4*)(qu + 32) = PK8(xb0, xb1);
                    if (lat) { bf16_t* qr = WSH(O_QRB) + (size_t)(r - TC) * AW + hh * 128 + e1; *(pg8::u32x4*)qr = PK8(ya0, ya1); *(pg8::u32x4*)(qr + 32) = PK8(yb0, yb1); }
                } else {
                    bf16_t* kd = WSH(O_KB) + (size_t)r * KVW + (hh - QH) * 128 + e1; *(pg8::u32x4*)kd = PK8(ya0, ya1); *(pg8::u32x4*)(kd + 32) = PK8(yb0, yb1);
                }
#undef PK8
            }
        }
        WAVE_FENCE();
#pragma unroll 2
        for (int i = tid; i < nr * (KVW / 4); i += NT) {
            const int rr = i / (KVW / 4), c4 = (i % (KVW / 4)) * 4, r = r0 + rr;
            const float4 v = *(const float4*)(U + (size_t)r * UW + OFF_V + c4);
            uint2 o; o.x = pg8::pk_bf16(v.x, v.y); o.y = pg8::pk_bf16(v.z, v.w);
            *(uint2*)(WSH(O_VB) + (size_t)r * KVW + c4) = o;
        }
        WAVE_FENCE();
        if (tid < RC / 4) {
            const int c4 = tid * 4;
            float4 uv[PR + 2];
#pragma unroll
            for (int q = 0; q < PR + 2; ++q) { const int row = r0 - 1 + q; uv[q] = (row >= 0 && row < T) ? *(const float4*)(U + (size_t)row * UW + OFF_RW + c4) : make_float4(0.f, 0.f, 0.f, 0.f); }
            const float4 m4 = *(const float4*)(mu + c4);
#pragma unroll
            for (int rr = 0; rr < PR; ++rr) if (rr < nr) {
                const int r = r0 + rr; int t, len, mr; seq_info(r, t, len, mr);
                const float4 u0 = uv[rr + 1];
                const float4 up = (t > 0) ? uv[rr] : make_float4(0.f, 0.f, 0.f, 0.f), un = (t < len - 1) ? uv[rr + 2] : make_float4(0.f, 0.f, 0.f, 0.f);
                float* d = us + rr * RC + c4;
                d[0] = u0.x + m4.x * (0.5f * (up.x + un.x) - u0.x); d[1] = u0.y + m4.y * (0.5f * (up.y + un.y) - u0.y);
                d[2] = u0.z + m4.z * (0.5f * (up.z + un.z) - u0.z); d[3] = u0.w + m4.w * (0.5f * (up.w + un.w) - u0.w);
            }
        }
#if PROBE_MASK & 0x10000000
        }
#endif
        __syncthreads();
        for (int i = tid; i < PR * 256; i += NT) {
            const int rr = i >> 8, j = i & 255;
            const float v = (rr < nr) ? us[rr * RC + 3 * RW + j] : 0.f;
            const float tv = (j < DL) ? 1.0f - 2.0f * pg8::frcp(1.0f + __expf(2.0f * v)) : ((j < DL + IL) ? v : pg8::fsig(v));
            const bf16_t h = f2bf(tv);
            const int ar = 4 * (rr / 3) + rr % 3;
            Ahi[ar * LAS_A + j] = h; Alo[ar * LAS_A + j] = f2bf(tv - bf2f(h));
        }
        __syncthreads();
#ifdef EMU
        const int hd = tid >> 6;
#else
        const int hd = p.sw;
#endif
        const int mrow = lane & 15, kg = lane >> 4;
        pg8::f32x4 aG[4], aW0[4], aW1[4], aA0[4], aA1[4];
#pragma unroll
        for (int nt = 0; nt < 4; ++nt) {
            const int chn = hd * 64 + 4 * mrow + nt;
            const float w00 = p.in[IDW0][(l * 2 + 0) * RW + chn], w01 = p.in[IDW0][(l * 2 + 1) * RW + chn], a00 = p.in[IA0][(l * 2 + 0) * RW + chn], a01 = p.in[IA0][(l * 2 + 1) * RW + chn];
            aG[nt] = pg8::f32x4{0.f, 0.f, 0.f, 0.f}; aW0[nt] = pg8::f32x4{w00, w00, w00, w00}; aW1[nt] = pg8::f32x4{w01, w01, w01, w01};
            aA0[nt] = pg8::f32x4{a00, a00, a00, a00}; aA1[nt] = pg8::f32x4{a01, a01, a01, a01};
        }
        {
            const BufRsrc rlp = make_rsrc(p.ws + O_LP + (size_t)(l * NW + hd) * LKS * 4 * 1024, (size_t)LKS * 4 * 1024);
            const int vo = lane * 16;
            const bf16_t* arow_h = Ahi + mrow * LAS_A + kg * 8; const bf16_t* arow_l = Alo + mrow * LAS_A + kg * 8;
            pg8::bf16x8 bh[2][4];
#pragma unroll
            for (int nt = 0; nt < 4; ++nt) bh[0][nt] = buf_load16(rlp, vo, nt * 1024);
#pragma unroll
            for (int ks = 0; ks < LKS; ++ks) {
                const int cur = ks & 1, nxt = cur ^ 1;
                if (ks + 1 < LKS) {
#pragma unroll
                    for (int nt = 0; nt < 4; ++nt) bh[nxt][nt] = buf_load16(rlp, vo, ((ks + 1) * 4 + nt) * 1024);
                }
                const int kb = (ks < 4) ? 128 + 32 * ks : ((ks < 8) ? 32 * ((ks - 4) & 1) : 64 + 32 * ((ks - 8) & 1));
                const pg8::bf16x8 ah = *(const pg8::bf16x8*)(arow_h + kb), al = *(const pg8::bf16x8*)(arow_l + kb);
#pragma unroll
                for (int nt = 0; nt < 4; ++nt) {
                    pg8::f32x4& acc = (ks < 4) ? aG[nt] : ((ks < 6) ? aW0[nt] : ((ks < 8) ? aW1[nt] : ((ks < 10) ? aA0[nt] : aA1[nt])));
                    acc = __builtin_amdgcn_mfma_f32_16x16x32_bf16(ah, bh[cur][nt], acc, 0, 0, 0);
                    acc = __builtin_amdgcn_mfma_f32_16x16x32_bf16(al, bh[cur][nt], acc, 0, 0, 0);
                }
                WAVE_FENCE();
            }
        }
        float ssq[3] = {0.f, 0.f, 0.f}, bsm[3] = {0.f, 0.f, 0.f};
#pragma unroll
        for (int nt = 0; nt < 4; ++nt) {
            const int chn = hd * 64 + 4 * mrow + nt;
            const float kkc = p.in[IKK][l * RW + chn], kac = p.in[IKA][l * RW + chn], rkc = p.in[IRK][l * RW + chn];
#pragma unroll
            for (int i = 0; i < 3; ++i) {
                const int rr = kg * 3 + i;
                const float rv = us[rr * RC + chn], kv = us[rr * RC + RW + chn];
                aW0[nt][i] = __expf(-0.6065306597f * pg8::frcp(1.0f + __expf(-aW0[nt][i]))); aW1[nt][i] = __expf(-0.6065306597f * pg8::frcp(1.0f + __expf(-aW1[nt][i])));
                const float a0 = pg8::fsig(aA0[nt][i]), a1 = pg8::fsig(aA1[nt][i]);
                aA0[nt][i] = a0; aA1[nt][i] = a1;
                const float key0 = kv * (1.0f + (a0 - 1.0f) * kac), key1 = kv * (1.0f + (a1 - 1.0f) * kac);
                const float kkr = kv * kkc;
                ssq[i] += kkr * kkr; bsm[i] += rv * (key0 + key1) * rkc;
            }
        }
#pragma unroll
        for (int i = 0; i < 3; ++i) { ssq[i] = dpp_sum16(ssq[i]); bsm[i] = dpp_sum16(bsm[i]); }
        const int ch4 = hd * 64 + 4 * mrow;
        const pg8::f32x4 kkc4 = *(const pg8::f32x4*)(p.in[IKK] + l * RW + ch4), kac4 = *(const pg8::f32x4*)(p.in[IKA] + l * RW + ch4);
#pragma unroll
        for (int i = 0; i < 3; ++i) {
            const int rr = kg * 3 + i;
            if (kg < 3 && rr < nr) {
                const int r = r0 + rr;
                const float inv = pg8::frcp(fmaxf(sqrtf(ssq[i]), 1e-12f));
                const pg8::f32x4 rv = *(const pg8::f32x4*)(us + rr * RC + ch4), kv = *(const pg8::f32x4*)(us + rr * RC + RW + ch4), vv = *(const pg8::f32x4*)(us + rr * RC + 2 * RW + ch4);
                pg8::f32x4 w0, w1, a0, a1, gg;
#pragma unroll
                for (int nt = 0; nt < 4; ++nt) { w0[nt] = aW0[nt][i]; w1[nt] = aW1[nt][i]; a0[nt] = aA0[nt][i]; a1[nt] = aA1[nt][i]; gg[nt] = aG[nt][i]; }
                const pg8::f32x4 key0 = kv * (1.0f + (a0 - 1.0f) * kac4), key1 = kv * (1.0f + (a1 - 1.0f) * kac4), kn = kv * kkc4 * inv;
                unsigned char* pk0 = p.ws + O_PACK + (((size_t)0 * T + r) * RH + hd) * REC + 16 * mrow;
                unsigned char* pk1 = p.ws + O_PACK + (((size_t)1 * T + r) * RH + hd) * REC + 16 * mrow;
                *(pg8::f32x4*)pk0 = w0; *(pg8::f32x4*)(pk0 + 256) = key0; *(pg8::f32x4*)(pk0 + 512) = kn * a0; *(pg8::f32x4*)(pk0 + 768) = kn;
                *(pg8::f32x4*)(pk0 + 1024) = rv; *(pg8::f32x4*)(pk0 + 1280) = vv;
                *(pg8::f32x4*)pk1 = w1; *(pg8::f32x4*)(pk1 + 256) = key1; *(pg8::f32x4*)(pk1 + 512) = kn * a1; *(pg8::f32x4*)(pk1 + 768) = kn;
                *(pg8::f32x4*)(pk1 + 1024) = rv; *(pg8::f32x4*)(pk1 + 1280) = vv;
                *(pg8::f32x4*)(WSF(O_V) + (size_t)r * RW + ch4) = vv;
                *(pg8::f32x4*)(WSF(O_G) + (size_t)r * RW + ch4) = gg;
                if (mrow == 0) WSF(O_BON)[(size_t)r * RH + hd] = 0.5f * bsm[i];
            }
            WAVE_FENCE();
        }
    }
    __syncthreads();
}

constexpr int SCAN_RING = 16, SCAN_SLOT = REC;
constexpr int SH_ROUNDS = 5;
static_assert(SH_ROUNDS * 16 * SCAN_SLOT + 64 <= LDS_BYTES - 16 && (C % 16) == 0 && ((C + L) % 16) == 0, "shared scan ring");
static_assert((C + L) % SCAN_RING == 0 && C % SCAN_RING == 0 && SCAN_RING == 16, "scan ring depth");
#ifdef EMU
__device__ __forceinline__ float dpp_sum16(float v) { v += __shfl_xor(v, 1); v += __shfl_xor(v, 2); v += __shfl_xor(v, 4); v += __shfl_xor(v, 8); return v; }
static thread_local unsigned char* emu_m0[16];
__device__ __forceinline__ void scan_set_m0(unsigned char* slot) { emu_m0[threadIdx.x >> 6] = slot; }
__device__ __forceinline__ void scan_dma2(int q, BufRsrc rs, int voff, int voffb, int soff_adj) {
    (void)q;
    __builtin_memcpy(emu_m0[threadIdx.x >> 6] + voff, rs.p + soff_adj + voff, 16);
    __builtin_memcpy(emu_m0[threadIdx.x >> 6] + 1024 + 2 * voffb, rs.p + soff_adj + 1024 + 2 * voffb, 8);
}
__device__ __forceinline__ void scan_dma2_settled(BufRsrc rs, int voff, int voffb, int soff_adj) { scan_dma2(0, rs, voff, voffb, soff_adj); }
#define SCAN_WAIT(n) emu::wave_sync()
#define SH_RELAX() emu::yield()
#define SH_FENCE() ((void)0)
#define SCAN_SGPR_SETTLE(rs_, so_) ((void)0)
__device__ __forceinline__ float row_push(float keep, float v, int kq) { const float up = __shfl(keep, (int)(threadIdx.x & 63) - 1); return kq ? up : v; }
__device__ __forceinline__ void scan_store(float* q, float v) { *q = v; }
#else
template <int CTRL> __device__ __forceinline__ float dpp_mov(float v) { return __builtin_bit_cast(float, __builtin_amdgcn_update_dpp(0, __builtin_bit_cast(int, v), CTRL, 0xf, 0xf, false)); }
__device__ __forceinline__ float dpp_sum16(float v) {
    v += dpp_mov<0xB1>(v); v += dpp_mov<0x4E>(v); v += dpp_mov<0x141>(v); v += dpp_mov<0x140>(v); return v;
}
__device__ __forceinline__ void scan_set_m0(LAS unsigned char* slot) { const unsigned dst = (unsigned)(uintptr_t)slot; asm volatile("s_mov_b32 m0, %0\n\ts_nop 0" :: "s"(dst) : "memory", "m0"); }
__device__ __forceinline__ void scan_dma2_settled(BufRsrc rs, int voff, int voffb, int soff_adj) {
    asm volatile("s_nop 4\n\tbuffer_load_dwordx4 %0, %2, %3 offen lds\n\tbuffer_load_dword %1, %2, %3 offen offset:1024 lds\n\tbuffer_load_dword %1, %2, %3 offen offset:1280 lds" :: "v"(voff), "v"(voffb), "s"(rs), "s"(soff_adj) : "memory");
}
__device__ __forceinline__ void scan_dma2(int q, BufRsrc rs, int voff, int voffb, int soff_adj) {
    (void)q;
    asm volatile("buffer_load_dwordx4 %0, %2, %3 offen lds\n\tbuffer_load_dword %1, %2, %3 offen offset:1024 lds\n\tbuffer_load_dword %1, %2, %3 offen offset:1280 lds" :: "v"(voff), "v"(voffb), "s"(rs), "s"(soff_adj) : "memory");
}
#define SCAN_WAIT(n) asm volatile("s_waitcnt vmcnt(" #n ")" ::: "memory")
#define SH_RELAX() __builtin_amdgcn_s_sleep(1)
#define SH_FENCE() asm volatile("" ::: "memory")
#define SCAN_SGPR_SETTLE(rs_, so_) asm volatile("s_nop 4" :: "s"(rs_), "s"(so_) : "memory")
__device__ __forceinline__ float row_push(float keep, float v, int) {
    return __builtin_bit_cast(float, __builtin_amdgcn_update_dpp(__builtin_bit_cast(int, v), __builtin_bit_cast(int, keep), 0x111, 0xf, 0xf, false));
}
__device__ __forceinline__ void scan_store(float* q, float v) { asm volatile("global_store_dword %0, %1, off" :: "v"(q), "v"(v) : "memory"); }
#endif
__device__ __forceinline__ int scan_row(int s, int d, int b) {
    const int in_ctx = s < C;
    const int len = in_ctx ? C : L, base = in_ctx ? b * C : TC + b * L, t = in_ctx ? s : s - C;
    return base + (d == 0 ? t : len - 1 - t);
}
struct ScanOps { pg8::f32x4 w, k, b, kk, r; float v; };
__device__ __forceinline__ pg8::f32x4 bf4_to_f32(pg8::u32x2 q) {
    pg8::f32x4 o; o[0] = __builtin_bit_cast(float, q[0] << 16); o[1] = __builtin_bit_cast(float, q[0] & 0xffff0000u); o[2] = __builtin_bit_cast(float, q[1] << 16); o[3] = __builtin_bit_cast(float, q[1] & 0xffff0000u); return o;
}
__device__ __forceinline__ ScanOps scan_read(const LAS unsigned char* slot, int kq, int vrow) {
    ScanOps o;
    o.w = *(const LAS pg8::f32x4*)(slot + kq * 16); o.k = *(const LAS pg8::f32x4*)(slot + 256 + kq * 16); o.b = *(const LAS pg8::f32x4*)(slot + 512 + kq * 16); o.kk = *(const LAS pg8::f32x4*)(slot + 768 + kq * 16);
    o.r = *(const LAS pg8::f32x4*)(slot + 1024 + kq * 16);
    o.v = *(const LAS float*)(slot + 1280 + vrow * 4); return o;
}
struct ConvTile { const float* src; bf16_t* dst; int ld_src, ld_dst; };
__device__ __forceinline__ int conv_total(int l) {
    return (KCAT / 64) * (D / 64) + (D / 64) * (D / 64) + NE * 2 * (D / 64) * (DE / 64) + NE * (DE / 64) * (D / 64) + ((l + 1 < DEPTH) ? (D / 64) * (IN_DIM / 64) : 0);
}
__device__ __forceinline__ ConvTile conv_tile_of(const Params& p, int l, int it) {
    ConvTile c;
    const float* ppp = p.in[IPP]; const float* ppr = p.in[IPR]; const float* ppa = p.in[IPA]; const float* pwg = p.in[IEWG]; const float* pwu = p.in[IEWU];
#ifndef EMU
    asm volatile("" : "+s"(ppp), "+s"(ppr), "+s"(ppa), "+s"(pwg), "+s"(pwu));
#endif
    constexpr int N0 = (PW / 64) * (D / 64), N1 = N0 + (RW / 64) * (D / 64), N2 = N1 + (AW / 64) * (D / 64), N3 = N2 + (D / 64) * (D / 64);
    constexpr int TPE1 = (D / 64) * (DE / 64), N4 = N3 + NE * 2 * TPE1, TPE2 = (DE / 64) * (D / 64), N5 = N4 + NE * TPE2;
    if (it < N2) {
        const int j = it < N0 ? it : (it < N1 ? it - N0 : it - N1);
        const int nk = it < N0 ? PW / 64 : (it < N1 ? RW / 64 : AW / 64), koff = it < N0 ? 0 : (it < N1 ? PW : PW + RW);
        const float* sb = it < N0 ? ppp + (size_t)l * PW * D : (it < N1 ? ppr + (size_t)l * RW * D : ppa + (size_t)l * AW * D);
        const int kt = j % nk, nt = j / nk;
        c.src = sb + (size_t)kt * 64 * D + nt * 64; c.ld_src = D; c.dst = WSH(O_WMT) + (size_t)l * D * KCAT + (size_t)nt * 64 * KCAT + koff + kt * 64; c.ld_dst = KCAT;
    } else if (it < N3) {
        const int j = it - N2, kt = j % (D / 64), nt = j / (D / 64);
        c.src = p.in[IWOUT] + (size_t)l * D * D + (size_t)kt * 64 * D + nt * 64; c.ld_src = D; c.dst = WSH(O_WOT) + (size_t)l * D * D + (size_t)nt * 64 * D + kt * 64; c.ld_dst = D;
    } else if (it < N4) {
        const int j = it - N3, e = j / (2 * TPE1), rem = j % (2 * TPE1), which = rem / TPE1, r2 = rem % TPE1, kt = r2 % (D / 64), nt = r2 / (D / 64);
        c.src = (which ? pwu : pwg) + ((size_t)l * NE + e) * D * DE + (size_t)kt * 64 * DE + nt * 64; c.ld_src = DE;
        const int drow = (nt >> 1) * 256 + which * 128 + (nt & 1) * 64;
        c.dst = WSH(O_EGU) + (((size_t)l * NE + e) * 2 * DE + drow) * D + kt * 64; c.ld_dst = D;
    } else if (it < N5) {
        const int j = it - N4, e = j / TPE2, r2 = j % TPE2, kt = r2 % (DE / 64), nt = r2 / (DE / 64);
        c.src = p.in[IEWD] + ((size_t)l * NE + e) * DE * D + (size_t)kt * 64 * D + nt * 64; c.ld_src = D; c.dst = WSH(O_ED) + (((size_t)l * NE + e) * D + nt * 64) * DE + kt * 64; c.ld_dst = DE;
    } else {
        const int j = it - N5, kt = j % (D / 64), nt = j / (D / 64);
        c.src = p.in[IWIN] + (size_t)(l + 1) * D * IN_DIM + (size_t)kt * 64 * IN_DIM + nt * 64; c.ld_src = IN_DIM; c.dst = WSH(O_WINT) + (size_t)(l + 1) * IN_DIM * D + (size_t)nt * 64 * D + kt * 64; c.ld_dst = D;
    }
    return c;
}
__device__ __forceinline__ void conv_load(const ConvTile& c, int lane, float (&v)[64]) {
    const BufRsrc rs = make_rsrc(c.src, (size_t)64 * c.ld_src * 4);
#pragma unroll
    for (int k = 0; k < 64; ++k) v[k] = buf_load4(rs, lane * 4, k * c.ld_src * 4);
}
__device__ __forceinline__ void conv_emit(const ConvTile& c, int lane, const float (&v)[64]) {
#ifdef EMU
    bf16_t* q = c.dst + (size_t)lane * c.ld_dst;
#pragma unroll
    for (int j = 0; j < 8; ++j)
        *(uint4*)(q + 8 * j) = make_uint4(pg8::pk_bf16(v[8 * j], v[8 * j + 1]), pg8::pk_bf16(v[8 * j + 2], v[8 * j + 3]), pg8::pk_bf16(v[8 * j + 4], v[8 * j + 5]), pg8::pk_bf16(v[8 * j + 6], v[8 * j + 7]));
#else
    const BufRsrc rd = make_rsrc(c.dst, (size_t)64 * c.ld_dst * 2);
    const int vo = lane * c.ld_dst * 2;
#pragma unroll
    for (int j = 0; j < 8; ++j) {
        pg8::u32x4 w; w[0] = pg8::pk_bf16(v[8 * j], v[8 * j + 1]); w[1] = pg8::pk_bf16(v[8 * j + 2], v[8 * j + 3]); w[2] = pg8::pk_bf16(v[8 * j + 4], v[8 * j + 5]); w[3] = pg8::pk_bf16(v[8 * j + 6], v[8 * j + 7]);
        __builtin_amdgcn_raw_buffer_store_b128(w, rd, vo + 16 * j, 0, 0);
    }
#endif
}
__device__ __forceinline__ void conv_role(const Params& p, int l, int cw, int ncw, int lane) {
    constexpr int NFOLD = (PW / 64) * (D / 64);
    const int total = conv_total(l);
    cw += NFOLD;
    while (cw >= NFOLD + ncw) cw -= ncw;
    if (cw >= total) return;
    float va[64], vb[64];
    ConvTile ca = conv_tile_of(p, l, cw);
    conv_load(ca, lane, va);
#pragma unroll 1
    for (int it = cw; it < total; it += ncw) {
        const int nx = it + ncw;
        const ConvTile cb = conv_tile_of(p, l, nx < total ? nx : it);
        conv_load(cb, lane, vb);
        conv_emit(ca, lane, va);
        ca = cb;
#pragma unroll
        for (int i = 0; i < 64; ++i) va[i] = vb[i];
    }
}
PHASE_FN void ph_scan(const Params& p, int l, LAS unsigned char* lds) {
    (void)l;
    const int TX_ = ltid(p.sw);
#ifdef EMU
    const int wave = TX_ >> 6;
#else
    const int wave = p.sw;
#endif
    const int lane = TX_ & 63, g = lane >> 4, kq = lane & 15;
    constexpr int NS = C + L, nitems = 2 * NB * RH * 16;
    const BufRsrc rs = make_rsrc((const unsigned char*)WSF(O_PACK) - 4096, PACK_BYTES + 4096);
    volatile LAS int* flg = (volatile LAS int*)(lds + SH_ROUNDS * 16 * SCAN_SLOT);
    if (TX_ < 8) flg[TX_] = 0;
    __syncthreads();
    if (wave < 4) {
        LAS unsigned char* ring = lds + wave * (SCAN_RING * SCAN_SLOT);
        const bool xcd_deal = (gridDim.x % 8 == 0) && (nitems % (8 * 16) == 0) && (gridDim.x * 4 == nitems);
        if (xcd_deal) {
            constexpr int NR = NS / 16;
            const int x = blockIdx.x % 8, slot = (blockIdx.x / 8) * 4 + wave;
            const int item = (x + 8 * (slot >> 4)) * 16 + (slot & 15);
            const int chain = item >> 4, rg = item & 15;
            const int d = chain / (NB * RH), b = (chain / RH) % NB, h = chain % RH;
            const int vrow = rg * 4 + g;
            const int dstep = (d == 0 ? 1 : -1) * RH * REC;
#define SCAN_SOFF(s) ((int)((((size_t)d * T + scan_row((s), d, b)) * RH + h) * REC))
            const int voff = lane * 16, voffb = lane * 4;
#define SH_ISSUE(q_, phq_) { int so_ = SCAN_SOFF(16 * (q_) + wave) + 4096; SCAN_SGPR_SETTLE(rs, so_); LAS unsigned char* sb_ = lds + (((phq_) * 16 + wave) * SCAN_SLOT); \
                _Pragma("unroll") for (int k_ = 0; k_ < 4; ++k_) { scan_set_m0(sb_ + k_ * 4 * SCAN_SLOT); scan_dma2_settled(rs, voff, voffb, so_); so_ += 4 * dstep; } }
#define SH_SPIN(needl_, needc_) { unsigned sp_ = 0; for (;;) { const int l0_ = flg[0], l1_ = flg[1], l2_ = flg[2], l3_ = flg[3], c0_ = flg[4], c1_ = flg[5], c2_ = flg[6], c3_ = flg[7]; \
                if ((min(min(l0_, l1_), min(l2_, l3_)) >= (needl_) && min(min(c0_, c1_), min(c2_, c3_)) >= (needc_)) || ++sp_ > (1u << 20)) break; SH_RELAX(); } SH_FENCE(); }
            SH_ISSUE(0, 0) SH_ISSUE(1, 1) SH_ISSUE(2, 2)
            SCAN_WAIT(0);
            SH_FENCE();
            if (lane == 0) flg[wave] = 3;
            float S0 = 0.f, S1 = 0.f, S2 = 0.f, S3 = 0.f;
            float* Yb = WSF(O_Y) + (size_t)d * T * RW + h * 64 + vrow;
            SH_SPIN(1, -1)
            ScanOps cur = scan_read(lds, kq, vrow);
            float yprev = 0.f, ykA = 0.f;
            int ph = 0;
#pragma unroll 1
            for (int r = 0; r < NR; ++r) {
                SH_FENCE();
                if (lane == 0) flg[4 + wave] = r;
                SH_SPIN(min(r + 2, NR), r - 1)
                const int ph3 = (ph + 3 >= SH_ROUNDS) ? ph + 3 - SH_ROUNDS : ph + 3;
                if (r + 3 < NR) { SH_ISSUE(r + 3, ph3) SCAN_WAIT(12); } else { SCAN_WAIT(0); }
                SH_FENCE();
                if (lane == 0) flg[wave] = min(r + 3, NR);
                const int phn = (ph + 1 >= SH_ROUNDS) ? 0 : ph + 1;
                const LAS unsigned char* rb = lds + ph * 16 * SCAN_SLOT;
                const LAS unsigned char* rbn = lds + phn * 16 * SCAN_SLOT;
                const int s0 = r * 16;
#pragma unroll
                for (int j = 0; j < 16; ++j) {
                    const ScanOps nxt = scan_read(j < 15 ? rb + (j + 1) * SCAN_SLOT : rbn, kq, vrow);
                    float dot = S0 * cur.kk[0] + S1 * cur.kk[1] + S2 * cur.kk[2] + S3 * cur.kk[3];
                    const float cv = cur.v; const pg8::f32x4 cr = cur.r;
                    const float t0 = S0 * cur.w[0] + cv * cur.k[0], t1 = S1 * cur.w[1] + cv * cur.k[1], t2 = S2 * cur.w[2] + cv * cur.k[2], t3 = S3 * cur.w[3] + cv * cur.k[3];
                    dot = dpp_sum16(dot);
                    const float yred = dpp_sum16(yprev);
                    ykA = row_push(ykA, yred, kq);
                    S0 = t0 - dot * cur.b[0]; S1 = t1 - dot * cur.b[1]; S2 = t2 - dot * cur.b[2]; S3 = t3 - dot * cur.b[3];
                    yprev = S0 * cr[0] + S1 * cr[1] + S2 * cr[2] + S3 * cr[3];
                    cur = nxt;
                }
                {
                    const int sa = s0 + 14 - kq;
                    if (sa >= 0) scan_store(Yb + (size_t)scan_row(sa, d, b) * RW, ykA);
                }
                ph = phn;
            }
            scan_store(Yb + (size_t)scan_row(NS - 1, d, b) * RW, dpp_sum16(yprev));
            SCAN_WAIT(0);
#undef SCAN_SOFF
#undef SH_ISSUE
#undef SH_SPIN
        }
#if PROBE_MASK & 0x200000
        for (int rep_ = 0; rep_ < 2; ++rep_)
#endif
        for (int it0 = xcd_deal ? nitems : wave * gridDim.x + blockIdx.x; it0 < nitems; it0 += 4 * gridDim.x) {
            int item = it0;
            if (xcd_deal) { const int x = blockIdx.x % 8, slot = (blockIdx.x / 8) * 4 + wave;
                item = (x + 8 * (slot >> 4)) * 16 + (slot & 15); }
            const int chain = item >> 4, rg = item & 15;
            const int d = chain / (NB * RH), b = (chain / RH) % NB, h = chain % RH;
            const int vrow = rg * 4 + g;
            const int dstep = (d == 0 ? 1 : -1) * RH * REC;
#define SCAN_SOFF(s) ((int)((((size_t)d * T + scan_row((s), d, b)) * RH + h) * REC))
            const int voff = lane * 16;
            const int dstepA = dstep - SCAN_SLOT, dstepB = dstep + 2 * SCAN_SLOT;
            const int voffb = lane * 4;
            {
                int so = SCAN_SOFF(0) + 4096;
                SCAN_SGPR_SETTLE(rs, so);
#pragma unroll
                for (int j = 0; j < SCAN_RING; ++j) { scan_set_m0(ring + j * SCAN_SLOT); scan_dma2(0, rs, voff, voffb, so); so += dstep; }
            }
            float S0 = 0.f, S1 = 0.f, S2 = 0.f, S3 = 0.f;
            float* Yb = WSF(O_Y) + (size_t)d * T * RW + h * 64 + vrow;
            SCAN_WAIT(45);
            ScanOps cur = scan_read(ring, kq, vrow);
            float yprev = 0.f, ykA = 0.f;
#pragma unroll 1
            for (int s0 = 0; s0 < NS; s0 += SCAN_RING) {
                const int sn0 = (s0 + SCAN_RING < NS) ? s0 + SCAN_RING : s0;
                int so = SCAN_SOFF(sn0) + 4096;
                SCAN_SGPR_SETTLE(rs, so);
#pragma unroll
                for (int j = 0; j < SCAN_RING; ++j) {
                    SCAN_WAIT(42);
                    const ScanOps nxt = scan_read(ring + ((j + 1) % SCAN_RING) * SCAN_SLOT, kq, vrow);
                    float dot = S0 * cur.kk[0] + S1 * cur.kk[1] + S2 * cur.kk[2] + S3 * cur.kk[3];
                    const float cv = cur.v; const pg8::f32x4 cr = cur.r;
                    const float t0 = S0 * cur.w[0] + cv * cur.k[0], t1 = S1 * cur.w[1] + cv * cur.k[1], t2 = S2 * cur.w[2] + cv * cur.k[2], t3 = S3 * cur.w[3] + cv * cur.k[3];
                    dot = dpp_sum16(dot);
                    const float yred = dpp_sum16(yprev);
                    ykA = row_push(ykA, yred, kq);
                    S0 = t0 - dot * cur.b[0]; S1 = t1 - dot * cur.b[1]; S2 = t2 - dot * cur.b[2]; S3 = t3 - dot * cur.b[3];
                    yprev = S0 * cr[0] + S1 * cr[1] + S2 * cr[2] + S3 * cr[3];
                    scan_set_m0(ring + j * SCAN_SLOT);
                    scan_dma2(0, rs, voff, voffb, so); so += dstep;
                    cur = nxt;
                }
                {
                    const int sa = s0 + 14 - kq;
                    if (sa >= 0) scan_store(Yb + (size_t)scan_row(sa, d, b) * RW, ykA);
                }
            }
            scan_store(Yb + (size_t)scan_row(NS - 1, d, b) * RW, dpp_sum16(yprev));
            SCAN_WAIT(0);
#undef SCAN_SOFF
        }
#if PROBE_MASK & 0x4000000
        __syncthreads();
#endif
    } else {
#if PROBE_MASK & 0x4000000
        __syncthreads();
#endif
        conv_role(p, l, (int)blockIdx.x * 4 + (wave - 4), (int)gridDim.x * 4, lane);
#if PROBE_MASK & 0x100000
        conv_role(p, l, (int)blockIdx.x * 4 + (wave - 4), (int)gridDim.x * 4, lane);
#endif
    }
    __syncthreads();
}

PHASE_FN void ph_readout(const Params& p, int l) {
    static_assert(RW == 512 && RH == 8, "readout geometry");
    const int TX_ = ltid(p.sw);
    const int wave = TX_ >> 6, lane = TX_ & 63;
    for (int r = blockIdx.x * NW + wave; r < T; r += gridDim.x * NW) {
        pg8::f32x4 y[2], vv[2], gg[2];
#pragma unroll
        for (int j = 0; j < 2; ++j) { const size_t o = (size_t)r * RW + j * 256 + lane * 4;
            y[j] = *(const pg8::f32x4*)(WSF(O_Y) + o) + *(const pg8::f32x4*)(WSF(O_Y) + (size_t)T * RW + o); vv[j] = *(const pg8::f32x4*)(WSF(O_V) + o); gg[j] = *(const pg8::f32x4*)(WSF(O_G) + o); }
#pragma unroll
        for (int j = 0; j < 2; ++j) { const int ch = j * 256 + lane * 4;
            const float mean = dpp_sum16(y[j][0] + y[j][1] + y[j][2] + y[j][3]) * (1.0f / 64.0f);
            const pg8::f32x4 dv = y[j] - mean;
            const float var = dpp_sum16(dv[0] * dv[0] + dv[1] * dv[1] + dv[2] * dv[2] + dv[3] * dv[3]) * (1.0f / 64.0f);
            const float rs = rsqrtf(var + GN_EPS), bon = WSF(O_BON)[(size_t)r * RH + (ch >> 6)];
            const pg8::f32x4 lg = *(const pg8::f32x4*)(p.in[ILNG] + l * RW + ch), lb = *(const pg8::f32x4*)(p.in[ILNB] + l * RW + ch);
            const pg8::f32x4 o4 = (dv * rs * lg + lb + bon * vv[j]) * gg[j];
            pg8::u32x2 w2; w2[0] = pg8::pk_bf16(o4[0], o4[1]); w2[1] = pg8::pk_bf16(o4[2], o4[3]);
            *(pg8::u32x2*)(WSH(O_OCAT) + (size_t)r * KCAT + PW + ch) = w2; }
    }
}

constexpr int AT_KS = 272, AT_VS = 144, AT_PS = 144;
constexpr int AT_K = 0, AT_V = 64 * AT_KS, AT_P = AT_V + 128 * AT_VS, AT_ST = AT_P + NW * 32 * AT_PS;
typedef float f32x16 __attribute__((ext_vector_type(16)));
struct AttnRegs { pg8::u32x4 k[2], v[2]; };
template <bool WITHV> __device__ __forceinline__ void attn_load(const Params& p, AttnRegs& r, int krow0, int rlo, int rhi, int kvh, int tid) {
#pragma unroll
    for (int i = 0; i < 2; ++i) {
        const int chunk = tid + i * NT, key = chunk >> 4, part = chunk & 15;
        int row = krow0 + key; row = row < rlo ? rlo : (row > rhi ? rhi : row);
        r.k[i] = *(const pg8::u32x4*)(WSH(O_KB) + (size_t)row * KVW + kvh * 128 + part * 8);
        if (WITHV) {
            const int keyv = chunk & 63, partv = chunk >> 6;
            int rowv = krow0 + keyv; rowv = rowv < rlo ? rlo : (rowv > rhi ? rhi : rowv);
            r.v[i] = *(const pg8::u32x4*)(WSH(O_VB) + (size_t)rowv * KVW + kvh * 128 + partv * 8);
        }
    }
}
template <bool WITHV> __device__ __forceinline__ void attn_store(LAS unsigned char* lds, const AttnRegs& r, int tid) {
#pragma unroll
    for (int i = 0; i < 2; ++i) {
        const int chunk = tid + i * NT, key = chunk >> 4, part = chunk & 15;
        *(LAS pg8::u32x4*)(lds + AT_K + key * AT_KS + part * 16) = r.k[i];
        if (WITHV) {
            const int keyv = chunk & 63, partv = chunk >> 6;
            const unsigned w4[4] = {r.v[i][0], r.v[i][1], r.v[i][2], r.v[i][3]};
#pragma unroll
            for (int q = 0; q < 4; ++q) {
                *(LAS bf16_t*)(lds + AT_V + (partv * 8 + 2 * q) * AT_VS + keyv * 2) = (bf16_t)(w4[q] & 0xffffu);
                *(LAS bf16_t*)(lds + AT_V + (partv * 8 + 2 * q + 1) * AT_VS + keyv * 2) = (bf16_t)(w4[q] >> 16);
            }
        }
    }
}
PHASE_FN void ph_attn(const Params& p, int l, bool need_ctx, LAS unsigned char* lds) {
    const int TX_ = ltid(p.sw);
#ifdef EMU
    const int wave = TX_ >> 6;
#else
    const int wave = p.sw;
#endif
    const int g = wave & 3, th = wave >> 2;
    constexpr int NCT = C / 64, NQT = L / 64, n_lat = NB * KVH * NQT;
    const int n_ctx = need_ctx ? NB * KVH * NCT : 0;
    const float SC = 0.08838834764831845f;
    LAS unsigned char* Pw = lds + AT_P + wave * 32 * AT_PS;
    LAS float* st = (LAS float*)(lds + AT_ST + wave * 512);
    for (int u = blockIdx.x; u < n_lat + n_ctx; u += gridDim.x) {
        int txo = TX_; PG8_OPAQUE(txo);
        const int lane = txo & 63, c = lane & 31, h = lane >> 5;
        const bool lat = u < n_lat;
        const int uu = lat ? u : u - n_lat, nqt = lat ? NQT : NCT;
        const int tq = uu % nqt, kvh = (uu / nqt) % KVH, b = uu / (nqt * KVH);
        const int hq = kvh * 4 + g, ntile = lat ? NCT + 5 : NCT;
        const int tw = tq * 64 + th * 32 + c;
        const int qrow = lat ? TC + b * L + tw : b * C + tw;
        const float sink = p.in[ISINK][l * QH + hq];
        pg8::bf16x8 Qu[8], Qr[8];
#pragma unroll
        for (int ks = 0; ks < 8; ++ks) {
            Qu[ks] = *(const pg8::bf16x8*)(WSH(O_QB) + (size_t)qrow * AW + hq * 128 + ks * 16 + h * 8);
            Qr[ks] = lat ? *(const pg8::bf16x8*)(WSH(O_QRB) + (size_t)(qrow - TC) * AW + hq * 128 + ks * 16 + h * 8) : Qu[ks];
        }
#define AT_TILE(kt, krow0, rlo, rhi, jpos0) const bool ctxt = (kt) < NCT; \
        const int jpos0 = ctxt ? 0 : tq * 64 - 128 + ((kt) - NCT) * 64; \
        const int krow0 = ctxt ? b * C + (kt) * 64 : TC + b * L + jpos0, rlo = ctxt ? b * C : TC + b * L, rhi = ctxt ? b * C + C - 1 : TC + b * L + L - 1;
#define AT_SCORES(acc, kb, ctxt) { acc = (f32x16){0.f, 0.f, 0.f, 0.f, 0.f, 0.f, 0.f, 0.f, 0.f, 0.f, 0.f, 0.f, 0.f, 0.f, 0.f, 0.f}; \
        _Pragma("unroll") for (int ks = 0; ks < 8; ++ks) { const pg8::bf16x8 kf = *(const LAS pg8::bf16x8*)(lds + AT_K + ((kb) * 32 + c) * AT_KS + ks * 32 + h * 16); \
            acc = __builtin_amdgcn_mfma_f32_32x32x16_bf16(kf, (ctxt) ? Qu[ks] : Qr[ks], acc, 0, 0, 0); } }
        float mloc = -1e30f;
        AttnRegs ar;
        { AT_TILE(0, krow0, rlo, rhi, jpos0) (void)jpos0; attn_load<false>(p, ar, krow0, rlo, rhi, kvh, txo); }
        for (int kt = 0; kt < ntile; ++kt) {
            AT_TILE(kt, krow0, rlo, rhi, jpos0)
            __syncthreads();
            attn_store<false>(lds, ar, txo);
            __syncthreads();
            if (kt + 1 < ntile) { const int kn = kt + 1; const bool ctxt2 = kn < NCT; const int jp2 = ctxt2 ? 0 : tq * 64 - 128 + (kn - NCT) * 64;
              attn_load<false>(p, ar, ctxt2 ? b * C + kn * 64 : TC + b * L + jp2, ctxt2 ? b * C : TC + b * L, ctxt2 ? b * C + C - 1 : TC + b * L + L - 1, kvh, txo); }
#pragma unroll
            for (int kb = 0; kb < 2; ++kb) {
                f32x16 acc; AT_SCORES(acc, kb, ctxt)
#pragma unroll
                for (int i = 0; i < 16; ++i) {
                    const int j = jpos0 + kb * 32 + (i & 3) + 8 * (i >> 2) + 4 * h;
                    const bool valid = ctxt || (j >= 0 && j < L && j - tw <= 128 && tw - j <= 128);
                    mloc = fmaxf(mloc, valid ? acc[i] : -1e30f);
                }
            }
        }
        st[h * 32 + c] = mloc;
        WAVE_SYNC();
        const float m = fmaxf(fmaxf(st[c], st[32 + c]) * SC, sink);
        WAVE_SYNC();
        f32x16 O[4];
#pragma unroll
        for (int db = 0; db < 4; ++db) O[db] = (f32x16){0.f, 0.f, 0.f, 0.f, 0.f, 0.f, 0.f, 0.f, 0.f, 0.f, 0.f, 0.f, 0.f, 0.f, 0.f, 0.f};
        float lsum = 0.f;
        { AT_TILE(0, krow0, rlo, rhi, jpos0) (void)jpos0; attn_load<true>(p, ar, krow0, rlo, rhi, kvh, txo); }
        for (int kt = 0; kt < ntile; ++kt) {
            AT_TILE(kt, krow0, rlo, rhi, jpos0)
            __syncthreads();
            attn_store<true>(lds, ar, txo);
            __syncthreads();
            if (kt + 1 < ntile) { const int kn = kt + 1; const bool ctxt2 = kn < NCT; const int jp2 = ctxt2 ? 0 : tq * 64 - 128 + (kn - NCT) * 64;
              attn_load<true>(p, ar, ctxt2 ? b * C + kn * 64 : TC + b * L + jp2, ctxt2 ? b * C : TC + b * L, ctxt2 ? b * C + C - 1 : TC + b * L + L - 1, kvh, txo); }
#pragma unroll
            for (int kb = 0; kb < 2; ++kb) {
                f32x16 acc; AT_SCORES(acc, kb, ctxt)
#pragma unroll
                for (int grp = 0; grp < 4; ++grp) {
                    float pv[4];
#pragma unroll
                    for (int q = 0; q < 4; ++q) {
                        const int i = grp * 4 + q, j = jpos0 + kb * 32 + q + 8 * grp + 4 * h;
                        const bool valid = ctxt || (j >= 0 && j < L && j - tw <= 128 && tw - j <= 128);
                        const float e = valid ? __expf(acc[i] * SC - m) : 0.f;
                        lsum += e; pv[q] = e;
                    }
                    pg8::u32x2 w2; w2[0] = pg8::pk_bf16(pv[0], pv[1]); w2[1] = pg8::pk_bf16(pv[2], pv[3]);
                    *(LAS pg8::u32x2*)(Pw + c * AT_PS + (kb * 32 + 8 * grp + 4 * h) * 2) = w2;
                }
            }
            WAVE_SYNC();
#pragma unroll
            for (int ks = 0; ks < 4; ++ks) {
                const pg8::bf16x8 pf = *(const LAS pg8::bf16x8*)(Pw + c * AT_PS + ks * 32 + h * 16);
#pragma unroll
                for (int db = 0; db < 4; ++db) {
                    const pg8::bf16x8 vf = *(const LAS pg8::bf16x8*)(lds + AT_V + (db * 32 + c) * AT_VS + ks * 32 + h * 16);
                    O[db] = __builtin_amdgcn_mfma_f32_32x32x16_bf16(pf, vf, O[db], 0, 0, 0);
                }
            }
            WAVE_SYNC();
        }
        st[64 + h * 32 + c] = lsum;
        WAVE_SYNC();
        float rinv[16];
#pragma unroll
        for (int i = 0; i < 16; ++i) { const int q = (i & 3) + 8 * (i >> 2) + 4 * h; const float mm = fmaxf(fmaxf(st[q], st[32 + q]) * SC, sink); rinv[i] = pg8::frcp(st[64 + q] + st[96 + q] + __expf(sink - mm)); }
        WAVE_SYNC();
        const int orow0 = (lat ? TC + b * L : b * C) + tq * 64 + th * 32;
#pragma unroll
        for (int dh = 0; dh < 2; ++dh) {
#pragma unroll
            for (int d2 = 0; d2 < 2; ++d2)
#pragma unroll
                for (int i = 0; i < 16; ++i) { const int q = (i & 3) + 8 * (i >> 2) + 4 * h;
                    *(LAS bf16_t*)(Pw + q * AT_PS + (d2 * 32 + c) * 2) = f2bf(O[dh * 2 + d2][i] * rinv[i]); }
            WAVE_SYNC();
#pragma unroll
            for (int pz = 0; pz < 4; ++pz) { const int row = pz * 8 + (lane >> 3), ck = lane & 7;
                const pg8::u32x4 w4 = *(const LAS pg8::u32x4*)(Pw + row * AT_PS + ck * 16);
                *(pg8::u32x4*)(WSH(O_OCAT) + (size_t)(orow0 + row) * KCAT + PW + RW + hq * 128 + dh * 64 + ck * 8) = w4; }
            WAVE_SYNC();
        }
#undef AT_TILE
#undef AT_SCORES
    }
    __syncthreads();
}

PHASE_FN void ph_poolmm(const Params& p, int l, float* lds) {
    const int TX_ = ltid(p.sw);
    const int tx = TX_ & 15, ty = TX_ >> 4;
    const int nM = T / GT_M, nN = PW / 64;
    for (int it = blockIdx.x; it < nM * nN; it += gridDim.x) {
        const int m0 = (it / nN) * GT_M, n0 = (it % nN) * 64, g = n0 / PGD;
        float acc[4][4]; ZERO_ACC(acc);
        gemm_tile(WSF(O_POOLED) + g * PGD, PW, nullptr, 0, T, m0, p.in[IPOOLW] + ((size_t)l * 4 + g) * PGD * PGD, PGD, n0 - g * PGD, PGD, acc, lds, TX_);
#pragma unroll
        for (int i = 0; i < 4; ++i)
#pragma unroll
            for (int j = 0; j < 4; ++j) { const int n = n0 + 4 * tx + j; WSH(O_OCAT)[(size_t)(m0 + 4 * ty + i) * KCAT + n] = f2bf(acc[i][j] * p.in[IPOOLS][l * PW + n]); }
    }
}

PHASE_FN void ph_merge(const Params& p, int l, bool need_ctx, LAS unsigned char* lds) {
    const int pm0 = need_ctx ? 0 : TC / 256;
    pg8::DenseOrder S; S.init(WSH(O_OCAT), KCAT, WSH(O_WMT) + (size_t)l * D * KCAT, KCAT, pm0, T / 256 - pm0, D / 256, gridDim.x, blockIdx.x);
    pg8::EpiMerge E{WSH(O_SG), WSH(O_MBB)};
    pg8::gemm_phase<pg8::EpiMerge, pg8::DenseOrder>(lds, KCAT, KCAT, KCAT, S, E, ltid(p.sw));
}
PHASE_FN void ph_wout(const Params& p, int l, bool need_ctx, LAS unsigned char* lds) {
    const int pm0 = need_ctx ? 0 : TC / 256;
    pg8::DenseOrder S; S.init(WSH(O_MBB), D, WSH(O_WOT) + (size_t)l * D * D, D, pm0, T / 256 - pm0, D / 256, gridDim.x, blockIdx.x);
    pg8::EpiWout E{WSF(O_X), WSF(O_MOD) + (size_t)l * (NB + 1) * 6 * D, l == 0 ? p.in[ICTX] : nullptr, l == 0 ? p.in[IX] : nullptr};
    pg8::gemm_phase<pg8::EpiWout, pg8::DenseOrder>(lds, D, D, D, S, E, ltid(p.sw));
}

PHASE_FN void ph_norm2(const Params& p, int l, bool need_ctx, LAS unsigned char* lds, bool dry = false) {
    const int TX_ = ltid(p.sw);
#ifdef EMU
    const int wave = TX_ >> 6;
#else
    const int wave = p.sw;
#endif
    const int lane = TX_ & 63;
    LAS float* Wc = (LAS float*)lds;
    LAS float* lg = (LAS float*)lds + 6 * D + wave * 200;
    const int r_begin = need_ctx ? 0 : TC, nrows_all = T - r_begin;
    const int per = min((nrows_all + (int)gridDim.x - 1) / (int)gridDim.x, 40);
    const int nblk = (nrows_all + per - 1) / per;
    for (int blk = blockIdx.x; blk < nblk; blk += gridDim.x) {
    const int rb0 = r_begin + blk * per, rb1 = min(rb0 + per, T);
    const int q4 = per / 8, extra = per - 8 * q4;
    const int myn = q4 + (wave < extra ? 1 : 0), myr0 = rb0 + wave * q4 + min(wave, extra);
    const int nrow = max(0, min(myn, rb1 - myr0));
    const float* g2 = p.in[INORM2] + l * D;
    int ln = lane; PG8_OPAQUE(ln);
    float hv[5][D / 64];
#pragma unroll
    for (int rr = 0; rr < 5; ++rr) {
        const int r = min(myr0 + rr, T - 1); int t, len, mr; seq_info(r, t, len, mr);
        const float* xr = WSF(O_X) + (size_t)r * D;
        float ss = 0.f;
#pragma unroll
        for (int i = 0; i < D / 256; ++i) { const float4 x = *(const float4*)(xr + (i * 64 + ln) * 4); hv[rr][4 * i] = x.x; hv[rr][4 * i + 1] = x.y; hv[rr][4 * i + 2] = x.z; hv[rr][4 * i + 3] = x.w; ss += x.x * x.x + x.y * x.y + x.z * x.z + x.w * x.w; }
        ss = wave_bcast63(wave_total63(ss));
        const float rs = rsqrtf(ss / (float)D + NORM_EPS);
        const float* md = WSF(O_MOD) + ((size_t)l * (NB + 1) + mr) * 6 * D;
#pragma unroll
        for (int i = 0; i < D / 256; ++i) {
            const int c = (i * 64 + ln) * 4;
            const float4 g = *(const float4*)(g2 + c), sh = *(const float4*)(md + 3 * D + c), sc = *(const float4*)(md + 4 * D + c);
            const float h0 = (hv[rr][4 * i] * rs * g.x) * (1.0f + sc.x) + sh.x, h1 = (hv[rr][4 * i + 1] * rs * g.y) * (1.0f + sc.y) + sh.y;
            const float h2 = (hv[rr][4 * i + 2] * rs * g.z) * (1.0f + sc.z) + sh.z, h3 = (hv[rr][4 * i + 3] * rs * g.w) * (1.0f + sc.w) + sh.w;
            hv[rr][4 * i] = h0; hv[rr][4 * i + 1] = h1; hv[rr][4 * i + 2] = h2; hv[rr][4 * i + 3] = h3;
            if (rr < nrow) { uint2 o; o.x = pg8::pk_bf16(h0, h1); o.y = pg8::pk_bf16(h2, h3); *(uint2*)(WSH(O_H2B) + (size_t)r * D + c) = o; }
        }
        WAVE_FENCE();
    }
#pragma unroll 1
    for (int ch = 0; ch < 6; ++ch) {
        __syncthreads();
        {
            const float* wsrc = WSF(O_WRT) + ((size_t)l * (4 + NE) + ch * 6) * D;
            for (int i4 = TX_; i4 < 6 * D / 4; i4 += NT) *(LAS pg8::f32x4*)(Wc + i4 * 4) = *(const pg8::f32x4*)(wsrc + i4 * 4);
        }
        __syncthreads();
        float acc[5][6];
#pragma unroll
        for (int rr = 0; rr < 5; ++rr)
#pragma unroll
            for (int n = 0; n < 6; ++n) acc[rr][n] = 0.f;
#pragma unroll
        for (int i = 0; i < D / 256; ++i) {
#pragma unroll
            for (int n = 0; n < 6; ++n) {
                const pg8::f32x4 wq = *(const LAS pg8::f32x4*)(Wc + n * D + (i * 64 + lane) * 4);
#pragma unroll
                for (int rr = 0; rr < 5; ++rr) acc[rr][n] += hv[rr][4 * i] * wq[0] + hv[rr][4 * i + 1] * wq[1] + hv[rr][4 * i + 2] * wq[2] + hv[rr][4 * i + 3] * wq[3];
            }
#pragma unroll
            for (int rr = 0; rr < 5; ++rr) ACC_PIN6(acc[rr]);
            WAVE_FENCE();
        }
#pragma unroll
        for (int rr = 0; rr < 5; ++rr)
#pragma unroll
            for (int n = 0; n < 6; ++n) { const float tsum = wave_total63(acc[rr][n]); if (lane == 63) lg[rr * 40 + ch * 6 + n] = tsum; }
    }
    WAVE_SYNC();
    if (lane < nrow && !dry) {
        const int r = myr0 + lane; const LAS float* q = lg + lane * 40;
        float lgv[36];
#pragma unroll
        for (int i = 0; i < 36; ++i) lgv[i] = q[i] + (i < 4 ? p.in[IRGB][l * 4 + i] : p.in[IREB][l * NE + i - 4]);
        int gi = 0; float gm = lgv[0];
#pragma unroll
        for (int i = 1; i < 4; ++i) if (lgv[i] > gm) { gm = lgv[i]; gi = i; }
        float gs = 0.f;
#pragma unroll
        for (int i = 0; i < 4; ++i) gs += expf(lgv[i] - gm);
        const float g_top = 1.0f / gs;
        float el[8];
#pragma unroll
        for (int i = 0; i < 8; ++i) el[i] = (gi == 0) ? lgv[4 + i] : (gi == 1 ? lgv[12 + i] : (gi == 2 ? lgv[20 + i] : lgv[28 + i]));
        int e0 = 0; float m0 = el[0];
#pragma unroll
        for (int i = 1; i < 8; ++i) if (el[i] > m0) { m0 = el[i]; e0 = i; }
        int e1 = -1; float m1 = -3.0e38f;
#pragma unroll
        for (int i = 0; i < 8; ++i) if (i != e0 && el[i] > m1) { m1 = el[i]; e1 = i; }
        const float p1 = expf(m1 - m0);
        const float w0 = g_top / (1.0f + p1), w1 = g_top * p1 / (1.0f + p1);
        const int id0 = gi * 8 + e0, id1 = gi * 8 + e1;
        WSI(O_EID)[2 * r] = id0; WSI(O_EID)[2 * r + 1] = id1; WSF(O_EWT)[2 * r] = w0; WSF(O_EWT)[2 * r + 1] = w1;
        WSI(O_POS)[2 * r] = atomicAdd(&WSI(O_ECNT)[l * NE + id0], 1);
        WSI(O_POS)[2 * r + 1] = atomicAdd(&WSI(O_ECNT)[l * NE + id1], 1);
    }
    WAVE_SYNC();
    }
    __syncthreads();
}

constexpr int LDS_TOFF = pg8::STAGE_BYTES;
__device__ __forceinline__ void moe_offsets(const Params& p, int l, LAS int* toff) {
    const int TX_ = ltid(p.sw);
    __syncthreads();
    if (TX_ < NE) toff[64 + TX_] = WSI(O_ECNT)[l * NE + TX_];
    __syncthreads();
    if (TX_ <= NE) { int s = 0; for (int q = 0; q < TX_; ++q) s += (toff[64 + q] + 255) >> 8; toff[TX_] = s; }
    __syncthreads();
}
PHASE_FN void ph_gather(const Params& p, int l, bool need_ctx, LAS unsigned char* lds) {
    const int TX_ = ltid(p.sw);
    LAS int* toff = (LAS int*)(lds + LDS_TOFF);
    moe_offsets(p, l, toff);
    const int wave = TX_ >> 6, lane = TX_ & 63;
    const int s_begin = need_ctx ? 0 : 2 * TC;
    for (int sl = s_begin + blockIdx.x * NT + TX_; sl < 2 * T; sl += gridDim.x * NT) {
        const int e = WSI(O_EID)[sl], dst = toff[e] * 256 + WSI(O_POS)[sl];
        WSI(O_SLOTOF)[dst] = sl; WSF(O_WTP)[dst] = WSF(O_EWT)[sl];
    }
    for (int e = blockIdx.x; e < NE; e += gridDim.x) {
        const int r0 = toff[e] * 256 + toff[64 + e], r1 = toff[e + 1] * 256;
        for (int r = r0 + TX_; r < r1; r += NT) { WSI(O_SLOTOF)[r] = -1; WSF(O_WTP)[r] = 0.f; }
    }
    __syncthreads();
}
PHASE_FN void ph_moe1(const Params& p, int l, LAS unsigned char* lds) {
    LAS int* toff = (LAS int*)(lds + LDS_TOFF);
    moe_offsets(p, l, toff);
    pg8::MoeGatherOrder S{(const char*)WSH(O_H2B), (const char*)(WSH(O_EGU) + (size_t)l * NE * 2 * DE * D), (size_t)2 * DE * D * 2, (size_t)256 * D * 2, 2 * DE / 256, (int)gridDim.x, (int)blockIdx.x, toff, WSI(O_SLOTOF)};
    pg8::EpiSwiglu E{WSH(O_ACTB), WSF(O_WTP)};
    pg8::gemm_phase<pg8::EpiSwiglu, pg8::MoeGatherOrder>(lds, D, D, D, S, E, ltid(p.sw));
}
PHASE_FN void ph_moe2(const Params& p, int l, LAS unsigned char* lds) {
    LAS int* toff = (LAS int*)(lds + LDS_TOFF);
    moe_offsets(p, l, toff);
    pg8::MoeOrder S{(const char*)WSH(O_ACTB), (const char*)(WSH(O_ED) + (size_t)l * NE * D * DE), (size_t)256 * DE * 2, (size_t)D * DE * 2, (size_t)256 * DE * 2, D / 256, (int)gridDim.x, (int)blockIdx.x, toff};
    pg8::EpiDown E{WSH(O_YSB), WSI(O_SLOTOF)};
    pg8::gemm_phase<pg8::EpiDown, pg8::MoeOrder>(lds, DE, DE, DE, S, E, ltid(p.sw));
}

enum { PH_P0 = 0, PH_NORM1, PH_WIN, PH_PREP, PH_MIX, PH_READOUT, PH_MERGE, PH_WOUT, PH_NORM2, PH_GATHER, PH_MOE1, PH_MOE2, PH_FINAL };
template <int PH> __device__ __forceinline__ void run_phase(const Params& p_in, int l, unsigned char* smem, int sw) {
    const bool need_ctx = (l != DEPTH - 1);
    float* ldsf = (float*)smem;
    Params p;
#ifdef EMU
    p = p_in; p.sw = sw;
#else
    typedef const __attribute__((address_space(4))) Params* KP;
    KP kp = (KP)__builtin_amdgcn_kernarg_segment_ptr();
    asm volatile("" : "+s"(kp));
#pragma unroll
    for (int i = 0; i < N_IN; ++i) p.in[i] = kp->in[i];
    p.out = kp->out; p.ws = kp->ws; p.sw = sw; p.pad = 0;
    (void)p_in;
#endif
    LAS unsigned char* ldsl = (LAS unsigned char*)smem;
    if (PH == PH_P0) {
#if PROBE_MASK & 0x2000000
        {
            const int TX_ = ltid(p.sw); unsigned acc_ = 0;
            const size_t gt_ = (size_t)blockIdx.x * NT + TX_, gs_ = (size_t)gridDim.x * NT;
            for (size_t pg = gt_; pg < O_END / 4096; pg += gs_) acc_ += ((const volatile unsigned*)p.ws)[pg * 1024];
            for (size_t pg = gt_; pg < (size_t)DEPTH * D * 6 * D / 1024; pg += gs_) acc_ += ((const volatile unsigned*)p.in[IMODW])[pg * 1024];
            for (size_t pg = gt_; pg < (size_t)DEPTH * D * IN_DIM / 1024; pg += gs_) acc_ += ((const volatile unsigned*)p.in[IWIN])[pg * 1024];
            for (size_t pg = gt_; pg < (size_t)DEPTH * NE * D * DE / 1024; pg += gs_) { acc_ += ((const volatile unsigned*)p.in[IEWG])[pg * 1024]; acc_ += ((const volatile unsigned*)p.in[IEWU])[pg * 1024]; acc_ += ((const volatile unsigned*)p.in[IEWD])[pg * 1024]; }
            for (size_t pg = gt_; pg < (size_t)NB * L * D / 1024; pg += gs_) acc_ += ((const volatile unsigned*)p.in[IX])[pg * 1024];
            if (acc_ == 0x12345678u) WSI(O_EID)[0] = 1;
        }
#endif
        ph_pws(p); ph_rope_table(p); ph_lora_pack(p); ph_router_pack(p); ph_mod(p, ldsf); ph_conv_win0(p, ldsf); }
    if (PH == PH_NORM1) {
#if PROBE_MASK & 0x800000
        ph_norm1(p, l, 0, true);
#endif
        ph_norm1(p, l, 0); ph_fold(p, l, ldsf); }
    if (PH == PH_WIN) ph_win(p, l, ldsl);
    if (PH == PH_PREP) ph_prep(p, l, ldsf);
    if (PH == PH_MIX) {
        ph_scan(p, l, ldsl);
#if PROBE_MASK & 0x10000
        ph_scan(p, l, ldsl);
#endif
        ph_attn(p, l, need_ctx, ldsl);
#if PROBE_MASK & 0x20000
        ph_attn(p, l, need_ctx, ldsl);
#endif
    }
    if (PH == PH_READOUT) ph_readout(p, l);
    if (PH == PH_MERGE) ph_merge(p, l, need_ctx, ldsl);
    if (PH == PH_WOUT) ph_wout(p, l, need_ctx, ldsl);
    if (PH == PH_NORM2) {
#if PROBE_MASK & 0x400000
        ph_norm2(p, l, need_ctx, ldsl, true);
#endif
        ph_norm2(p, l, need_ctx, ldsl); }
    if (PH == PH_GATHER) ph_gather(p, l, need_ctx, ldsl);
    if (PH == PH_MOE1) ph_moe1(p, l, ldsl);
    if (PH == PH_MOE2) ph_moe2(p, l, ldsl);
    if (PH == PH_FINAL) {
#if PROBE_MASK & 0x800000
        ph_norm1(p, 0, 2, true);
#endif
        ph_norm1(p, 0, 2); }
}

#ifdef EMU
__shared__ unsigned char emu_smem[LDS_BYTES] __attribute__((aligned(16)));
template <int PH> __global__ void k_phase(Params p, int l) { run_phase<PH>(p, l, emu_smem, 0); }
#else
#define XB_TMO      128
#define XB_XCNT(j)  (256  + 64 * (j))
#define XB_XSUB(j)  (1280 + 64 * (j))
#define XB_XGEN(j)  (2304 + 64 * (j))
#define XB_TOP      3328
#define XB_TOPGEN   3392
#define XCD_BAR_WORDS 3456
#define XB_SPIN_CAP (1u << 18)
__device__ __forceinline__ unsigned xb_ld(unsigned* p)              { return __hip_atomic_load(p, __ATOMIC_RELAXED, __HIP_MEMORY_SCOPE_AGENT); }
__device__ __forceinline__ unsigned xb_add(unsigned* p, unsigned v) { return __hip_atomic_fetch_add(p, v, __ATOMIC_RELAXED, __HIP_MEMORY_SCOPE_AGENT); }
__device__ __forceinline__ unsigned xb_xcc_id() { return (unsigned)__builtin_amdgcn_s_getreg((3 << 11) | 20) & 0xFu; }
#define XB_SPIN(cond, bar) do { unsigned _sp = 0; while (cond) { __builtin_amdgcn_s_sleep(1); \
    if ((++_sp & 255u) == 0u) { if (xb_ld(&(bar)[XB_TMO])) break; if (_sp > XB_SPIN_CAP) { atomicAdd(&(bar)[XB_TMO], 1u); break; } } } } while (0)
struct XcdBarrier { unsigned* bar; unsigned x; volatile LAS unsigned* st; };
__device__ __forceinline__ XcdBarrier xcd_barrier_post(unsigned* bar, volatile LAS unsigned* st) {
    XcdBarrier b; b.bar = bar; b.x = xb_xcc_id(); b.st = st;
    if (threadIdx.x == 0) (void)xb_add(&bar[XB_XCNT(b.x)], 1u);
    return b;
}
__device__ __forceinline__ void xcd_barrier_complete(unsigned* bar, unsigned x, unsigned& nloc, unsigned& nx) {
    const unsigned G = gridDim.x * gridDim.y * gridDim.z;
    unsigned sum, cnt, mine, sp = 0u;
    for (;;) {
        sum = 0u; cnt = 0u; mine = 0u;
#pragma unroll
        for (unsigned j = 0; j < 16; ++j) { const unsigned c = xb_ld(&bar[XB_XCNT(j)]); sum += c; cnt += (c > 0u) ? 1u : 0u; mine = (j == x) ? c : mine; }
        if (sum == G) break;
        __builtin_amdgcn_s_sleep(1);
        if ((++sp & 255u) == 0u) { if (xb_ld(&bar[XB_TMO])) break; if (sp > XB_SPIN_CAP) { atomicAdd(&bar[XB_TMO], 1u); break; } }
    }
    nloc = mine > 0u ? mine : 1u; nx = cnt > 0u ? cnt : 1u;
}
__device__ __forceinline__ void xcd_barrier(const XcdBarrier& b_in, const int sw) {
    asm volatile("s_waitcnt vmcnt(0)" ::: "memory");
    __syncthreads();
    XcdBarrier b = b_in;
    asm volatile("" : "+s"(b.bar), "+s"(b.x));
    if (ltid(sw) == 0) {
        unsigned* bar = b.bar;
        __builtin_amdgcn_s_waitcnt(0);
        unsigned nloc = b.st[0], nx = b.st[1];
        if (nloc == 0u) { xcd_barrier_complete(bar, b.x, nloc, nx); b.st[0] = nloc; b.st[1] = nx; }
        const unsigned old = xb_add(&bar[XB_XSUB(b.x)], 1u);
        const unsigned gen = old / nloc;
        if (old + 1u == (gen + 1u) * nloc) {
            __builtin_amdgcn_fence(__ATOMIC_RELEASE, "agent");
            asm volatile("s_waitcnt vmcnt(0)" ::: "memory");
            const unsigned og = xb_add(&bar[XB_TOP], 1u);
            const unsigned tg = og / nx;
            if (og + 1u == (tg + 1u) * nx) xb_add(&bar[XB_TOPGEN], 1u);
            else XB_SPIN(xb_ld(&bar[XB_TOPGEN]) == tg, bar);
            __builtin_amdgcn_fence(__ATOMIC_ACQUIRE, "agent");
            xb_add(&bar[XB_XGEN(b.x)], 1u);
            asm volatile("s_waitcnt vmcnt(0)" ::: "memory");
        } else {
            XB_SPIN(xb_ld(&bar[XB_XGEN(b.x)]) == gen, bar);
            __builtin_amdgcn_fence(__ATOMIC_ACQUIRE, "agent");
            asm volatile("s_waitcnt vmcnt(0)" ::: "memory");
        }
    }
    __syncthreads();
}

#define RUNB(PH, l) { run_phase<PH>(p, l, smem, sw); if ((PROBE_MASK >> PH) & 1) run_phase<PH>(p, l, smem, sw); xcd_barrier(bar, sw); if (PROBE_MASK & 0x1000000) xcd_barrier(bar, sw); }
__global__ void __launch_bounds__(NT, 2) k_mega(Params p) {
    extern __shared__ __attribute__((aligned(16))) unsigned char smem[];
    const int sw = __builtin_amdgcn_readfirstlane((int)(threadIdx.x >> 6));
    volatile LAS unsigned* xbw = (volatile LAS unsigned*)((LAS unsigned char*)smem + LDS_BYTES - 16);
    if (threadIdx.x == 0) { xbw[0] = 0u; xbw[1] = 0u; xbw[2] = 0u; xbw[3] = 0u; }
    __syncthreads();
    XcdBarrier bar = xcd_barrier_post((unsigned*)(p.ws + O_BAR), xbw);
    RUNB(PH_P0, 0)
    for (int l = 0; l < DEPTH; ++l) {
        RUNB(PH_NORM1, l)
        RUNB(PH_WIN, l)
        RUNB(PH_PREP, l)
        RUNB(PH_MIX, l)
        RUNB(PH_READOUT, l)
        RUNB(PH_MERGE, l)
        RUNB(PH_WOUT, l)
        RUNB(PH_NORM2, l)
        RUNB(PH_GATHER, l)
        RUNB(PH_MOE1, l)
        RUNB(PH_MOE2, l)
    }
    run_phase<PH_FINAL>(p, 0, smem, sw);
}
#endif
}

extern "C" void kernel_launch(void* const* d_in, const int* in_sizes, int n_in, void* d_out, int out_size, void* d_ws, size_t ws_size, hipStream_t stream) {
    Params p{};
    for (int i = 0; i < N_IN; ++i) p.in[i] = (const float*)d_in[i];
    p.out = (float*)d_out;
    p.ws = (unsigned char*)d_ws;
    (void)in_sizes; (void)n_in; (void)out_size;
    if (ws_size < O_END) return;
#ifndef EMU
    static int grid = 0;
    if (!grid) {
        int dev = 0, cus = 0, per_cu = 0;
        (void)hipGetDevice(&dev);
        (void)hipDeviceGetAttribute(&cus, hipDeviceAttributeMultiprocessorCount, dev);
        (void)hipFuncSetAttribute((const void*)k_mega, hipFuncAttributeMaxDynamicSharedMemorySize, LDS_BYTES);
        (void)hipOccupancyMaxActiveBlocksPerMultiprocessor(&per_cu, (const void*)k_mega, NT, LDS_BYTES);
        (void)hipGetLastError();
        grid = cus;
    }
    (void)hipMemsetAsync(p.ws, 0, ZERO_BYTES, stream);
    hipLaunchKernelGGL(k_mega, dim3(grid), dim3(NT), LDS_BYTES, stream, p);
#else
    memset(p.ws, 0, ZERO_BYTES);
    const int G = 64;
#define LAUNCH(PH, l) emu::launch([=] { k_phase<PH>(p, l); }, dim3(G), dim3(NT))
    LAUNCH(PH_P0, 0);
    for (int l = 0; l < DEPTH; ++l) {
        LAUNCH(PH_NORM1, l); LAUNCH(PH_WIN, l); LAUNCH(PH_PREP, l); LAUNCH(PH_MIX, l); LAUNCH(PH_READOUT, l);
        LAUNCH(PH_MERGE, l); LAUNCH(PH_WOUT, l); LAUNCH(PH_NORM2, l); LAUNCH(PH_GATHER, l); LAUNCH(PH_MOE1, l); LAUNCH(PH_MOE2, l);
    }
    LAUNCH(PH_FINAL, 0);
#endif
}
```
